# Optimizing an MI355X kernel written in HIP

```python
import jax
import jax.numpy as jnp
from jax import lax
import numpy as np

D_MODEL = 1024
BATCH = 8
SEQ = 4096
DEPTH = 1

MIX_WIDTH = D_MODEL
DN_HEAD_DIM = 128
DN_WIDTH = MIX_WIDTH // 2
DN_HEADS = DN_WIDTH // DN_HEAD_DIM
DN_CONV = 4
DN_CHUNK = 64
SB_HEAD_DIM = 64
SB_WIDTH = MIX_WIDTH - DN_WIDTH
SB_HEADS = SB_WIDTH // SB_HEAD_DIM
SB_BLOCK = 128
IN_SIZES = (DN_WIDTH, DN_WIDTH, DN_WIDTH, DN_WIDTH, DN_HEADS, DN_HEADS, SB_WIDTH, SB_WIDTH, SB_WIDTH)
IN_COLS = sum(IN_SIZES)
PEER_HEADS = 8
PEER_N_KEYS = 128
PEER_EXPERTS = PEER_N_KEYS * PEER_N_KEYS
PEER_QUERY_DIM = 256
PEER_HALF = PEER_QUERY_DIM // 2
PEER_TOPK = 16
PEER_TOKEN_BLOCK = 128
N_MOD = 6
EPS = 1e-6

kernel_name = "hybrid_deltanet_stickbreak_peer_block"


def rms_norm(x, gain):
    xf = x.astype(jnp.float32)
    y = xf * lax.rsqrt(jnp.mean(xf * xf, axis=-1, keepdims=True) + EPS)
    return (y * gain.astype(jnp.float32)).astype(x.dtype)


def l2_norm(x):
    xf = x.astype(jnp.float32)
    return xf * lax.rsqrt(jnp.sum(xf * xf, axis=-1, keepdims=True) + EPS)


def causal_depthwise_conv(u, w):
    ch = u.shape[-1]
    return lax.conv_general_dilated(
        u, w[:, None, :].astype(u.dtype), window_strides=(1,), padding=[(w.shape[0] - 1, 0)],
        dimension_numbers=("NWC", "WIO", "NWC"), feature_group_count=ch)


def gated_delta_rule(q, k, v, g, beta):
    b, h, s, dk = q.shape
    dv = v.shape[-1]
    c = DN_CHUNK
    n = s // c
    q = q.reshape(b, h, n, c, dk)
    k = k.reshape(b, h, n, c, dk)
    v = v.reshape(b, h, n, c, dv)
    g = jnp.cumsum(g.reshape(b, h, n, c), axis=-1)
    beta = beta.reshape(b, h, n, c)[..., None]
    idx = jnp.arange(c)
    lower_incl = idx[:, None] >= idx[None, :]
    lower_strict = idx[:, None] > idx[None, :]
    decay = jnp.exp(jnp.where(lower_incl, g[..., :, None] - g[..., None, :], -jnp.inf))
    kbeta = k * beta
    kk = jnp.einsum('bhnid,bhnjd->bhnij', kbeta, k)
    tri = jnp.eye(c, dtype=jnp.float32) + jnp.where(lower_strict, kk * decay, 0.0)
    rhs = jnp.concatenate([kbeta * jnp.exp(g)[..., None], v * beta], axis=-1)
    sol = lax.linalg.triangular_solve(tri, rhs, left_side=True, lower=True, unit_diagonal=True)
    w_c, u_c = sol[..., :dk], sol[..., dk:]
    attn = jnp.einsum('bhnid,bhnjd->bhnij', q, k) * decay
    q_dec = q * jnp.exp(g)[..., None]
    k_dec = k * jnp.exp(g[..., -1:] - g)[..., None]
    g_last = jnp.exp(g[..., -1])

    def step(state, xs):
        q_i, k_i, w_i, u_i, a_i, gl_i = xs
        v_new = u_i - jnp.einsum('bhcd,bhde->bhce', w_i, state)
        o_i = jnp.einsum('bhcd,bhde->bhce', q_i, state) + jnp.einsum('bhij,bhje->bhie', a_i, v_new)
        state = state * gl_i[..., None, None] + jnp.einsum('bhcd,bhce->bhde', k_i, v_new)
        return state, o_i

    xs = tuple(jnp.moveaxis(t, 2, 0) for t in (q_dec, k_dec, w_c, u_c, attn, g_last))
    state0 = jnp.zeros((b, h, dk, dv), jnp.float32)
    _, o = lax.scan(step, state0, xs)
    return jnp.moveaxis(o, 0, 2).reshape(b, h, s, dv)


def stick_breaking_attention(q, k, v):
    s_len, d = q.shape[2], q.shape[3]
    scale = d ** -0.5
    outs = []
    for i in range(s_len // SB_BLOCK):
        t0 = i * SB_BLOCK
        t1 = t0 + SB_BLOCK
        z = jnp.einsum('bhtd,bhsd->bhts', q[:, :, t0:t1], k[:, :, :t1]) * scale
        causal = jnp.arange(t1)[None, :] < jnp.arange(t0, t1)[:, None]
        log_beta = jax.nn.log_sigmoid(z)
        log_1m = jnp.where(causal, jax.nn.log_sigmoid(-z), 0.0)
        after = lax.cumsum(log_1m, axis=3, reverse=True) - log_1m
        a = jnp.where(causal, jnp.exp(log_beta + after), 0.0)
        outs.append(jnp.einsum('bhts,bhsd->bhtd', a, v[:, :, :t1]))
    return jnp.concatenate(outs, axis=2)


def hybrid_mixer(h, w_in, conv_w, a_log, dt_bias, dn_out_gain, sb_q_gain, sb_k_gain, sb_out_gain, w_out):
    b, s, _ = h.shape
    f32 = jnp.float32
    proj = h @ w_in
    offs = [int(o) for o in np.cumsum(IN_SIZES)[:-1]]
    dq, dk, dv, dz, db, da, sq, sk, sv = jnp.split(proj, offs, axis=-1)
    qkv = jax.nn.silu(causal_depthwise_conv(jnp.concatenate([dq, dk, dv], axis=-1), conv_w))
    dq, dk, dv = jnp.split(qkv, 3, axis=-1)
    q = l2_norm(dq.reshape(b, s, DN_HEADS, DN_HEAD_DIM)) * DN_HEAD_DIM ** -0.5
    k = l2_norm(dk.reshape(b, s, DN_HEADS, DN_HEAD_DIM))
    v = dv.reshape(b, s, DN_HEADS, DN_HEAD_DIM).astype(f32)
    beta = jax.nn.sigmoid(db.astype(f32))
    g = -jnp.exp(a_log.astype(f32)) * jax.nn.softplus(da.astype(f32) + dt_bias.astype(f32))
    o = gated_delta_rule(q.transpose(0, 2, 1, 3), k.transpose(0, 2, 1, 3), v.transpose(0, 2, 1, 3),
                         g.transpose(0, 2, 1), beta.transpose(0, 2, 1)).transpose(0, 2, 1, 3)
    o_dn = rms_norm(o, dn_out_gain) * jax.nn.silu(dz.reshape(b, s, DN_HEADS, DN_HEAD_DIM).astype(f32))
    o_dn = o_dn.reshape(b, s, DN_WIDTH)
    qs = rms_norm(sq.reshape(b, s, SB_HEADS, SB_HEAD_DIM), sb_q_gain).astype(f32).transpose(0, 2, 1, 3)
    ks = rms_norm(sk.reshape(b, s, SB_HEADS, SB_HEAD_DIM), sb_k_gain).astype(f32).transpose(0, 2, 1, 3)
    vs = sv.reshape(b, s, SB_HEADS, SB_HEAD_DIM).astype(f32).transpose(0, 2, 1, 3)
    o_sb = stick_breaking_attention(qs, ks, vs).transpose(0, 2, 1, 3)
    o_sb = rms_norm(o_sb, sb_out_gain).reshape(b, s, SB_WIDTH)
    mixed = jnp.concatenate([o_dn, o_sb], axis=-1).astype(h.dtype)
    return mixed @ w_out


def peer_ffn(h, w_query, sub_keys, w_u, w_v):
    b, s, d = h.shape
    hb = h.reshape(b * s // PEER_TOKEN_BLOCK, PEER_TOKEN_BLOCK, d)

    def block(ht):
        t = ht.shape[0]
        q = (ht @ w_query).reshape(t, PEER_HEADS, 2, PEER_HALF)
        scores = jnp.einsum('thpk,hpnk->thpn', q, sub_keys)
        sv, si = lax.top_k(scores, PEER_TOPK)
        cand_s = sv[:, :, 0, :, None] + sv[:, :, 1, None, :]
        cand_i = si[:, :, 0, :, None] * PEER_N_KEYS + si[:, :, 1, None, :]
        top_s, top_j = lax.top_k(cand_s.reshape(t, PEER_HEADS, PEER_TOPK * PEER_TOPK), PEER_TOPK)
        expert = jnp.take_along_axis(cand_i.reshape(t, PEER_HEADS, PEER_TOPK * PEER_TOPK), top_j, axis=-1)
        gate = jax.nn.softmax(top_s.astype(jnp.float32), axis=-1)
        pre = jnp.einsum('td,thkd->thk', ht, w_u[expert]).astype(jnp.float32)
        act = jax.nn.gelu(pre, approximate=False) * gate
        return jnp.einsum('thk,thkd->td', act.astype(ht.dtype), w_v[expert])

    return lax.map(block, hb).reshape(b, s, d)


def setup_inputs(seed: int = 0) -> dict:
    key = jax.random.key(seed)
    ks = jax.random.split(key, 20)
    f32 = jnp.float32
    d = D_MODEL
    dt = jnp.exp(jax.random.uniform(ks[6], (DEPTH, DN_HEADS), f32, np.log(1e-3), np.log(1e-1)))
    return {
        "x": jax.random.normal(ks[0], (BATCH, SEQ, d), f32),
        "c": jax.random.normal(ks[1], (BATCH, d), f32),
        "w_ada": jax.random.normal(ks[2], (DEPTH, d, N_MOD * d), f32) * (0.5 * d ** -0.5),
        "b_ada": jax.random.normal(ks[3], (DEPTH, N_MOD * d), f32) * 0.02,
        "norm1_gain": 1.0 + 0.02 * jax.random.normal(ks[4], (DEPTH, d), f32),
        "w_in": jax.random.normal(ks[5], (DEPTH, d, IN_COLS), f32) * d ** -0.5,
        "dn_conv_w": jax.random.normal(ks[7], (DEPTH, DN_CONV, 3 * DN_WIDTH), f32) * DN_CONV ** -0.5,
        "dn_a_log": jnp.log(jax.random.uniform(ks[8], (DEPTH, DN_HEADS), f32, 1.0, 16.0)),
        "dn_dt_bias": dt + jnp.log(-jnp.expm1(-dt)),
        "dn_out_gain": 1.0 + 0.02 * jax.random.normal(ks[9], (DEPTH, DN_HEAD_DIM), f32),
        "sb_q_gain": 1.0 + 0.02 * jax.random.normal(ks[10], (DEPTH, SB_HEAD_DIM), f32),
        "sb_k_gain": 1.0 + 0.02 * jax.random.normal(ks[11], (DEPTH, SB_HEAD_DIM), f32),
        "sb_out_gain": 1.0 + 0.02 * jax.random.normal(ks[12], (DEPTH, SB_HEAD_DIM), f32),
        "w_out": jax.random.normal(ks[13], (DEPTH, MIX_WIDTH, d), f32) * MIX_WIDTH ** -0.5,
        "norm2_gain": 1.0 + 0.02 * jax.random.normal(ks[14], (DEPTH, d), f32),
        "peer_w_query": jax.random.normal(ks[15], (DEPTH, d, PEER_HEADS * PEER_QUERY_DIM), f32) * d ** -0.5,
        "peer_sub_keys": jax.random.normal(ks[16], (DEPTH, PEER_HEADS, 2, PEER_N_KEYS, PEER_HALF), f32) * PEER_HALF ** -0.5,
        "peer_w_u": jax.random.normal(ks[17], (DEPTH, PEER_EXPERTS, d), f32) * d ** -0.5,
        "peer_w_v": jax.random.normal(ks[18], (DEPTH, PEER_EXPERTS, d), f32),
    }


def reference(x, c, w_ada, b_ada, norm1_gain, w_in, dn_conv_w, dn_a_log, dn_dt_bias, dn_out_gain,
              sb_q_gain, sb_k_gain, sb_out_gain, w_out, norm2_gain, peer_w_query, peer_sub_keys,
              peer_w_u, peer_w_v):
    for l in range(DEPTH):
        mod = jax.nn.silu(c) @ w_ada[l] + b_ada[l]
        shift1, scale1, gate1, shift2, scale2, gate2 = jnp.split(mod[:, None, :], N_MOD, axis=-1)
        h = rms_norm(x, norm1_gain[l]) * (1.0 + scale1) + shift1
        mixed = hybrid_mixer(h, w_in[l], dn_conv_w[l], dn_a_log[l], dn_dt_bias[l], dn_out_gain[l],
                             sb_q_gain[l], sb_k_gain[l], sb_out_gain[l], w_out[l])
        x = x + gate1 * mixed
        h = rms_norm(x, norm2_gain[l]) * (1.0 + scale2) + shift2
        x = x + gate2 * peer_ffn(h, peer_w_query[l], peer_sub_keys[l], peer_w_u[l], peer_w_v[l])
    return x
```

```cpp
#include <hip/hip_runtime.h>
#include <hip/hip_cooperative_groups.h>
#include <cstdio>
namespace cg = cooperative_groups;

#define LAS __attribute__((address_space(3)))
typedef unsigned short bf16_t;
typedef short bf16x8 __attribute__((ext_vector_type(8)));
typedef float f32x4 __attribute__((ext_vector_type(4)));
typedef float f32x2 __attribute__((ext_vector_type(2)));
typedef unsigned u32x4 __attribute__((ext_vector_type(4)));
typedef unsigned u32x2 __attribute__((ext_vector_type(2)));
using bf16x2 = __attribute__((ext_vector_type(2))) __bf16;

constexpr int T_TOK = 32768, SEQ = 4096, DM = 1024, NMODC = 6144;
constexpr int NPROJ = 3584, LDW_IN = 3592;
constexpr int NTHR = 512, NWAVE = 8;
constexpr int LDS_BYTES = 144 * 1024;
constexpr int N_PHASES = 9;
constexpr int DN_BLOCKS = 32;
constexpr float EPS = 1e-6f;

constexpr size_t WS_MOD = 0;
constexpr size_t WS_WSM = WS_MOD + 8 * 6144 * 4;
constexpr size_t WS_SMALL = WS_WSM + 8 * 1024 * 4;
constexpr size_t WS_WIN_T = WS_SMALL + (size_t)T_TOK * 8 * 4;
constexpr size_t WS_WOUT_T = WS_WIN_T + (size_t)NPROJ * 1024 * 2;
constexpr size_t WS_WQ_T = WS_WOUT_T + (size_t)1024 * 1024 * 2;
constexpr size_t WS_SUBK = WS_WQ_T + (size_t)2048 * 1024 * 2;
constexpr size_t WS_UT = WS_SUBK + (size_t)16 * 128 * 128 * 2;
constexpr size_t WS_VT = WS_UT + (size_t)16384 * 1024 * 2;
constexpr size_t WS_ACT = WS_VT + (size_t)16384 * 1024 * 2;
constexpr size_t WS_PROJ = WS_ACT + (size_t)T_TOK * 1024 * 2;
constexpr size_t WS_QPEER = WS_PROJ;
constexpr size_t WS_CAND = WS_PROJ + (size_t)T_TOK * 2048 * 2;
constexpr size_t WS_END = WS_PROJ + (size_t)T_TOK * NPROJ * 2;

struct Args { const float* in[19]; float* out; unsigned char* ws; int ph_lo, ph_hi; };

__device__ __forceinline__ float wave_sum(float v) {
#pragma unroll
    for (int o = 1; o < 64; o <<= 1) v += __shfl_xor(v, o);
    return v;
}
__device__ __forceinline__ float wave_max(float v) {
#pragma unroll
    for (int o = 1; o < 64; o <<= 1) v = fmaxf(v, __shfl_xor(v, o));
    return v;
}
__device__ __forceinline__ unsigned f2bf(float f) { unsigned u = __float_as_uint(f); u += 0x7FFFu + ((u >> 16) & 1u); return u >> 16; }
__device__ __forceinline__ unsigned pk2(float lo, float hi) { return f2bf(lo) | (f2bf(hi) << 16); }
__device__ __forceinline__ float bf_lo(unsigned w) { return __uint_as_float(w << 16); }
__device__ __forceinline__ float bf_hi(unsigned w) { return __uint_as_float(w & 0xffff0000u); }
__device__ __forceinline__ float dot2(unsigned a, unsigned b, float acc) {
    return __builtin_amdgcn_fdot2_f32_bf16(__builtin_bit_cast(bf16x2, a), __builtin_bit_cast(bf16x2, b), acc, false);
}
__device__ __forceinline__ float siluf(float x) { return x / (1.0f + __expf(-x)); }
template <int CTRL> __device__ __forceinline__ float dppf(float x) {
    return __builtin_bit_cast(float, __builtin_amdgcn_update_dpp(0, __builtin_bit_cast(int, x), CTRL, 0xF, 0xF, true));
}
#define LDS_WAIT() asm volatile("s_waitcnt lgkmcnt(0)" ::: "memory")

namespace pg8 {
constexpr int BM = 256, BK = 64, HALF = 128, HTB = HALF * BK * 2, STAGE_BYTES = 8 * HTB, NXCD = 8, WGM = 8;
__device__ __forceinline__ int lds_byte(int r, int c) { const int st = (r >> 4) * 2 + (c >> 5), rr = r & 15, cc = c & 31, ob = rr * 64 + cc * 2; return st * 1024 + (ob ^ (((ob >> 9) & 1) << 5)); }
__device__ __forceinline__ void stage_rc(int b, int& R, int& C) { const int st = b / 1024, sb = b % 1024, swz = sb ^ (((sb >> 9) & 1) << 5); R = (st >> 1) * 16 + swz / 64; C = (st & 1) * 32 + (swz % 64) / 2; }
__device__ __forceinline__ int perm32(int rho) { const int n = rho >> 4, i = rho & 15; return 8 * (i >> 2) + 4 * n + (i & 3); }
struct Unit { int pm, pn; };
struct Gemm { const bf16_t* A; const bf16_t* Bt; int M, N, K; };
struct StaticOrder {
    int nM, nN, nwg, G, c;
    __device__ void init(int M, int N, int G_, int c_) { nM = M / BM; nN = N / BM; nwg = nM * nN; G = G_; c = c_; }
    __device__ bool next(int i, Unit& u) const {
        const long L = (long)i * G + c; if (L >= nwg) return false;
        int wgid = (int)L; { const int q = nwg / NXCD, r = nwg % NXCD, xcd = wgid % NXCD, off = wgid / NXCD; wgid = (xcd < r ? xcd * (q + 1) : r * (q + 1) + (xcd - r) * q) + off; }
        const int nig = WGM * nN, gid = wgid / nig, fm = gid * WGM, gsz = (nM - fm) < WGM ? (nM - fm) : WGM;
        u.pm = fm + ((wgid % nig) % gsz); u.pn = (wgid % nig) / gsz; return true;
    }
};
__device__ __forceinline__ unsigned cvt_pk_bf16(float lo, float hi) { unsigned r; asm volatile("v_cvt_pk_bf16_f32 %0, %1, %2" : "=v"(r) : "v"(lo), "v"(hi)); return r; }

struct EpiBf16 {
    static constexpr bool PERM = true;
    bf16_t* O; int ldc;
    __device__ __forceinline__ void operator()(const f32x4 (&acc)[2][2][4][2], const Unit& u, int wr, int wc, int fr, int fq) const {
        const int row0 = u.pm * BM + wr * 64 + fr; const int col0 = u.pn * BM + wc * 32 + 8 * fq;
#pragma unroll
        for (int ai = 0; ai < 2; ++ai)
#pragma unroll
            for (int m = 0; m < 4; ++m) { bf16_t* rowp = O + (size_t)(row0 + ai * HALF + m * 16) * ldc + col0;
#pragma unroll
                for (int bj = 0; bj < 2; ++bj) { const f32x4 v0 = acc[ai][bj][m][0], v1 = acc[ai][bj][m][1];
                    u32x4 w; w.x = cvt_pk_bf16(v0[0], v0[1]); w.y = cvt_pk_bf16(v0[2], v0[3]); w.z = cvt_pk_bf16(v1[0], v1[1]); w.w = cvt_pk_bf16(v1[2], v1[3]);
                    *(u32x4*)(rowp + bj * HALF) = w; } }
    }
};
struct EpiResid {
    static constexpr bool PERM = false;
    const float* x; const float* mod; float* out;
    __device__ __forceinline__ void operator()(const f32x4 (&acc)[2][2][4][2], const Unit& u, int wr, int wc, int fr, int fq) const {
        const int row0 = u.pm * BM + wr * 64 + fr, col0 = u.pn * BM + wc * 32 + 4 * fq;
        const int b = (u.pm * BM) >> 12;
        f32x4 gv[2][2];
#pragma unroll
        for (int bj = 0; bj < 2; ++bj)
#pragma unroll
            for (int n = 0; n < 2; ++n) gv[bj][n] = *(const f32x4*)(mod + (size_t)b * NMODC + 2048 + col0 + bj * HALF + n * 16);
#pragma unroll
        for (int ai = 0; ai < 2; ++ai)
#pragma unroll
            for (int m = 0; m < 4; ++m) { const size_t off = (size_t)(row0 + ai * HALF + m * 16) * DM + col0;
#pragma unroll
                for (int bj = 0; bj < 2; ++bj)
#pragma unroll
                    for (int n = 0; n < 2; ++n) { const f32x4 xv = *(const f32x4*)(x + off + bj * HALF + n * 16);
                        *(f32x4*)(out + off + bj * HALF + n * 16) = xv + gv[bj][n] * acc[ai][bj][m][n]; } }
    }
};

template <class Epi>
__device__ __forceinline__ void gemm_phase(LAS unsigned char* lds, const Gemm g, const StaticOrder& S, const Epi& E) {
    const int tid = threadIdx.x, wid = __builtin_amdgcn_readfirstlane(tid >> 6), lane = tid & 63, wr = wid >> 2, wc = wid & 3, fr = lane & 15, fq = lane >> 4;
    const int K = g.K, nt = K / BK;
    unsigned voffA[2], voffB[2];
#pragma unroll
    for (int i = 0; i < 2; ++i) { int R, C; stage_rc(tid * 16 + i * 8192, R, C); const int Rb = Epi::PERM ? ((R & ~31) + perm32(R & 31)) : R;
        voffA[i] = (unsigned)(R * K + C) * 2u; voffB[i] = (unsigned)(Rb * K + C) * 2u; }
    const size_t kstep = (size_t)(BK * 2);
    const size_t hstep = (size_t)HALF * K * 2;
    const size_t tstep = 2 * hstep;
    const unsigned ldsw = (unsigned)wid * 1024u;
    const int aoff = lds_byte(wr * 64 + fr, fq * 8), boff = lds_byte(wc * 32 + fr, fq * 8);
#define PG8_SA(b, h) (((b) * 2 + (h)) * HTB)
#define PG8_SB(b, h) ((4 + (b) * 2 + (h)) * HTB)
#define PG8_STAGE(bufoff, gbase, voff) do { _Pragma("unroll") for (int _i = 0; _i < 2; ++_i) \
        __builtin_amdgcn_global_load_lds((const unsigned*)((const char*)(gbase) + (voff)[_i]), (LAS unsigned*)(lds + (bufoff) + ldsw + _i * 8192), 16, 0, 0); } while (0)
#define PG8_LDA(dst, b, h) do { _Pragma("unroll") for (int m = 0; m < 4; ++m) _Pragma("unroll") for (int k = 0; k < 2; ++k) dst[m][k] = *(const LAS bf16x8*)(lds + PG8_SA(b, h) + aoff + m * 2048 + k * 1024); } while (0)
#define PG8_LDB(dst, b, h) do { _Pragma("unroll") for (int n = 0; n < 2; ++n) _Pragma("unroll") for (int k = 0; k < 2; ++k) dst[n][k] = *(const LAS bf16x8*)(lds + PG8_SB(b, h) + boff + n * 2048 + k * 1024); } while (0)
#define PG8_MMA(ai, bj, At, Bt) do { __builtin_amdgcn_s_setprio(1); _Pragma("unroll") for (int m = 0; m < 4; ++m) _Pragma("unroll") for (int n = 0; n < 2; ++n) _Pragma("unroll") for (int k = 0; k < 2; ++k) \
        acc[ai][bj][m][n] = __builtin_amdgcn_mfma_f32_16x16x32_bf16(Bt[n][k], At[m][k], acc[ai][bj][m][n], 0, 0, 0); __builtin_amdgcn_s_setprio(0); } while (0)
#define PG8_WAIT_V(n) asm volatile("s_waitcnt vmcnt(" #n ")" ::: "memory")
#define PG8_WAIT_L(n) asm volatile("s_waitcnt lgkmcnt(" #n ")" ::: "memory")
#define PG8_BAR __builtin_amdgcn_s_barrier()
#define PG8_SCHED __builtin_amdgcn_sched_barrier(0)
    Unit cur, nxt; int ui = 0;
    if (!S.next(0, cur)) return;
    f32x4 acc[2][2][4][2];
#pragma unroll
    for (int a = 0; a < 2; ++a)
#pragma unroll
        for (int b = 0; b < 2; ++b)
#pragma unroll
            for (int m = 0; m < 4; ++m)
#pragma unroll
                for (int n = 0; n < 2; ++n) acc[a][b][m][n] = (f32x4){0.f, 0.f, 0.f, 0.f};
    bf16x8 At[4][2], B0[2][2], B1[2][2];
    const char* cA = (const char*)g.A + (size_t)cur.pm * tstep; const char* cB = (const char*)g.Bt + (size_t)cur.pn * tstep;
    PG8_STAGE(PG8_SB(0, 0), cB, voffB); PG8_STAGE(PG8_SA(0, 0), cA, voffA); PG8_STAGE(PG8_SB(0, 1), cB + hstep, voffB); PG8_STAGE(PG8_SA(0, 1), cA + hstep, voffA);
    if (wr == 1) PG8_BAR;
    PG8_WAIT_V(4); PG8_BAR;
    PG8_STAGE(PG8_SB(1, 0), cB + kstep, voffB); PG8_STAGE(PG8_SA(1, 0), cA + kstep, voffA); PG8_STAGE(PG8_SB(1, 1), cB + hstep + kstep, voffB);
    PG8_WAIT_V(6); PG8_BAR;
    for (;;) {
        const bool has_next = S.next(ui + 1, nxt);
        const char* nA = has_next ? (const char*)g.A + (size_t)nxt.pm * tstep : cA; const char* nB = has_next ? (const char*)g.Bt + (size_t)nxt.pn * tstep : cB;
        for (int t = 0; t < nt; t += 2) {
            const bool last = (t == nt - 2);
            const char* a1 = cA + (size_t)(t + 1) * kstep;
            const char* a2 = last ? nA : cA + (size_t)(t + 2) * kstep; const char* b2 = last ? nB : cB + (size_t)(t + 2) * kstep;
            const char* a3 = a2 + kstep; const char* b3 = b2 + kstep;
            PG8_LDB(B0, 0, 0); PG8_SCHED; PG8_LDA(At, 0, 0); PG8_STAGE(PG8_SA(1, 1), a1 + hstep, voffA);
            PG8_WAIT_L(8); PG8_BAR; PG8_WAIT_L(0); PG8_MMA(0, 0, At, B0); PG8_BAR; PG8_SCHED;
            PG8_LDB(B1, 0, 1); PG8_STAGE(PG8_SB(0, 0), b2, voffB);
            PG8_BAR; PG8_WAIT_L(0); PG8_MMA(0, 1, At, B1); PG8_BAR;
            PG8_LDA(At, 0, 1); PG8_STAGE(PG8_SA(0, 0), a2, voffA);
            PG8_BAR; PG8_WAIT_L(0); PG8_MMA(1, 0, At, B0); PG8_BAR; PG8_SCHED;
            PG8_STAGE(PG8_SB(0, 1), b2 + hstep, voffB);
            PG8_WAIT_V(6); PG8_BAR; PG8_MMA(1, 1, At, B1); PG8_BAR;
            PG8_LDB(B0, 1, 0); PG8_SCHED; PG8_LDA(At, 1, 0); PG8_STAGE(PG8_SA(0, 1), a2 + hstep, voffA);
            PG8_WAIT_L(8); PG8_BAR; PG8_WAIT_L(0); PG8_MMA(0, 0, At, B0); PG8_BAR; PG8_SCHED;
            PG8_LDB(B1, 1, 1); PG8_STAGE(PG8_SB(1, 0), b3, voffB);
            PG8_BAR; PG8_WAIT_L(0); PG8_MMA(0, 1, At, B1); PG8_BAR;
            PG8_LDA(At, 1, 1); PG8_STAGE(PG8_SA(1, 0), a3, voffA);
            PG8_BAR; PG8_WAIT_L(0); PG8_MMA(1, 0, At, B0); PG8_BAR; PG8_SCHED;
            PG8_STAGE(PG8_SB(1, 1), b3 + hstep, voffB);
            PG8_WAIT_V(6); PG8_BAR; PG8_MMA(1, 1, At, B1); PG8_BAR;
        }
        E(acc, cur, wr, wc, fr, fq);
        if (!has_next) break;
#pragma unroll
        for (int a = 0; a < 2; ++a)
#pragma unroll
            for (int b = 0; b < 2; ++b)
#pragma unroll
                for (int m = 0; m < 4; ++m)
#pragma unroll
                    for (int n = 0; n < 2; ++n) acc[a][b][m][n] = (f32x4){0.f, 0.f, 0.f, 0.f};
        cur = nxt; cA = nA; cB = nB; ++ui;
    }
    PG8_WAIT_V(0);
    if (wr == 0) PG8_BAR;
    PG8_BAR;
#undef PG8_SA
#undef PG8_SB
#undef PG8_STAGE
#undef PG8_LDA
#undef PG8_LDB
#undef PG8_MMA
#undef PG8_WAIT_V
#undef PG8_WAIT_L
#undef PG8_BAR
#undef PG8_SCHED
}
}

__device__ __forceinline__ void transpose_item(const float* W, int ldw, int K, bf16_t* WT, LAS float* scr, int kb, int src_col0, int dst_row0, int lane) {
    const int k0 = 64 * kb;
#pragma unroll 8
    for (int i = 0; i < 32; ++i) { const int kk = 2 * i + (lane >> 5); scr[kk * 33 + (lane & 31)] = W[(size_t)(k0 + kk) * ldw + src_col0 + (lane & 31)]; }
    LDS_WAIT();
    const int c = lane & 7;
#pragma unroll
    for (int j = 0; j < 4; ++j) { const int n = (lane >> 3) + 8 * j; const LAS float* s = scr + (8 * c) * 33 + n;
        u32x4 o; o.x = pk2(s[0 * 33], s[1 * 33]); o.y = pk2(s[2 * 33], s[3 * 33]); o.z = pk2(s[4 * 33], s[5 * 33]); o.w = pk2(s[6 * 33], s[7 * 33]);
        *(u32x4*)(WT + (size_t)(dst_row0 + n) * K + k0 + 8 * c) = o; }
    LDS_WAIT();
}

__device__ __forceinline__ void phase0(const Args& a, LAS unsigned char* lds) {
    const int tid = threadIdx.x, lane = tid & 63, wave = tid >> 6, G = gridDim.x;
    unsigned char* ws = a.ws;
    {
        const float* c = a.in[1]; const float* w_ada = a.in[2]; const float* b_ada = a.in[3]; float* mod = (float*)(ws + WS_MOD);
        LAS float* sc = (LAS float*)lds;
        LAS float* red = (LAS float*)(lds + 32768);
        if ((int)blockIdx.x < 96) {
            for (int i = tid; i < 8192; i += NTHR) sc[i] = siluf(c[i]);
            __syncthreads();
            for (int item = blockIdx.x; item < 96; item += G) {
                const int n = item * 64 + lane; float acc[8];
#pragma unroll
                for (int b = 0; b < 8; ++b) acc[b] = 0.f;
                for (int k4 = 0; k4 < 32; ++k4) {
                    const int k = wave * 128 + k4 * 4;
                    float wv[4];
#pragma unroll
                    for (int j = 0; j < 4; ++j) wv[j] = w_ada[(size_t)(k + j) * NMODC + n];
#pragma unroll
                    for (int b = 0; b < 8; ++b) { const f32x4 s = *(const LAS f32x4*)(sc + b * 1024 + k);
                        acc[b] += s[0] * wv[0] + s[1] * wv[1] + s[2] * wv[2] + s[3] * wv[3]; }
                }
#pragma unroll
                for (int b = 0; b < 8; ++b) red[(wave * 8 + b) * 64 + lane] = acc[b];
                __syncthreads();
                { const int b = tid >> 6; float s = 0.f;
#pragma unroll
                  for (int w = 0; w < 8; ++w) s += red[(w * 8 + b) * 64 + lane];
                  mod[b * NMODC + n] = s + b_ada[n]; }
                __syncthreads();
            }
        }
        __syncthreads();
    }
    {
        const int gw = blockIdx.x * NWAVE + wave, NGW = G * NWAVE;
        LAS float* scr = (LAS float*)(lds + wave * 8704);
        bf16_t* win_t = (bf16_t*)(ws + WS_WIN_T); bf16_t* wout_t = (bf16_t*)(ws + WS_WOUT_T); bf16_t* wq_t = (bf16_t*)(ws + WS_WQ_T);
        constexpr int I_IN = 16 * (NPROJ / 32), I_OUT = 16 * 32, I_Q = 16 * 64;
        for (int it = gw; it < I_IN + I_OUT + I_Q; it += NGW) {
            int r = it;
            if (r < I_IN) { const int kb = r / (NPROJ / 32), nb = r % (NPROJ / 32), n0 = nb * 32; transpose_item(a.in[5], LDW_IN, 1024, win_t, scr, kb, n0 + (n0 >= 2048 ? 8 : 0), n0, lane); continue; }
            r -= I_IN;
            if (r < I_OUT) { const int kb = r / 32, nb = r % 32; transpose_item(a.in[13], 1024, 1024, wout_t, scr, kb, nb * 32, nb * 32, lane); continue; }
            r -= I_OUT;
            { const int kb = r / 64, nb = r % 64; transpose_item(a.in[15], 2048, 1024, wq_t, scr, kb, nb * 32, nb * 32, lane); }
        }
    }
    {
        const size_t gt = (size_t)blockIdx.x * NTHR + tid, NGT = (size_t)G * NTHR;
        float* wsm = (float*)(ws + WS_WSM);
        for (size_t i = gt; i < 8 * 1024; i += NGT) { const int j = (int)(i >> 10), k = (int)(i & 1023); wsm[i] = a.in[5][(size_t)k * LDW_IN + 2048 + j]; }
        { const float* sk = a.in[16]; unsigned* o = (unsigned*)(ws + WS_SUBK);
          for (size_t i = gt; i < 16 * 128 * 128 / 2; i += NGT) o[i] = pk2(sk[2 * i], sk[2 * i + 1]); }
        { const f32x4* u = (const f32x4*)a.in[17]; const f32x4* v = (const f32x4*)a.in[18]; u32x4* uo = (u32x4*)(ws + WS_UT); u32x4* vo = (u32x4*)(ws + WS_VT);
          const size_t n8 = (size_t)16384 * 1024 / 8;
          for (size_t i = gt; i < n8; i += NGT) {
              const f32x4 a0 = u[2 * i], a1 = u[2 * i + 1]; u32x4 o; o.x = pk2(a0[0], a0[1]); o.y = pk2(a0[2], a0[3]); o.z = pk2(a1[0], a1[1]); o.w = pk2(a1[2], a1[3]); uo[i] = o;
              const f32x4 b0 = v[2 * i], b1 = v[2 * i + 1]; u32x4 p; p.x = pk2(b0[0], b0[1]); p.y = pk2(b0[2], b0[3]); p.z = pk2(b1[0], b1[1]); p.w = pk2(b1[2], b1[3]); vo[i] = p; } }
    }
}

template <bool FIRST>
__device__ __forceinline__ void phase_norm(const Args& a, const float* src, const float* gain, int shift_off, int scale_off) {
    const int tid = threadIdx.x, lane = tid & 63, wave = tid >> 6;
    const int gw = blockIdx.x * NWAVE + wave, NGW = gridDim.x * NWAVE;
    const float* mod = (const float*)(a.ws + WS_MOD); const float* wsm = (const float*)(a.ws + WS_WSM);
    bf16_t* dst = (bf16_t*)(a.ws + WS_ACT); float* small = (float*)(a.ws + WS_SMALL);
    for (int tok = gw; tok < T_TOK; tok += NGW) {
        const f32x4* xr = (const f32x4*)(src + (size_t)tok * DM) + lane;
        f32x4 v[4]; float ss = 0.f;
#pragma unroll
        for (int j = 0; j < 4; ++j) { v[j] = xr[64 * j]; ss += (v[j][0] * v[j][0] + v[j][1] * v[j][1]) + (v[j][2] * v[j][2] + v[j][3] * v[j][3]); }
        const float rstd = rsqrtf(wave_sum(ss) * (1.0f / DM) + EPS);
        const float* mrow = mod + (size_t)(tok >> 12) * NMODC;
        float sa[8];
#pragma unroll
        for (int c = 0; c < 8; ++c) sa[c] = 0.f;
#pragma unroll
        for (int j = 0; j < 4; ++j) {
            const int d = 4 * lane + 256 * j;
            const f32x4 g = *(const f32x4*)(gain + d), sc = *(const f32x4*)(mrow + scale_off + d), sh = *(const f32x4*)(mrow + shift_off + d);
            const f32x4 h = v[j] * rstd * g * (1.0f + sc) + sh;
            u32x2 o; o.x = pk2(h[0], h[1]); o.y = pk2(h[2], h[3]);
            *(u32x2*)(dst + (size_t)tok * DM + d) = o;
            if (FIRST) {
#pragma unroll
                for (int c = 0; c < 8; ++c) { const f32x4 w = *(const f32x4*)(wsm + c * 1024 + d); sa[c] += (h[0] * w[0] + h[1] * w[1]) + (h[2] * w[2] + h[3] * w[3]); }
            }
        }
        if (FIRST) {
            float ov = 0.f;
#pragma unroll
            for (int c = 0; c < 8; ++c) { const float s = wave_sum(sa[c]); if (lane == c) ov = s; }
            if (lane < 8) small[(size_t)tok * 8 + lane] = ov;
        }
    }
}

__device__ __forceinline__ void dn_scan(const Args& a, LAS unsigned char* lds) {
    const int tid = threadIdx.x, lane = tid & 63, wave = tid >> 6;
    const int b = blockIdx.x >> 2, hd = blockIdx.x & 3;
    const bf16_t* proj = (const bf16_t*)(a.ws + WS_PROJ); const float* small = (const float*)(a.ws + WS_SMALL);
    bf16_t* mixed = (bf16_t*)(a.ws + WS_ACT);
    const float* convw = a.in[6]; const float* ogain = a.in[9];
    LAS float* qs = (LAS float*)lds;
    LAS float* ks = qs + 64 * 144;
    LAS float* vs = ks + 64 * 144;
    LAS float* os = vs + 64 * 128;
    LAS float* be = os + 64 * 128;
    LAS float* eg = be + 64;
    const float Aexp = __expf(a.in[7][hd]), dtb = a.in[8][hd];
    const int kq = lane & 3, cs = lane >> 2, e = wave * 16 + cs;
    f32x2 S[16];
#pragma unroll
    for (int j = 0; j < 16; ++j) S[j] = (f32x2){0.f, 0.f};
    for (int bt = 0; bt < SEQ / 64; ++bt) {
        const int s0 = bt * 64; const size_t tok0 = (size_t)b * SEQ + s0;
        for (int idx = tid; idx < 64 * 96; idx += NTHR) {
            const int i = idx / 96, cgp = idx % 96, which = cgp >> 5, c4 = (cgp & 31) * 4, col = which * 512 + hd * 128 + c4;
            f32x4 y = (f32x4){0.f, 0.f, 0.f, 0.f};
#pragma unroll
            for (int j = 0; j < 4; ++j) {
                const int sp = s0 + i - 3 + j;
                if (sp >= 0) {
                    const u32x2 u = *(const u32x2*)(proj + ((size_t)b * SEQ + sp) * NPROJ + col);
                    const f32x4 w = *(const f32x4*)(convw + j * 1536 + col);
                    y[0] += w[0] * bf_lo(u.x); y[1] += w[1] * bf_hi(u.x); y[2] += w[2] * bf_lo(u.y); y[3] += w[3] * bf_hi(u.y);
                }
            }
            f32x4 r; r[0] = siluf(y[0]); r[1] = siluf(y[1]); r[2] = siluf(y[2]); r[3] = siluf(y[3]);
            if (which == 2) *(LAS f32x4*)(vs + i * 128 + c4) = r;
            else *(LAS f32x4*)((which == 0 ? qs : ks) + i * 144 + (c4 >> 5) * 36 + (c4 & 31)) = r;
        }
        __syncthreads();
        for (int rr = 0; rr < 16; ++rr) {
            const int row = wave * 16 + rr, i = row & 63; const bool isk = row >= 64;
            LAS float* p = (isk ? ks : qs) + i * 144 + ((2 * lane) >> 5) * 36 + ((2 * lane) & 31);
            f32x2 v = *(LAS f32x2*)p;
            const float ss = wave_sum(v[0] * v[0] + v[1] * v[1]);
            const float sc = rsqrtf(ss + EPS) * (isk ? 1.0f : 0.08838834764831845f);
            v[0] *= sc; v[1] *= sc; *(LAS f32x2*)p = v;
        }
        if (tid < 64) {
            const float bl = small[(tok0 + tid) * 8 + hd], dl = small[(tok0 + tid) * 8 + 4 + hd] + dtb;
            be[tid] = 1.0f / (1.0f + expf(-bl));
            const float sp = fmaxf(dl, 0.f) + log1pf(expf(-fabsf(dl)));
            eg[tid] = expf(-Aexp * sp);
        }
        __syncthreads();
        for (int i = 0; i < 64; ++i) {
            const LAS f32x4* kp = (const LAS f32x4*)(ks + i * 144 + kq * 36);
            const LAS f32x4* qp = (const LAS f32x4*)(qs + i * 144 + kq * 36);
            f32x4 kv[8];
#pragma unroll
            for (int j = 0; j < 8; ++j) kv[j] = kp[j];
            f32x2 p2 = (f32x2){0.f, 0.f};
#pragma unroll
            for (int j = 0; j < 8; ++j) { p2 += S[2 * j] * (f32x2){kv[j][0], kv[j][1]}; p2 += S[2 * j + 1] * (f32x2){kv[j][2], kv[j][3]}; }
            float kS = p2[0] + p2[1];
            kS += dppf<0xB1>(kS); kS += dppf<0x4E>(kS);
            const float g_ = eg[i], bt_ = be[i], ve = vs[i * 128 + e];
            const float cc = bt_ * (ve - g_ * kS);
            const f32x2 g2 = (f32x2){g_, g_}, c2 = (f32x2){cc, cc};
#pragma unroll
            for (int j = 0; j < 8; ++j) { S[2 * j] = S[2 * j] * g2 + (f32x2){kv[j][0], kv[j][1]} * c2; S[2 * j + 1] = S[2 * j + 1] * g2 + (f32x2){kv[j][2], kv[j][3]} * c2; }
            f32x2 o2 = (f32x2){0.f, 0.f};
#pragma unroll
            for (int j = 0; j < 8; ++j) { const f32x4 qv = qp[j]; o2 += S[2 * j] * (f32x2){qv[0], qv[1]}; o2 += S[2 * j + 1] * (f32x2){qv[2], qv[3]}; }
            float o = o2[0] + o2[1];
            o += dppf<0xB1>(o); o += dppf<0x4E>(o);
            if (kq == 0) os[i * 128 + e] = o;
        }
        __syncthreads();
        for (int rr = 0; rr < 8; ++rr) {
            const int i = wave * 8 + rr; const size_t tok = tok0 + i;
            const f32x2 ov = *(const LAS f32x2*)(os + i * 128 + 2 * lane);
            const float ss = wave_sum(ov[0] * ov[0] + ov[1] * ov[1]);
            const float r = rsqrtf(ss * (1.0f / 128.0f) + EPS);
            const unsigned z = *(const unsigned*)(proj + tok * NPROJ + 1536 + hd * 128 + 2 * lane);
            const float o0 = ov[0] * r * ogain[2 * lane] * siluf(bf_lo(z)), o1 = ov[1] * r * ogain[2 * lane + 1] * siluf(bf_hi(z));
            *(unsigned*)(mixed + tok * DM + hd * 128 + 2 * lane) = pk2(o0, o1);
        }
    }
}

__device__ __forceinline__ void sb_attn(const Args& a, LAS unsigned char* lds, int wave_id, int n_waves) {
    const int tid = threadIdx.x, lane = tid & 63, wave = tid >> 6;
    const bf16_t* proj = (const bf16_t*)(a.ws + WS_PROJ); bf16_t* mixed = (bf16_t*)(a.ws + WS_ACT);
    const float* gq = a.in[10]; const float* gk = a.in[11]; const float* go = a.in[12];
    LAS unsigned char* kl = lds + wave * 18432;
    LAS unsigned char* vl = kl + 9216;
    LAS float* rk = (LAS float*)(vl + 8192);
    for (int item = wave_id; item < 8 * 8 * 64; item += n_waves) {
        const int tile = 63 - (item >> 6), bh = item & 63, b = bh >> 3, h = bh & 7;
        const int t0 = tile * 64, t = t0 + lane; const size_t tokq = (size_t)b * SEQ + t;
        unsigned qp[32];
        {
            const u32x4* qr = (const u32x4*)(proj + tokq * NPROJ + 2048 + h * 64);
            u32x4 raw[8]; float ss = 0.f;
#pragma unroll
            for (int j = 0; j < 8; ++j) { raw[j] = qr[j];
#pragma unroll
                for (int c = 0; c < 4; ++c) { const float lo = bf_lo(raw[j][c]), hi = bf_hi(raw[j][c]); ss += lo * lo + hi * hi; } }
            const float rq = rsqrtf(ss * (1.0f / 64.0f) + EPS) * 0.125f;
#pragma unroll
            for (int j = 0; j < 8; ++j)
#pragma unroll
                for (int c = 0; c < 4; ++c) { const int d = j * 8 + c * 2;
                    qp[j * 4 + c] = pk2(bf_lo(raw[j][c]) * rq * gq[d] * gk[d], bf_hi(raw[j][c]) * rq * gq[d + 1] * gk[d + 1]); }
        }
        float o[64];
#pragma unroll
        for (int d = 0; d < 64; ++d) o[d] = 0.f;
        float R = 0.f;
        for (int kb = tile; kb >= 0; --kb) {
            {
                const size_t tokk = (size_t)b * SEQ + kb * 64;
#pragma unroll
                for (int j = 0; j < 8; ++j) { const int c = lane + 64 * j, r = c >> 3, cc = c & 7;
                    const u32x4 kvv = *(const u32x4*)(proj + (tokk + r) * NPROJ + 2560 + h * 64 + cc * 8);
                    const u32x4 vvv = *(const u32x4*)(proj + (tokk + r) * NPROJ + 3072 + h * 64 + cc * 8);
                    *(LAS u32x4*)(kl + r * 144 + cc * 16) = kvv; *(LAS u32x4*)(vl + r * 128 + cc * 16) = vvv; }
                LDS_WAIT();
                float ss = 0.f;
#pragma unroll
                for (int j = 0; j < 8; ++j) { const u32x4 w = *(const LAS u32x4*)(kl + lane * 144 + j * 16);
                    ss = dot2(w.x, w.x, ss); ss = dot2(w.y, w.y, ss); ss = dot2(w.z, w.z, ss); ss = dot2(w.w, w.w, ss); }
                rk[lane] = rsqrtf(ss * (1.0f / 64.0f) + EPS);
                LDS_WAIT();
            }
            for (int sl = 63; sl >= 0; --sl) {
                const int s = kb * 64 + sl;
                float z0 = 0.f, z1 = 0.f;
#pragma unroll
                for (int j = 0; j < 8; ++j) { const u32x4 w = *(const LAS u32x4*)(kl + sl * 144 + j * 16);
                    z0 = dot2(w.x, qp[4 * j], z0); z1 = dot2(w.y, qp[4 * j + 1], z1); z0 = dot2(w.z, qp[4 * j + 2], z0); z1 = dot2(w.w, qp[4 * j + 3], z1); }
                const float z = (z0 + z1) * rk[sl];
                const float lp = __logf(1.0f + __expf(-fabsf(z)));
                const float l1m = -(fmaxf(z, 0.f) + lp), lb = fminf(z, 0.f) - lp;
                const bool valid = s < t;
                const float aw = valid ? __expf(lb + R) : 0.f;
                R += valid ? l1m : 0.f;
#pragma unroll
                for (int j = 0; j < 8; ++j) { const u32x4 w = *(const LAS u32x4*)(vl + sl * 128 + j * 16);
#pragma unroll
                    for (int c = 0; c < 4; ++c) { o[j * 8 + 2 * c] += aw * bf_lo(w[c]); o[j * 8 + 2 * c + 1] += aw * bf_hi(w[c]); } }
            }
            LDS_WAIT();
            if (__all(R < -110.0f)) break;
        }
        {
            float ss = 0.f;
#pragma unroll
            for (int d = 0; d < 64; ++d) ss += o[d] * o[d];
            const float r = rsqrtf(ss * (1.0f / 64.0f) + EPS);
            u32x4* dst = (u32x4*)(mixed + tokq * DM + 512 + h * 64);
#pragma unroll
            for (int j = 0; j < 8; ++j) { u32x4 w;
#pragma unroll
                for (int c = 0; c < 4; ++c) { const int d = j * 8 + 2 * c; w[c] = pk2(o[d] * r * go[d], o[d + 1] * r * go[d + 1]); }
                dst[j] = w; }
        }
    }
}

__device__ __forceinline__ void phase_scores(const Args& a, LAS unsigned char* lds) {
    const int tid = threadIdx.x, lane = tid & 63, wave = tid >> 6;
    const bf16_t* qp = (const bf16_t*)(a.ws + WS_QPEER); const bf16_t* kb = (const bf16_t*)(a.ws + WS_SUBK); unsigned* cand = (unsigned*)(a.ws + WS_CAND);
    LAS unsigned char* kl = lds;
    LAS unsigned char* ql = lds + 128 * 272;
    for (int item = blockIdx.x; item < 4096; item += gridDim.x) {
        const int hp = item >> 8, tile = item & 255;
        __syncthreads();
        for (int c = tid; c < 2048; c += NTHR) { const int r = c >> 4, cc = c & 15;
            *(LAS u32x4*)(kl + r * 272 + cc * 16) = *(const u32x4*)(kb + ((size_t)hp * 128 + r) * 128 + cc * 8);
            *(LAS u32x4*)(ql + r * 256 + cc * 16) = *(const u32x4*)(qp + ((size_t)tile * 128 + r) * 2048 + hp * 128 + cc * 8); }
        __syncthreads();
        for (int tt = wave; tt < 128; tt += NWAVE) {
            float s0 = 0.f, s1 = 0.f;
#pragma unroll
            for (int i = 0; i < 16; ++i) {
                const u32x4 q = *(const LAS u32x4*)(ql + tt * 256 + i * 16);
                const u32x4 k0 = *(const LAS u32x4*)(kl + lane * 272 + i * 16), k1 = *(const LAS u32x4*)(kl + (lane + 64) * 272 + i * 16);
                s0 = dot2(k0.x, q.x, s0); s0 = dot2(k0.y, q.y, s0); s0 = dot2(k0.z, q.z, s0); s0 = dot2(k0.w, q.w, s0);
                s1 = dot2(k1.x, q.x, s1); s1 = dot2(k1.y, q.y, s1); s1 = dot2(k1.z, q.z, s1); s1 = dot2(k1.w, q.w, s1);
            }
            float v0 = __uint_as_float((__float_as_uint(s0) & ~127u) | (unsigned)lane);
            float v1 = __uint_as_float((__float_as_uint(s1) & ~127u) | (unsigned)(lane + 64));
            unsigned res = 0;
#pragma unroll
            for (int r = 0; r < 16; ++r) {
                const float m = wave_max(fmaxf(v0, v1));
                if (v0 == m) v0 = -3.0e38f;
                if (v1 == m) v1 = -3.0e38f;
                if (lane == r) res = __float_as_uint(m);
            }
            if (lane < 16) cand[((size_t)(tile * 128 + tt) * 16 + hp) * 16 + lane] = res;
        }
    }
}

__device__ __forceinline__ void phase_peer(const Args& a, LAS unsigned char* lds) {
    const int tid = threadIdx.x, lane = tid & 63, wave = tid >> 6;
    const int gw = blockIdx.x * NWAVE + wave, NGW = gridDim.x * NWAVE;
    const unsigned* cand = (const unsigned*)(a.ws + WS_CAND); const bf16_t* h2 = (const bf16_t*)(a.ws + WS_ACT);
    const bf16_t* UT = (const bf16_t*)(a.ws + WS_UT); const bf16_t* VT = (const bf16_t*)(a.ws + WS_VT);
    const float* mod = (const float*)(a.ws + WS_MOD); float* out = a.out;
    LAS unsigned* sel_e = (LAS unsigned*)(lds + wave * 1536);
    LAS float* sel_g = (LAS float*)(lds + wave * 1536 + 512);
    LAS float* act = (LAS float*)(lds + wave * 1536 + 1024);
    int ci, cj;
    if (lane < 16) { ci = 0; cj = lane; } else if (lane < 24) { ci = 1; cj = lane - 16; } else if (lane < 29) { ci = 2; cj = lane - 24; }
    else if (lane < 33) { ci = 3; cj = lane - 29; } else if (lane < 36) { ci = 4; cj = lane - 33; } else if (lane < 42) { ci = 5 + ((lane - 36) >> 1); cj = (lane - 36) & 1; }
    else if (lane < 50) { ci = 8 + (lane - 42); cj = 0; } else { ci = 0; cj = 0; }
    const int sub = lane & 15, grp = lane >> 4;
    for (int tok = gw; tok < T_TOK; tok += NGW) {
        for (int h = 0; h < 8; ++h) {
            const unsigned c0 = cand[((size_t)tok * 16 + h * 2) * 16 + sub], c1 = cand[((size_t)tok * 16 + h * 2 + 1) * 16 + sub];
            const unsigned ai = __shfl(c0, ci), bj = __shfl(c1, cj);
            const float s = __uint_as_float(ai & ~127u) + __uint_as_float(bj & ~127u);
            float v = (lane < 50) ? __uint_as_float((__float_as_uint(s) & ~255u) | (unsigned)(ci * 16 + cj)) : -3.0e38f;
            unsigned res = 0;
#pragma unroll
            for (int r = 0; r < 16; ++r) { const float m = wave_max(v); if (v == m) v = -3.0e38f; if (lane == r) res = __float_as_uint(m); }
            const int ri = (res >> 4) & 15, rj = res & 15;
            const unsigned e0 = __shfl(c0, ri) & 127u, e1 = __shfl(c1, rj) & 127u;
            const float val = __uint_as_float(res & ~255u);
            const float m0 = __shfl(val, 0);
            float ex = (lane < 16) ? __expf(val - m0) : 0.f;
            const float den = wave_sum(ex);
            if (lane < 16) { sel_e[h * 16 + lane] = e0 * 128u + e1; sel_g[h * 16 + lane] = ex / den; }
        }
        LDS_WAIT();
        {
            u32x4 hf[8];
#pragma unroll
            for (int i = 0; i < 8; ++i) hf[i] = *(const u32x4*)(h2 + (size_t)tok * DM + i * 128 + sub * 8);
            for (int g = 0; g < 32; ++g) {
                const unsigned e = sel_e[g * 4 + grp];
                const u32x4* ur = (const u32x4*)(UT + (size_t)e * DM) + sub;
                float p0 = 0.f, p1 = 0.f;
#pragma unroll
                for (int i = 0; i < 8; ++i) { const u32x4 w = ur[i * 16];
                    p0 = dot2(w.x, hf[i].x, p0); p1 = dot2(w.y, hf[i].y, p1); p0 = dot2(w.z, hf[i].z, p0); p1 = dot2(w.w, hf[i].w, p1); }
                float p = p0 + p1;
                p += __shfl_xor(p, 1); p += __shfl_xor(p, 2); p += __shfl_xor(p, 4); p += __shfl_xor(p, 8);
                const float ge = 0.5f * p * (1.0f + erff(p * 0.70710678118654752f));
                if (sub == 0) act[g * 4 + grp] = ge * sel_g[g * 4 + grp];
            }
        }
        LDS_WAIT();
        {
            float y[16];
#pragma unroll
            for (int d = 0; d < 16; ++d) y[d] = 0.f;
#pragma unroll 4
            for (int e = 0; e < 128; ++e) {
                const unsigned ex = sel_e[e]; const float av = act[e];
                const u32x4* vr = (const u32x4*)(VT + (size_t)ex * DM);
                const u32x4 w0 = vr[lane], w1 = vr[64 + lane];
#pragma unroll
                for (int c = 0; c < 4; ++c) { y[2 * c] += av * bf_lo(w0[c]); y[2 * c + 1] += av * bf_hi(w0[c]); y[8 + 2 * c] += av * bf_lo(w1[c]); y[8 + 2 * c + 1] += av * bf_hi(w1[c]); }
            }
            const float* g2 = mod + (size_t)(tok >> 12) * NMODC + 5120;
            float* orow = out + (size_t)tok * DM;
#pragma unroll
            for (int hh = 0; hh < 2; ++hh)
#pragma unroll
                for (int q = 0; q < 2; ++q) { const int d = hh * 512 + lane * 8 + q * 4;
                    const f32x4 xv = *(const f32x4*)(orow + d), gv = *(const f32x4*)(g2 + d);
                    f32x4 r; r[0] = xv[0] + gv[0] * y[hh * 8 + q * 4]; r[1] = xv[1] + gv[1] * y[hh * 8 + q * 4 + 1]; r[2] = xv[2] + gv[2] * y[hh * 8 + q * 4 + 2]; r[3] = xv[3] + gv[3] * y[hh * 8 + q * 4 + 3];
                    *(f32x4*)(orow + d) = r; }
        }
        LDS_WAIT();
    }
}

__global__ void __launch_bounds__(NTHR, 2) mega(Args a) {
    extern __shared__ __attribute__((aligned(16))) unsigned char smem[];
    LAS unsigned char* lds = (LAS unsigned char*)smem;
    const int lo = a.ph_lo, hi = a.ph_hi;
    const int G = gridDim.x;
#define IN(k) (lo <= (k) && (k) < hi)
#define SYNC(k) do { if (IN(k) && IN((k) + 1)) { cg::this_grid().sync(); } } while (0)
    if (IN(0)) phase0(a, lds);
    SYNC(0);
    if (IN(1)) phase_norm<true>(a, a.in[0], a.in[4], 0, 1024);
    SYNC(1);
    if (IN(2)) { pg8::Gemm g{(const bf16_t*)(a.ws + WS_ACT), (const bf16_t*)(a.ws + WS_WIN_T), T_TOK, NPROJ, 1024}; pg8::StaticOrder S; S.init(T_TOK, NPROJ, G, (int)blockIdx.x);
        pg8::EpiBf16 E{(bf16_t*)(a.ws + WS_PROJ), NPROJ}; pg8::gemm_phase(lds, g, S, E); }
    SYNC(2);
    if (IN(3)) {
        if ((int)blockIdx.x < DN_BLOCKS) dn_scan(a, lds);
        else sb_attn(a, lds, ((int)blockIdx.x - DN_BLOCKS) * NWAVE + (int)(threadIdx.x >> 6), (G - DN_BLOCKS) * NWAVE);
    }
    SYNC(3);
    if (IN(4)) { pg8::Gemm g{(const bf16_t*)(a.ws + WS_ACT), (const bf16_t*)(a.ws + WS_WOUT_T), T_TOK, 1024, 1024}; pg8::StaticOrder S; S.init(T_TOK, 1024, G, (int)blockIdx.x);
        pg8::EpiResid E{a.in[0], (const float*)(a.ws + WS_MOD), a.out}; pg8::gemm_phase(lds, g, S, E); }
    SYNC(4);
    if (IN(5)) phase_norm<false>(a, a.out, a.in[14], 3072, 4096);
    SYNC(5);
    if (IN(6)) { pg8::Gemm g{(const bf16_t*)(a.ws + WS_ACT), (const bf16_t*)(a.ws + WS_WQ_T), T_TOK, 2048, 1024}; pg8::StaticOrder S; S.init(T_TOK, 2048, G, (int)blockIdx.x);
        pg8::EpiBf16 E{(bf16_t*)(a.ws + WS_QPEER), 2048}; pg8::gemm_phase(lds, g, S, E); }
    SYNC(6);
    if (IN(7)) phase_scores(a, lds);
    SYNC(7);
    if (IN(8)) phase_peer(a, lds);
#undef IN
#undef SYNC
}

#ifndef ONE_LAUNCH
#define ONE_LAUNCH 0
#endif

extern "C" void kernel_launch(void* const* d_in, const int* in_sizes, int n_in, void* d_out, int out_size, void* d_ws, size_t ws_size, hipStream_t stream) {
    static int grid = 0;
    if (grid == 0) {
        int dev = 0, cus = 0, per_cu = 0;
        (void)hipGetDevice(&dev);
        (void)hipDeviceGetAttribute(&cus, hipDeviceAttributeMultiprocessorCount, dev);
        (void)hipFuncSetAttribute((const void*)mega, hipFuncAttributeMaxDynamicSharedMemorySize, LDS_BYTES);
        (void)hipOccupancyMaxActiveBlocksPerMultiprocessor(&per_cu, (const void*)mega, NTHR, LDS_BYTES);
        if (per_cu < 1) { fprintf(stderr, "kernel_launch: occupancy query says %d blocks/CU\n", per_cu); per_cu = 1; }
        if (per_cu > 1) per_cu = 1;
        grid = cus * per_cu;
        if (ws_size < WS_END) fprintf(stderr, "kernel_launch: workspace too small: %zu < %zu\n", ws_size, (size_t)WS_END);
    }
    Args a{};
    for (int i = 0; i < 19; ++i) a.in[i] = (const float*)d_in[i];
    a.out = (float*)d_out; a.ws = (unsigned char*)d_ws;
#if ONE_LAUNCH
    a.ph_lo = 0; a.ph_hi = N_PHASES;
    void* args[] = {&a};
    hipError_t e = hipLaunchCooperativeKernel((const void*)mega, dim3(grid), dim3(NTHR), args, LDS_BYTES, stream);
    if (e != hipSuccess) fprintf(stderr, "cooperative launch failed: %s (grid %d)\n", hipGetErrorString(e), grid);
#else
    for (int p = 0; p < N_PHASES; ++p) {
        a.ph_lo = p; a.ph_hi = p + 1;
        hipLaunchKernelGGL(mega, dim3(grid), dim3(NTHR), LDS_BYTES, stream, a);
    }
#endif
}
```

```cpp
#include <hip/hip_runtime.h>
#include <hip/hip_cooperative_groups.h>
#include <cstdio>
#include <utility>
#include <type_traits>
namespace cg = cooperative_groups;
#ifndef INPROJ_I8
#define INPROJ_I8 1
#endif
#ifndef QUERY_I8
#define QUERY_I8 1
#endif

#define LAS __attribute__((address_space(3)))
typedef unsigned short bf16_t;
typedef short bf16x8 __attribute__((ext_vector_type(8)));
typedef float f32x4 __attribute__((ext_vector_type(4)));
typedef float f32x2 __attribute__((ext_vector_type(2)));
typedef unsigned u32x4 __attribute__((ext_vector_type(4)));
typedef unsigned u32x2 __attribute__((ext_vector_type(2)));
using bf16x2 = __attribute__((ext_vector_type(2))) __bf16;

constexpr int T_TOK = 32768, SEQ = 4096, DM = 1024, NMODC = 6144;
constexpr int NPROJ = 3584, LDW_IN = 3592;
constexpr int NTHR = 512, NWAVE = 8;
constexpr int LDS_BYTES = 160 * 1024;
constexpr int N_PHASES = 11;
constexpr int DN_BLOCKS = 64;
constexpr float EPS = 1e-6f;

constexpr size_t WS_MOD = 0;
constexpr size_t WS_WSM = WS_MOD + 8 * 6144 * 4;
constexpr size_t WS_SMALL = WS_WSM + 8 * 1024 * 4;
constexpr size_t WS_WIN_T = WS_SMALL + (size_t)T_TOK * 8 * 4;
constexpr size_t WS_WOUT_T = WS_WIN_T + (size_t)NPROJ * 1024 * 2;
constexpr size_t WS_WQ_T = WS_WOUT_T + (size_t)1024 * 1024 * 2;
constexpr size_t WS_SUBK = WS_WQ_T + (size_t)2048 * 1024 * 2;
constexpr size_t WS_UT = WS_SUBK + (size_t)16 * 128 * 128 * 2;
constexpr size_t WS_VT = WS_UT + (size_t)16384 * 1024 * 2;
constexpr size_t WS_US = WS_UT + (size_t)16384 * 1024;
constexpr size_t WS_VS = WS_US + 65536;
constexpr size_t WS_H1S = WS_VS + 65536;
constexpr size_t WS_WINS = WS_H1S + (size_t)T_TOK * 4;
constexpr size_t WS_WQS = WS_WINS + 16384;
constexpr size_t WS_WOS = WS_WQS + 8192;
constexpr size_t WS_MS = WS_WOS + 4096;
constexpr size_t WS_ACT = WS_VT + (size_t)16384 * 1024 * 2;
constexpr size_t WS_PROJ = WS_ACT + (size_t)T_TOK * 1024 * 2;
constexpr size_t WS_QPEER = WS_PROJ;
constexpr size_t WS_SELE = WS_PROJ + (size_t)T_TOK * 2048 * 2;
constexpr size_t WS_SELG = WS_SELE + (size_t)T_TOK * 128 * 4;
constexpr size_t WS_HQ = WS_SELG + (size_t)T_TOK * 128 * 4;
constexpr size_t WS_HS = WS_HQ + (size_t)T_TOK * 1024;
constexpr size_t WS_END = WS_PROJ + (size_t)T_TOK * NPROJ * 2;
constexpr size_t DN_REC = 73728;
constexpr size_t WS_DN = WS_END;
constexpr size_t WS_X1B = WS_DN;
constexpr size_t WS_MQ = WS_DN + (size_t)T_TOK * 1024 * 2;
constexpr size_t WS_GLS = WS_DN + 2048 * DN_REC;
constexpr size_t WS_END2 = WS_GLS + 8192;
constexpr size_t WS_BAR = WS_END2;
constexpr size_t WS_XB = WS_BAR + 16 * 256;
constexpr size_t WS_END3 = WS_XB + 3456 * 4;
constexpr size_t VT_OFF = (size_t)T_TOK * 512 * 4;

struct Args { const float* in[19]; float* out; unsigned char* ws; int ph_lo, ph_hi; };

template <int CTRL> __device__ __forceinline__ float dpp_(float x) {
    return __builtin_bit_cast(float, __builtin_amdgcn_update_dpp(0, __builtin_bit_cast(int, x), CTRL, 0xF, 0xF, true));
}
__device__ __forceinline__ float wave_sum(float v) {
    v += dpp_<0xB1>(v); v += dpp_<0x4E>(v); v += dpp_<0x141>(v); v += dpp_<0x140>(v);
    v += __shfl_xor(v, 16); v += __shfl_xor(v, 32);
    return v;
}
__device__ __forceinline__ float wave_max(float v) {
    v = fmaxf(v, dpp_<0xB1>(v)); v = fmaxf(v, dpp_<0x4E>(v)); v = fmaxf(v, dpp_<0x141>(v)); v = fmaxf(v, dpp_<0x140>(v));
    v = fmaxf(v, __shfl_xor(v, 16)); v = fmaxf(v, __shfl_xor(v, 32));
    return v;
}
__device__ __forceinline__ unsigned pk2(float lo, float hi) {
    typedef __bf16 bf2v_t __attribute__((ext_vector_type(2)));
    bf2v_t v; v[0] = (__bf16)lo; v[1] = (__bf16)hi; return __builtin_bit_cast(unsigned, v);
}
__device__ __forceinline__ unsigned f2bf(float f) { return pk2(f, 0.f) & 0xffffu; }
__device__ __forceinline__ float bf_lo(unsigned w) { return __uint_as_float(w << 16); }
__device__ __forceinline__ float bf_hi(unsigned w) { return __uint_as_float(w & 0xffff0000u); }
__device__ __forceinline__ float dot2(unsigned a, unsigned b, float acc) {
    return __builtin_amdgcn_fdot2_f32_bf16(__builtin_bit_cast(bf16x2, a), __builtin_bit_cast(bf16x2, b), acc, false);
}
__device__ __forceinline__ float siluf(float x) { return x * __builtin_amdgcn_rcpf(1.0f + __expf(-x)); }
template <int CTRL> __device__ __forceinline__ float dppf(float x) {
    return __builtin_bit_cast(float, __builtin_amdgcn_update_dpp(0, __builtin_bit_cast(int, x), CTRL, 0xF, 0xF, true));
}
#define LDS_WAIT() asm volatile("s_waitcnt lgkmcnt(0)" ::: "memory")

namespace pg8 {
typedef int i32x4 __attribute__((ext_vector_type(4)));
constexpr int BM = 256, BK = 64, HALF = 128, HTB = HALF * BK * 2, STAGE_BYTES = 8 * HTB, NXCD = 8, WGM = 4;
__device__ __forceinline__ int lds_byte(int r, int c) { const int st = (r >> 4) * 2 + (c >> 5), rr = r & 15, cc = c & 31, ob = rr * 64 + cc * 2; return st * 1024 + (ob ^ (((ob >> 9) & 1) << 5)); }
__device__ __forceinline__ void stage_rc(int b, int& R, int& C) { const int st = b / 1024, sb = b % 1024, swz = sb ^ (((sb >> 9) & 1) << 5); R = (st >> 1) * 16 + swz / 64; C = (st & 1) * 32 + (swz % 64) / 2; }
__device__ __forceinline__ int perm32(int rho) { const int n = rho >> 4, i = rho & 15; return 8 * (i >> 2) + 4 * n + (i & 3); }
struct Unit { int pm, pn; };
struct Gemm { const bf16_t* A; const bf16_t* Bt; int M, N, K; };
struct StaticOrder {
    int nM, nN, nwg, G, c;
    __device__ void init(int M, int N, int G_, int c_) { nM = M / BM; nN = N / BM; nwg = nM * nN; G = G_; c = c_; }
    __device__ bool next(int i, Unit& u) const {
        const long L = (long)i * G + c; if (L >= nwg) return false;
        int wgid = (int)L; { const int q = nwg / NXCD, r = nwg % NXCD, xcd = wgid % NXCD, off = wgid / NXCD; wgid = (xcd < r ? xcd * (q + 1) : r * (q + 1) + (xcd - r) * q) + off; }
        const int nig = WGM * nN, gid = wgid / nig, fm = gid * WGM, gsz = (nM - fm) < WGM ? (nM - fm) : WGM;
        u.pm = fm + ((wgid % nig) % gsz); u.pn = (wgid % nig) / gsz; return true;
    }
};
__device__ __forceinline__ unsigned cvt_pk_bf16(float lo, float hi) { unsigned r; asm volatile("v_cvt_pk_bf16_f32 %0, %1, %2" : "=v"(r) : "v"(lo), "v"(hi)); return r; }

struct EpiBf16 {
    static constexpr bool PERM = true;
    bf16_t* O; int ldc;
    __device__ __forceinline__ void operator()(const f32x4 (&acc)[2][2][4][2], const Unit& u, int wr, int wc, int fr, int fq) const {
        const int row0 = u.pm * BM + wr * 64 + fr; const int col0 = u.pn * BM + wc * 32 + 8 * fq;
#pragma unroll
        for (int ai = 0; ai < 2; ++ai)
#pragma unroll
            for (int m = 0; m < 4; ++m) { bf16_t* rowp = O + (size_t)(row0 + ai * HALF + m * 16) * ldc + col0;
#pragma unroll
                for (int bj = 0; bj < 2; ++bj) { const f32x4 v0 = acc[ai][bj][m][0], v1 = acc[ai][bj][m][1];
                    u32x4 w; w.x = cvt_pk_bf16(v0[0], v0[1]); w.y = cvt_pk_bf16(v0[2], v0[3]); w.z = cvt_pk_bf16(v1[0], v1[1]); w.w = cvt_pk_bf16(v1[2], v1[3]);
                    *(u32x4*)(rowp + bj * HALF) = w; } }
    }
};
struct EpiBf16S {
    static constexpr bool PERM = true;
    bf16_t* O; int ldc; const float* ascale; const float* bscale;
    __device__ __forceinline__ void operator()(const i32x4 (&acc)[2][2][4][2], const Unit& u, int wr, int wc, int fr, int fq) const {
        const int row0 = u.pm * BM + wr * 64 + fr; const int col0 = u.pn * BM + wc * 32 + 8 * fq;
        f32x4 bs[2][2];
#pragma unroll
        for (int bj = 0; bj < 2; ++bj) { bs[bj][0] = *(const f32x4*)(bscale + col0 + bj * HALF); bs[bj][1] = *(const f32x4*)(bscale + col0 + bj * HALF + 4); }
#pragma unroll
        for (int ai = 0; ai < 2; ++ai)
#pragma unroll
            for (int m = 0; m < 4; ++m) { const int row = row0 + ai * HALF + m * 16; const float as = ascale[row]; bf16_t* rowp = O + (size_t)row * ldc + col0;
#pragma unroll
                for (int bj = 0; bj < 2; ++bj) { const i32x4 a0 = acc[ai][bj][m][0], a1 = acc[ai][bj][m][1];
                    const f32x4 v0 = (f32x4){(float)a0[0], (float)a0[1], (float)a0[2], (float)a0[3]} * bs[bj][0] * as;
                    const f32x4 v1 = (f32x4){(float)a1[0], (float)a1[1], (float)a1[2], (float)a1[3]} * bs[bj][1] * as;
                    u32x4 w; w.x = cvt_pk_bf16(v0[0], v0[1]); w.y = cvt_pk_bf16(v0[2], v0[3]); w.z = cvt_pk_bf16(v1[0], v1[1]); w.w = cvt_pk_bf16(v1[2], v1[3]);
                    *(u32x4*)(rowp + bj * HALF) = w; } }
    }
};
struct EpiResidS {
    static constexpr bool PERM = false;
    const float* x; const float* mod; bf16_t* out; const float* ascale; const float* bscale;
    __device__ __forceinline__ void operator()(const i32x4 (&acc)[2][2][4][2], const Unit& u, int wr, int wc, int fr, int fq) const {
        const int row0 = u.pm * BM + wr * 64 + fr, col0 = u.pn * BM + wc * 32 + 4 * fq;
        const int b = (u.pm * BM) >> 12;
        f32x4 gv[2][2];
#pragma unroll
        for (int bj = 0; bj < 2; ++bj)
#pragma unroll
            for (int n = 0; n < 2; ++n) gv[bj][n] = *(const f32x4*)(mod + (size_t)b * NMODC + 2048 + col0 + bj * HALF + n * 16) * *(const f32x4*)(bscale + col0 + bj * HALF + n * 16);
#pragma unroll
        for (int ai = 0; ai < 2; ++ai) {
            f32x4 xv[4][2][2]; float as[4];
#pragma unroll
            for (int m = 0; m < 4; ++m) { const int row = row0 + ai * HALF + m * 16; const size_t off = (size_t)row * DM + col0; as[m] = ascale[row];
#pragma unroll
                for (int bj = 0; bj < 2; ++bj)
#pragma unroll
                    for (int n = 0; n < 2; ++n) xv[m][bj][n] = *(const f32x4*)(x + off + bj * HALF + n * 16); }
            __builtin_amdgcn_sched_barrier(0);
#pragma unroll
            for (int m = 0; m < 4; ++m) { const int row = row0 + ai * HALF + m * 16; const size_t off = (size_t)row * DM + col0;
#pragma unroll
                for (int bj = 0; bj < 2; ++bj)
#pragma unroll
                    for (int n = 0; n < 2; ++n) { const i32x4 ai4 = acc[ai][bj][m][n];
                        const f32x4 r = xv[m][bj][n] + gv[bj][n] * ((f32x4){(float)ai4[0], (float)ai4[1], (float)ai4[2], (float)ai4[3]} * as[m]);
                        u32x2 w; w.x = cvt_pk_bf16(r[0], r[1]); w.y = cvt_pk_bf16(r[2], r[3]);
                        *(u32x2*)(out + off + bj * HALF + n * 16) = w; } }
        }
    }
};
struct EpiResid {
    static constexpr bool PERM = false;
    const float* x; const float* mod; bf16_t* out;
    __device__ __forceinline__ void operator()(const f32x4 (&acc)[2][2][4][2], const Unit& u, int wr, int wc, int fr, int fq) const {
        const int row0 = u.pm * BM + wr * 64 + fr, col0 = u.pn * BM + wc * 32 + 4 * fq;
        const int b = (u.pm * BM) >> 12;
        f32x4 gv[2][2];
#pragma unroll
        for (int bj = 0; bj < 2; ++bj)
#pragma unroll
            for (int n = 0; n < 2; ++n) gv[bj][n] = *(const f32x4*)(mod + (size_t)b * NMODC + 2048 + col0 + bj * HALF + n * 16);
#pragma unroll
        for (int ai = 0; ai < 2; ++ai)
#pragma unroll
            for (int m = 0; m < 4; ++m) { const size_t off = (size_t)(row0 + ai * HALF + m * 16) * DM + col0;
#pragma unroll
                for (int bj = 0; bj < 2; ++bj)
#pragma unroll
                    for (int n = 0; n < 2; ++n) { const f32x4 xv = *(const f32x4*)(x + off + bj * HALF + n * 16);
                        const f32x4 r = xv + gv[bj][n] * acc[ai][bj][m][n];
                        u32x2 w; w.x = cvt_pk_bf16(r[0], r[1]); w.y = cvt_pk_bf16(r[2], r[3]);
                        *(u32x2*)(out + off + bj * HALF + n * 16) = w; } }
    }
};

__device__ __forceinline__ f32x4 mma16(bf16x8 a, bf16x8 b, f32x4 c) { return __builtin_amdgcn_mfma_f32_16x16x32_bf16(a, b, c, 0, 0, 0); }
__device__ __forceinline__ i32x4 mma16(bf16x8 a, bf16x8 b, i32x4 c) { return __builtin_amdgcn_mfma_i32_16x16x64_i8(__builtin_bit_cast(i32x4, a), __builtin_bit_cast(i32x4, b), c, 0, 0, 0); }
template <class Epi, bool I8 = false>
__device__ __forceinline__ void gemm_phase(LAS unsigned char* lds, const Gemm g, const StaticOrder& S, const Epi& E) {
    typedef typename std::conditional<I8, i32x4, f32x4>::type acc_t;
    const int tid = threadIdx.x, wid = __builtin_amdgcn_readfirstlane(tid >> 6), lane = tid & 63, wr = wid >> 2, wc = wid & 3, fr = lane & 15, fq = lane >> 4;
    const int K = g.K, nt = K / BK;
    unsigned voffA[2], voffB[2];
#pragma unroll
    for (int i = 0; i < 2; ++i) { int R, C; stage_rc(tid * 16 + i * 8192, R, C); const int Rb = Epi::PERM ? ((R & ~31) + perm32(R & 31)) : R;
        voffA[i] = (unsigned)(R * K + C) * 2u; voffB[i] = (unsigned)(Rb * K + C) * 2u; }
    const size_t kstep = (size_t)(BK * 2);
    const size_t hstep = (size_t)HALF * K * 2;
    const size_t tstep = 2 * hstep;
    const unsigned ldsw = (unsigned)wid * 1024u;
    const int aoff = lds_byte(wr * 64 + fr, fq * 8), boff = lds_byte(wc * 32 + fr, fq * 8);
#define PG8_SA(b, h) (((b) * 2 + (h)) * HTB)
#define PG8_SB(b, h) ((4 + (b) * 2 + (h)) * HTB)
#define PG8_STAGE(bufoff, gbase, voff) do { _Pragma("unroll") for (int _i = 0; _i < 2; ++_i) \
        __builtin_amdgcn_global_load_lds((const unsigned*)((const char*)(gbase) + (voff)[_i]), (LAS unsigned*)(lds + (bufoff) + ldsw + _i * 8192), 16, 0, 0); } while (0)
#define PG8_LDA(dst, b, h) do { _Pragma("unroll") for (int m = 0; m < 4; ++m) _Pragma("unroll") for (int k = 0; k < 2; ++k) dst[m][k] = *(const LAS bf16x8*)(lds + PG8_SA(b, h) + aoff + m * 2048 + k * 1024); } while (0)
#define PG8_LDB(dst, b, h) do { _Pragma("unroll") for (int n = 0; n < 2; ++n) _Pragma("unroll") for (int k = 0; k < 2; ++k) dst[n][k] = *(const LAS bf16x8*)(lds + PG8_SB(b, h) + boff + n * 2048 + k * 1024); } while (0)
#define PG8_MMA(ai, bj, At, Bt) do { __builtin_amdgcn_s_setprio(1); _Pragma("unroll") for (int m = 0; m < 4; ++m) _Pragma("unroll") for (int n = 0; n < 2; ++n) _Pragma("unroll") for (int k = 0; k < 2; ++k) \
        acc[ai][bj][m][n] = mma16(Bt[n][k], At[m][k], acc[ai][bj][m][n]); __builtin_amdgcn_s_setprio(0); } while (0)
#define PG8_WAIT_V(n) asm volatile("s_waitcnt vmcnt(" #n ")" ::: "memory")
#define PG8_WAIT_L(n) asm volatile("s_waitcnt lgkmcnt(" #n ")" ::: "memory")
#define PG8_BAR __builtin_amdgcn_s_barrier()
#define PG8_SCHED __builtin_amdgcn_sched_barrier(0)
    Unit cur, nxt; int ui = 0;
    if (!S.next(0, cur)) return;
    acc_t acc[2][2][4][2];
#pragma unroll
    for (int a = 0; a < 2; ++a)
#pragma unroll
        for (int b = 0; b < 2; ++b)
#pragma unroll
            for (int m = 0; m < 4; ++m)
#pragma unroll
                for (int n = 0; n < 2; ++n) acc[a][b][m][n] = (acc_t){0, 0, 0, 0};
    bf16x8 At[4][2], B0[2][2], B1[2][2];
    const char* cA = (const char*)g.A + (size_t)cur.pm * tstep; const char* cB = (const char*)g.Bt + (size_t)cur.pn * tstep;
    PG8_STAGE(PG8_SB(0, 0), cB, voffB); PG8_STAGE(PG8_SA(0, 0), cA, voffA); PG8_STAGE(PG8_SB(0, 1), cB + hstep, voffB); PG8_STAGE(PG8_SA(0, 1), cA + hstep, voffA);
    if (wr == 1) PG8_BAR;
    PG8_WAIT_V(4); PG8_BAR;
    PG8_STAGE(PG8_SB(1, 0), cB + kstep, voffB); PG8_STAGE(PG8_SA(1, 0), cA + kstep, voffA); PG8_STAGE(PG8_SB(1, 1), cB + hstep + kstep, voffB);
    PG8_WAIT_V(6); PG8_BAR;
    for (;;) {
        const bool has_next = S.next(ui + 1, nxt);
        const char* nA = has_next ? (const char*)g.A + (size_t)nxt.pm * tstep : cA; const char* nB = has_next ? (const char*)g.Bt + (size_t)nxt.pn * tstep : cB;
        for (int t = 0; t < nt; t += 2) {
            const bool last = (t == nt - 2);
            const char* a1 = cA + (size_t)(t + 1) * kstep;
            const char* a2 = last ? nA : cA + (size_t)(t + 2) * kstep; const char* b2 = last ? nB : cB + (size_t)(t + 2) * kstep;
            const char* a3 = a2 + kstep; const char* b3 = b2 + kstep;
            PG8_LDB(B0, 0, 0); PG8_SCHED; PG8_LDA(At, 0, 0); PG8_STAGE(PG8_SA(1, 1), a1 + hstep, voffA);
            PG8_WAIT_L(8); PG8_BAR; PG8_WAIT_L(0); PG8_MMA(0, 0, At, B0); PG8_BAR; PG8_SCHED;
            PG8_LDB(B1, 0, 1); PG8_STAGE(PG8_SB(0, 0), b2, voffB);
            PG8_BAR; PG8_WAIT_L(0); PG8_MMA(0, 1, At, B1); PG8_BAR;
            PG8_LDA(At, 0, 1); PG8_STAGE(PG8_SA(0, 0), a2, voffA);
            PG8_BAR; PG8_WAIT_L(0); PG8_MMA(1, 0, At, B0); PG8_BAR; PG8_SCHED;
            PG8_STAGE(PG8_SB(0, 1), b2 + hstep, voffB);
            PG8_WAIT_V(6); PG8_BAR; PG8_MMA(1, 1, At, B1); PG8_BAR;
            PG8_LDB(B0, 1, 0); PG8_SCHED; PG8_LDA(At, 1, 0); PG8_STAGE(PG8_SA(0, 1), a2 + hstep, voffA);
            PG8_WAIT_L(8); PG8_BAR; PG8_WAIT_L(0); PG8_MMA(0, 0, At, B0); PG8_BAR; PG8_SCHED;
            PG8_LDB(B1, 1, 1); PG8_STAGE(PG8_SB(1, 0), b3, voffB);
            PG8_BAR; PG8_WAIT_L(0); PG8_MMA(0, 1, At, B1); PG8_BAR;
            PG8_LDA(At, 1, 1); PG8_STAGE(PG8_SA(1, 0), a3, voffA);
            PG8_BAR; PG8_WAIT_L(0); PG8_MMA(1, 0, At, B0); PG8_BAR; PG8_SCHED;
            PG8_STAGE(PG8_SB(1, 1), b3 + hstep, voffB);
            PG8_WAIT_V(6); PG8_BAR; PG8_MMA(1, 1, At, B1); PG8_BAR;
        }
        E(acc, cur, wr, wc, fr, fq);
        if (!has_next) break;
#pragma unroll
        for (int a = 0; a < 2; ++a)
#pragma unroll
            for (int b = 0; b < 2; ++b)
#pragma unroll
                for (int m = 0; m < 4; ++m)
#pragma unroll
                    for (int n = 0; n < 2; ++n) acc[a][b][m][n] = (acc_t){0, 0, 0, 0};
        cur = nxt; cA = nA; cB = nB; ++ui;
    }
    PG8_WAIT_V(0);
    if (wr == 0) PG8_BAR;
    PG8_BAR;
#undef PG8_SA
#undef PG8_SB
#undef PG8_STAGE
#undef PG8_LDA
#undef PG8_LDB
#undef PG8_MMA
#undef PG8_WAIT_V
#undef PG8_WAIT_L
#undef PG8_BAR
#undef PG8_SCHED
}
}

__device__ __forceinline__ void transpose_item(const float* W, int ldw, int K, bf16_t* WT, LAS float* scr, int kb, int src_col0, int dst_row0, int lane) {
    const int k0 = 64 * kb;
#pragma unroll 8
    for (int i = 0; i < 32; ++i) { const int kk = 2 * i + (lane >> 5); scr[kk * 33 + (lane & 31)] = W[(size_t)(k0 + kk) * ldw + src_col0 + (lane & 31)]; }
    LDS_WAIT();
    const int c = lane & 7;
#pragma unroll
    for (int j = 0; j < 4; ++j) { const int n = (lane >> 3) + 8 * j; const LAS float* s = scr + (8 * c) * 33 + n;
        u32x4 o; o.x = pk2(s[0 * 33], s[1 * 33]); o.y = pk2(s[2 * 33], s[3 * 33]); o.z = pk2(s[4 * 33], s[5 * 33]); o.w = pk2(s[6 * 33], s[7 * 33]);
        *(u32x4*)(WT + (size_t)(dst_row0 + n) * K + k0 + 8 * c) = o; }
    LDS_WAIT();
}

__device__ __forceinline__ void transpose_item_q(const float* W, int ldw, int K, signed char* WT, LAS float* scr, int kb, int src_col0, int dst_row0, int lane, const float* scale) {
    const int k0 = 64 * kb;
#pragma unroll 8
    for (int i = 0; i < 32; ++i) { const int kk = 2 * i + (lane >> 5); scr[kk * 33 + (lane & 31)] = W[(size_t)(k0 + kk) * ldw + src_col0 + (lane & 31)]; }
    LDS_WAIT();
    const int c = lane & 7;
#pragma unroll
    for (int j = 0; j < 4; ++j) { const int n = (lane >> 3) + 8 * j; const LAS float* s = scr + (8 * c) * 33 + n;
        const float sc = scale[dst_row0 + n], inv = sc > 0.f ? 1.0f / sc : 0.f;
        u32x2 o;
        o.x = ((unsigned)(int)rintf(s[0 * 33] * inv) & 255u) | (((unsigned)(int)rintf(s[1 * 33] * inv) & 255u) << 8) | (((unsigned)(int)rintf(s[2 * 33] * inv) & 255u) << 16) | (((unsigned)(int)rintf(s[3 * 33] * inv) & 255u) << 24);
        o.y = ((unsigned)(int)rintf(s[4 * 33] * inv) & 255u) | (((unsigned)(int)rintf(s[5 * 33] * inv) & 255u) << 8) | (((unsigned)(int)rintf(s[6 * 33] * inv) & 255u) << 16) | (((unsigned)(int)rintf(s[7 * 33] * inv) & 255u) << 24);
        *(u32x2*)(WT + (size_t)(dst_row0 + n) * K + k0 + 8 * c) = o; }
    LDS_WAIT();
}

__device__ __forceinline__ void phase0(const Args& a, LAS unsigned char* lds) {
    const int tid = threadIdx.x, lane = tid & 63, wave = tid >> 6, G = gridDim.x;
    unsigned char* ws = a.ws;
    if (blockIdx.x == 0 && tid < 64) ((unsigned*)(ws + WS_BAR))[16 * tid] = 0u;
    if (blockIdx.x == 1) for (int i = tid; i < 3456; i += NTHR) ((unsigned*)(ws + WS_XB))[i] = 0u;
    {
        const float* c = a.in[1]; const float* w_ada = a.in[2]; const float* b_ada = a.in[3]; float* mod = (float*)(ws + WS_MOD);
        LAS float* sc = (LAS float*)lds;
        LAS float* red = (LAS float*)(lds + 32768);
        if ((int)blockIdx.x < 96) {
            for (int i = tid; i < 8192; i += NTHR) sc[i] = siluf(c[i]);
            __syncthreads();
            for (int item = blockIdx.x; item < 96; item += G) {
                const int n = item * 64 + lane; float acc[8];
#pragma unroll
                for (int b = 0; b < 8; ++b) acc[b] = 0.f;
                for (int k4 = 0; k4 < 32; ++k4) {
                    const int k = wave * 128 + k4 * 4;
                    float wv[4];
#pragma unroll
                    for (int j = 0; j < 4; ++j) wv[j] = w_ada[(size_t)(k + j) * NMODC + n];
#pragma unroll
                    for (int b = 0; b < 8; ++b) { const f32x4 s = *(const LAS f32x4*)(sc + b * 1024 + k);
                        acc[b] += s[0] * wv[0] + s[1] * wv[1] + s[2] * wv[2] + s[3] * wv[3]; }
                }
#pragma unroll
                for (int b = 0; b < 8; ++b) red[(wave * 8 + b) * 64 + lane] = acc[b];
                __syncthreads();
                { const int b = tid >> 6; float s = 0.f;
#pragma unroll
                  for (int w = 0; w < 8; ++w) s += red[(w * 8 + b) * 64 + lane];
                  mod[b * NMODC + n] = s + b_ada[n]; }
                __syncthreads();
            }
        }
        __syncthreads();
    }
    if ((int)blockIdx.x >= 96) {
        LAS float* red = (LAS float*)lds;
        for (int cb = (int)blockIdx.x - 96; cb < 104; cb += G - 96) {
            const bool isq = cb >= 56 && cb < 88, iso = cb >= 88; const int n = (iso ? cb - 88 : (isq ? cb - 56 : cb)) * 64 + lane;
            const float* W = iso ? a.in[13] : (isq ? a.in[15] : a.in[5]); const int ldw = iso ? 1024 : (isq ? 2048 : LDW_IN); const int col = (isq || iso) ? n : n + (n >= 2048 ? 8 : 0);
            float m = 0.f;
            for (int k = wave * 128; k < wave * 128 + 128; ++k) m = fmaxf(m, fabsf(W[(size_t)k * ldw + col]));
            red[wave * 64 + lane] = m;
            __syncthreads();
            if (wave == 0) {
#pragma unroll
                for (int w = 1; w < 8; ++w) m = fmaxf(m, red[w * 64 + lane]);
                ((float*)(ws + (iso ? WS_WOS : (isq ? WS_WQS : WS_WINS))))[n] = m * (1.0f / 127.0f);
            }
            __syncthreads();
        }
    }
    {
        const size_t gt = (size_t)blockIdx.x * NTHR + tid, NGT = (size_t)G * NTHR;
        float* wsm = (float*)(ws + WS_WSM);
        for (size_t i = gt; i < 8 * 1024; i += NGT) { const int j = (int)(i >> 10), k = (int)(i & 1023); wsm[i] = a.in[5][(size_t)k * LDW_IN + 2048 + j]; }
    }
}
__device__ __forceinline__ void phase0b(const Args& a, LAS unsigned char* lds) {
    const int tid = threadIdx.x, lane = tid & 63, wave = tid >> 6, G = gridDim.x;
    unsigned char* ws = a.ws;
    {
        const int gw = blockIdx.x * NWAVE + wave, NGW = G * NWAVE;
        LAS float* scr = (LAS float*)(lds + wave * 8704);
        bf16_t* win_t = (bf16_t*)(ws + WS_WIN_T);
        constexpr int I_IN = 16 * (NPROJ / 32);
        for (int it = gw; it < I_IN; it += NGW) {
            const int kb = it / (NPROJ / 32), nb = it % (NPROJ / 32), n0 = nb * 32; if (INPROJ_I8) transpose_item_q(a.in[5], LDW_IN, 1024, (signed char*)win_t, scr, kb, n0 + (n0 >= 2048 ? 8 : 0), n0, lane, (const float*)(ws + WS_WINS));
            else transpose_item(a.in[5], LDW_IN, 1024, win_t, scr, kb, n0 + (n0 >= 2048 ? 8 : 0), n0, lane);
        }
    }
    {
        const size_t gt = (size_t)blockIdx.x * NTHR + tid, NGT = (size_t)G * NTHR;
        const float* sk = a.in[16]; unsigned* o = (unsigned*)(ws + WS_SUBK);
        for (size_t i = gt; i < 16 * 128 * 128 / 2; i += NGT) o[i] = pk2(sk[2 * i], sk[2 * i + 1]);
    }
}

__device__ __forceinline__ void late_prep(const Args& a, LAS unsigned char* lds, int widx, int nw) {
    const int lane = threadIdx.x & 63, wave = threadIdx.x >> 6;
    unsigned char* ws = a.ws;
    {
        LAS float* scr = (LAS float*)(lds + wave * 8704);
        bf16_t* wout_t = (bf16_t*)(ws + WS_WOUT_T); bf16_t* wq_t = (bf16_t*)(ws + WS_WQ_T);
        constexpr int I_OUT = 16 * 32, I_Q = 16 * 64;
        for (int it = widx; it < I_OUT + I_Q; it += nw) {
            if (it < I_OUT) { const int kb = it / 32, nb = it % 32; transpose_item_q(a.in[13], 1024, 1024, (signed char*)wout_t, scr, kb, nb * 32, nb * 32, lane, (const float*)(ws + WS_WOS)); }
            else { const int r = it - I_OUT, kb = r / 64, nb = r % 64;
                if (QUERY_I8) transpose_item_q(a.in[15], 2048, 1024, (signed char*)wq_t, scr, kb, nb * 32, nb * 32, lane, (const float*)(ws + WS_WQS));
                else transpose_item(a.in[15], 2048, 1024, wq_t, scr, kb, nb * 32, nb * 32, lane); }
        }
    }
    {
        const int G = 0; (void)G;
        { const int gw = widx, NGW = nw;
          for (int row = gw; row < 2 * 16384; row += NGW) {
              const bool isv = row >= 16384; const int e = row & 16383;
              const f32x4* src = (const f32x4*)((isv ? a.in[18] : a.in[17]) + (size_t)e * 1024) + lane;
              f32x4 v[4]; float am = 0.f;
#pragma unroll
              for (int j = 0; j < 4; ++j) { v[j] = src[64 * j]; am = fmaxf(am, fmaxf(fmaxf(fabsf(v[j][0]), fabsf(v[j][1])), fmaxf(fabsf(v[j][2]), fabsf(v[j][3])))); }
              am = wave_max(am);
              const float inv = am > 0.f ? 127.0f / am : 0.f;
              unsigned char* dst = ws + (isv ? WS_VT : WS_UT);
#pragma unroll
              for (int j = 0; j < 4; ++j) {
                  const unsigned pk = ((unsigned)(int)rintf(v[j][0] * inv) & 255u) | (((unsigned)(int)rintf(v[j][1] * inv) & 255u) << 8) |
                                      (((unsigned)(int)rintf(v[j][2] * inv) & 255u) << 16) | (((unsigned)(int)rintf(v[j][3] * inv) & 255u) << 24);
                  const int sl = 2 * j + (lane >> 5);
                  *(unsigned*)(dst + ((size_t)sl * 16384 + e) * 128 + ((4 * lane) & 127)) = pk;
              }
              if (lane == 0) ((float*)(ws + (isv ? WS_VS : WS_US)))[e] = am * (1.0f / 127.0f);
          } }
    }
}

template <bool FIRST>
__device__ __forceinline__ void phase_norm(const Args& a, const float* src, const float* gain, int shift_off, int scale_off) {
    const bf16_t* srcb = (const bf16_t*)(a.ws + WS_X1B);
    constexpr int R = FIRST ? 2 : 4;
    const int wave = threadIdx.x >> 6;
    const int gw = blockIdx.x * NWAVE + wave, NGW = gridDim.x * NWAVE;
    const float* mod = (const float*)(a.ws + WS_MOD); const float* wsm = (const float*)(a.ws + WS_WSM);
    bf16_t* dst = (bf16_t*)(a.ws + WS_ACT); float* small = (float*)(a.ws + WS_SMALL);
    for (int tok0 = gw * R; tok0 < T_TOK; tok0 += NGW * R) {
        int lane = threadIdx.x & 63; asm volatile("" : "+v"(lane));
        f32x4 v[R][4]; float rstd[R];
#pragma unroll
        for (int q = 0; q < R; ++q)
#pragma unroll
            for (int j = 0; j < 4; ++j) {
                if (FIRST) v[q][j] = ((const f32x4*)(src + (size_t)(tok0 + q) * DM) + lane)[64 * j];
                else { const u32x2 w = ((const u32x2*)(srcb + (size_t)(tok0 + q) * DM) + lane)[64 * j]; v[q][j] = (f32x4){bf_lo(w.x), bf_hi(w.x), bf_lo(w.y), bf_hi(w.y)}; }
            }
#pragma unroll
        for (int q = 0; q < R; ++q) { float ss = 0.f;
#pragma unroll
            for (int j = 0; j < 4; ++j) ss += (v[q][j][0] * v[q][j][0] + v[q][j][1] * v[q][j][1]) + (v[q][j][2] * v[q][j][2] + v[q][j][3] * v[q][j][3]);
            rstd[q] = ss; }
#pragma unroll
        for (int q = 0; q < R; ++q) rstd[q] = rsqrtf(wave_sum(rstd[q]) * (1.0f / DM) + EPS);
        const float* mrow = mod + (size_t)(tok0 >> 12) * NMODC;
        float sa[R][8];
#pragma unroll
        for (int q = 0; q < R; ++q)
#pragma unroll
            for (int c = 0; c < 8; ++c) sa[q][c] = 0.f;
#pragma unroll
        for (int j = 0; j < 4; ++j) {
            const int d = 4 * lane + 256 * j;
            const f32x4 g = *(const f32x4*)(gain + d), sc = *(const f32x4*)(mrow + scale_off + d), sh = *(const f32x4*)(mrow + shift_off + d);
            const f32x4 gs = g * (1.0f + sc);
#pragma unroll
            for (int q = 0; q < R; ++q) {
                v[q][j] = v[q][j] * rstd[q] * gs + sh;
                if ((FIRST && !INPROJ_I8) || (!FIRST && !QUERY_I8)) { u32x2 o; o.x = pk2(v[q][j][0], v[q][j][1]); o.y = pk2(v[q][j][2], v[q][j][3]); *(u32x2*)(dst + (size_t)(tok0 + q) * DM + d) = o; }
            }
            if (FIRST) {
#pragma unroll
                for (int c = 0; c < 8; ++c) { const f32x4 w = *(const f32x4*)(wsm + c * 1024 + d);
#pragma unroll
                    for (int q = 0; q < R; ++q) sa[q][c] += (v[q][j][0] * w[0] + v[q][j][1] * w[1]) + (v[q][j][2] * w[2] + v[q][j][3] * w[3]); }
            }
            __builtin_amdgcn_sched_barrier(0);
        }
        if (!FIRST || INPROJ_I8) {
#pragma unroll
            for (int q = 0; q < R; ++q) {
                float am = 0.f;
#pragma unroll
                for (int j = 0; j < 4; ++j) am = fmaxf(am, fmaxf(fmaxf(fabsf(v[q][j][0]), fabsf(v[q][j][1])), fmaxf(fabsf(v[q][j][2]), fabsf(v[q][j][3]))));
                am = wave_max(am);
                const float inv = am > 0.f ? 127.0f / am : 0.f;
                unsigned* hq = (unsigned*)(a.ws + (FIRST ? WS_ACT : WS_HQ)) + (size_t)(tok0 + q) * 256;
#pragma unroll
                for (int j = 0; j < 4; ++j)
                    hq[lane + 64 * j] = ((unsigned)(int)rintf(v[q][j][0] * inv) & 255u) | (((unsigned)(int)rintf(v[q][j][1] * inv) & 255u) << 8) |
                                        (((unsigned)(int)rintf(v[q][j][2] * inv) & 255u) << 16) | (((unsigned)(int)rintf(v[q][j][3] * inv) & 255u) << 24);
                if (lane == 0) ((float*)(a.ws + (FIRST ? WS_H1S : WS_HS)))[tok0 + q] = am * (1.0f / 127.0f);
            }
        }
        if (FIRST) {
#pragma unroll
            for (int q = 0; q < R; ++q) {
                float ov = 0.f;
#pragma unroll
                for (int c = 0; c < 8; ++c) { const float s = wave_sum(sa[q][c]); if (lane == c) ov = s; }
                if (lane < 8) small[(size_t)(tok0 + q) * 8 + lane] = ov;
            }
        }
    }
}

typedef float f32x16 __attribute__((ext_vector_type(16)));
__device__ __forceinline__ unsigned cvt2(float lo, float hi) {
    typedef __bf16 bf2_t __attribute__((ext_vector_type(2)));
    bf2_t v; v[0] = (__bf16)lo; v[1] = (__bf16)hi; return __builtin_bit_cast(unsigned, v);
}
__device__ __forceinline__ int crow(int reg, int h) { return (reg & 3) + 8 * (reg >> 2) + 4 * h; }
constexpr int R_W = 0, R_QD = 16384, R_KDT = 32768, R_ATT = 49152, R_U = 57344;

template <int I> __device__ __forceinline__ void tsolve_row(float (&x)[32], const LAS float* Lb, int c) {
    float a0 = 0.f, a1 = 0.f, a2 = 0.f, a3 = 0.f;
#pragma unroll
    for (int j4 = 0; j4 < (I + 3) / 4; ++j4) {
        const f32x4 l = *(const LAS f32x4*)(Lb + I * 68 + 4 * j4);
        if (4 * j4 + 0 < I) a0 += l[0] * x[4 * j4 + 0];
        if (4 * j4 + 1 < I) a1 += l[1] * x[4 * j4 + 1];
        if (4 * j4 + 2 < I) a2 += l[2] * x[4 * j4 + 2];
        if (4 * j4 + 3 < I) a3 += l[3] * x[4 * j4 + 3];
    }
    x[I] = (I == c ? 1.0f : 0.0f) - ((a0 + a1) + (a2 + a3));
}
template <int... Is> __device__ __forceinline__ void tsolve_all(float (&x)[32], const LAS float* Lb, int c, std::integer_sequence<int, Is...>) {
    (tsolve_row<Is>(x, Lb, c), ...);
}
__device__ __forceinline__ bf16x8 lda_split(const LAS unsigned char* p) {
    const u32x2 lo = *(const LAS u32x2*)p, hi = *(const LAS u32x2*)(p + 16);
    u32x4 v; v.x = lo.x; v.y = lo.y; v.z = hi.x; v.w = hi.y; return __builtin_bit_cast(bf16x8, v);
}
__device__ __forceinline__ bf16x8 pack8(const f32x16& x, int s) {
    u32x4 v; v.x = cvt2(x[8 * s], x[8 * s + 1]); v.y = cvt2(x[8 * s + 2], x[8 * s + 3]); v.z = cvt2(x[8 * s + 4], x[8 * s + 5]); v.w = cvt2(x[8 * s + 6], x[8 * s + 7]);
    return __builtin_bit_cast(bf16x8, v);
}

#ifndef DNP_DUP
#define DNP_DUP 0
#endif
#define DNP_REP(k) _Pragma("nounroll") for (int drep_ = 0; drep_ < 1 + ((DNP_DUP >> (k)) & 1); ++drep_)
constexpr int DNL_KBT = 98304, DNL_VBT = 116736, DNL_T = 135168, DNL_T11T = 144384;
__device__ __forceinline__ void dn_prep(const Args& a, LAS unsigned char* lds) {
    const bf16_t* proj = (const bf16_t*)(a.ws + WS_PROJ); const float* small = (const float*)(a.ws + WS_SMALL);
    const float* convw = a.in[6];
    LAS float* qs = (LAS float*)lds;
    LAS float* ks = (LAS float*)(lds + 32768);
    LAS float* vs = (LAS float*)(lds + 65536);
    LAS unsigned char* q16 = lds + 98304;
    LAS unsigned char* k16 = lds + 115712;
    LAS unsigned char* kb16 = lds + 133120;
    LAS float* sbeta = (LAS float*)(lds + 150528);
    LAS float* sG = sbeta + 64;
    LAS float* seG = sG + 64;
    LAS float* sbg = seG + 64;
    LAS float* Lm = (LAS float*)lds;
    float* gls = (float*)(a.ws + WS_GLS);
    u32x2 rawn[19];
    float bln = 0.f, dln = 0.f;
    f32x4 w[4]; int whd = -1;
    {
        const int tid0 = threadIdx.x, ci0 = blockIdx.x;
        if (tid0 < 384 && ci0 < 2048) {
            const int cgp = tid0 % 96, seg = tid0 / 96, which = cgp >> 5, c4 = (cgp & 31) * 4, col = which * 512 + ((ci0 >> 6) & 3) * 128 + c4;
#pragma unroll
            for (int r = 0; r < 19; ++r) { const int sp = (ci0 & 63) * 64 + 16 * seg - 3 + r;
                rawn[r] = *(const u32x2*)(proj + ((size_t)(ci0 >> 8) * SEQ + (sp < 0 ? 0 : sp)) * NPROJ + col); }
        }
        if (tid0 >= 448 && ci0 < 2048) { const size_t tk = (size_t)(ci0 >> 8) * SEQ + (ci0 & 63) * 64 + (tid0 - 448); bln = small[tk * 8 + ((ci0 >> 6) & 3)]; dln = small[tk * 8 + 4 + ((ci0 >> 6) & 3)]; }
#pragma unroll
        for (int j = 0; j < 4; ++j) w[j] = (f32x4){0.f, 0.f, 0.f, 0.f};
    }
    for (int ci = blockIdx.x; ci < 2048; ci += gridDim.x) {
        int tid = threadIdx.x; asm volatile("" : "+v"(tid));
        const int lane = tid & 63, wave = tid >> 6;
        const int b = ci >> 8, hd = (ci >> 6) & 3, n = ci & 63, s0 = n * 64; const size_t tok0 = (size_t)b * SEQ + s0;
        unsigned char* rec = a.ws + WS_DN + (size_t)ci * DN_REC;
        if (hd != whd) { whd = hd;
            if (tid < 384) { const int cgp = tid % 96, which = cgp >> 5, c4 = (cgp & 31) * 4, col = which * 512 + hd * 128 + c4;
#pragma unroll
                for (int j = 0; j < 4; ++j) w[j] = *(const f32x4*)(convw + j * 1536 + col); } }
        const float bl = bln, dl = dln;
        DNP_REP(0) if (tid < 384) {
            const int cgp = tid % 96, seg = tid / 96, which = cgp >> 5, c4 = (cgp & 31) * 4;
            u32x2 raw[19];
#pragma unroll
            for (int r = 0; r < 19; ++r) {
                const int sp = s0 + 16 * seg - 3 + r;
                raw[r] = (sp >= 0) ? rawn[r] : (u32x2){0u, 0u};
            }
            LAS float* dstp = (which == 0 ? qs : (which == 1 ? ks : vs)) + (16 * seg) * 128 + c4;
#pragma unroll
            for (int i = 0; i < 16; ++i) {
                f32x4 y = (f32x4){0.f, 0.f, 0.f, 0.f};
#pragma unroll
                for (int j = 0; j < 4; ++j) { const u32x2 u = raw[i + j];
                    y[0] += w[j][0] * bf_lo(u.x); y[1] += w[j][1] * bf_hi(u.x); y[2] += w[j][2] * bf_lo(u.y); y[3] += w[j][3] * bf_hi(u.y); }
                f32x4 r; r[0] = siluf(y[0]); r[1] = siluf(y[1]); r[2] = siluf(y[2]); r[3] = siluf(y[3]);
                *(LAS f32x4*)(dstp + i * 128) = r;
            }
        }
        if (wave == 7) {
            const float Aexp = __expf(a.in[7][hd]), dtb = a.in[8][hd];
            const float dlb = dl + dtb;
            const float sp = fmaxf(dlb, 0.f) + log1pf(expf(-fabsf(dlb)));
            float Gc = -Aexp * sp;
#pragma unroll
            for (int o = 1; o < 64; o <<= 1) { const float t = __shfl_up(Gc, o); if (lane >= o) Gc += t; }
            const float bt = 1.0f / (1.0f + expf(-bl)), eg = expf(Gc);
            sbeta[lane] = bt; sG[lane] = Gc; seG[lane] = eg; sbg[lane] = bt * eg;
        }
        __syncthreads();
        {
            const int cn = ci + (int)gridDim.x;
            if (tid < 384 && cn < 2048) {
                const int cgp = tid % 96, seg = tid / 96, which = cgp >> 5, c4 = (cgp & 31) * 4, col = which * 512 + ((cn >> 6) & 3) * 128 + c4;
#pragma unroll
                for (int r = 0; r < 19; ++r) { const int sp = (cn & 63) * 64 + 16 * seg - 3 + r;
                    rawn[r] = *(const u32x2*)(proj + ((size_t)(cn >> 8) * SEQ + (sp < 0 ? 0 : sp)) * NPROJ + col); }
            }
            if (tid >= 448 && cn < 2048) { const size_t tk = (size_t)(cn >> 8) * SEQ + (cn & 63) * 64 + (tid - 448); bln = small[tk * 8 + ((cn >> 6) & 3)]; dln = small[tk * 8 + 4 + ((cn >> 6) & 3)]; }
        }
        {
            const bool isk = wave >= 4;
            LAS float* pb = (isk ? ks : qs) + ((wave & 3) * 16) * 128 + 2 * lane;
#pragma unroll
            for (int r4 = 0; r4 < 4; ++r4) {
                f32x2 v[4]; float ss[4];
#pragma unroll
                for (int q = 0; q < 4; ++q) { v[q] = *(LAS f32x2*)(pb + (r4 * 4 + q) * 128); ss[q] = v[q][0] * v[q][0] + v[q][1] * v[q][1]; }
#pragma unroll
                for (int q = 0; q < 4; ++q) ss[q] = wave_sum(ss[q]);
#pragma unroll
                for (int q = 0; q < 4; ++q) { const float sc = rsqrtf(ss[q] + EPS) * (isk ? 1.0f : 0.08838834764831845f);
                    v[q][0] *= sc; v[q][1] *= sc; *(LAS f32x2*)(pb + (r4 * 4 + q) * 128) = v[q]; }
            }
        }
        __syncthreads();
        DNP_REP(1) for (int idx = tid; idx < 1024; idx += NTHR) {
            const int i = idx >> 4, d0 = (idx & 15) * 8; const float bt = sbeta[i], eg = seG[i];
            const f32x4 q0 = *(const LAS f32x4*)(qs + i * 128 + d0), q1 = *(const LAS f32x4*)(qs + i * 128 + d0 + 4);
            const f32x4 k0 = *(const LAS f32x4*)(ks + i * 128 + d0), k1 = *(const LAS f32x4*)(ks + i * 128 + d0 + 4);
            u32x4 o;
            o.x = cvt2(q0[0], q0[1]); o.y = cvt2(q0[2], q0[3]); o.z = cvt2(q1[0], q1[1]); o.w = cvt2(q1[2], q1[3]); *(LAS u32x4*)(q16 + i * 272 + d0 * 2) = o;
            o.x = cvt2(k0[0], k0[1]); o.y = cvt2(k0[2], k0[3]); o.z = cvt2(k1[0], k1[1]); o.w = cvt2(k1[2], k1[3]); *(LAS u32x4*)(k16 + i * 272 + d0 * 2) = o;
            o.x = cvt2(k0[0] * bt, k0[1] * bt); o.y = cvt2(k0[2] * bt, k0[3] * bt); o.z = cvt2(k1[0] * bt, k1[1] * bt); o.w = cvt2(k1[2] * bt, k1[3] * bt); *(LAS u32x4*)(kb16 + i * 272 + d0 * 2) = o;
            o.x = cvt2(q0[0] * eg, q0[1] * eg); o.y = cvt2(q0[2] * eg, q0[3] * eg); o.z = cvt2(q1[0] * eg, q1[1] * eg); o.w = cvt2(q1[2] * eg, q1[3] * eg);
            *(u32x4*)(rec + R_QD + (i * 128 + d0) * 2) = o;
        }
        DNP_REP(1) for (int idx = tid; idx < 1024; idx += NTHR) {
            const int d = idx & 127, i0 = (idx >> 7) * 8; const float G63 = sG[63];
            float v[8];
#pragma unroll
            for (int jj = 0; jj < 8; ++jj) v[jj] = ks[(i0 + jj) * 128 + d] * __expf(G63 - sG[i0 + jj]);
            u32x4 o; o.x = cvt2(v[0], v[1]); o.y = cvt2(v[2], v[3]); o.z = cvt2(v[4], v[5]); o.w = cvt2(v[6], v[7]);
            *(u32x4*)(rec + R_KDT + (d * 64 + i0) * 2) = o;
        }
        if (tid == 0) gls[ci] = seG[63];
        __syncthreads();
        DNP_REP(2) {
            const int which = wave >> 2, mt = (wave >> 1) & 1, nt = wave & 1, r32 = lane & 31, h = lane >> 5;
            const LAS unsigned char* Ab = (which ? q16 : kb16) + (32 * mt + r32) * 272 + h * 16;
            const LAS unsigned char* Bb = k16 + (32 * nt + r32) * 272 + h * 16;
            f32x16 acc;
#pragma unroll
            for (int r = 0; r < 16; ++r) acc[r] = 0.f;
#pragma unroll
            for (int kk = 0; kk < 8; ++kk) {
                const bf16x8 av = *(const LAS bf16x8*)(Ab + kk * 32), bv = *(const LAS bf16x8*)(Bb + kk * 32);
                acc = __builtin_amdgcn_mfma_f32_32x32x16_bf16(av, bv, acc, 0, 0, 0);
            }
            const int j = 32 * nt + r32; const float Gj = sG[j];
#pragma unroll
            for (int r = 0; r < 16; ++r) {
                const int i = 32 * mt + crow(r, h);
                const float val = acc[r] * __expf(sG[i] - Gj);
                if (which == 0) Lm[i * 68 + j] = (i > j) ? val : 0.f;
                else *(bf16_t*)(rec + R_ATT + (i * 64 + j) * 2) = (bf16_t)((i >= j) ? f2bf(val) : 0u);
            }
        }
        __syncthreads();
        const int n32 = lane & 31, h32 = lane >> 5;
        DNP_REP(3) {
        if (wave == 0) {
            int ln = lane; asm volatile("" : "+v"(ln));
            const int r = ln >> 5, c = ln & 31;
            float x[32];
            tsolve_all(x, Lm + (32 * r) * 68 + 32 * r, c, std::make_integer_sequence<int, 32>{});
            if (r == 0) {
#pragma unroll
                for (int q = 0; q < 4; ++q) { u32x4 o; o.x = cvt2(x[8 * q], x[8 * q + 1]); o.y = cvt2(x[8 * q + 2], x[8 * q + 3]); o.z = cvt2(x[8 * q + 4], x[8 * q + 5]); o.w = cvt2(x[8 * q + 6], x[8 * q + 7]);
                    *(LAS u32x4*)(lds + DNL_T11T + c * 80 + q * 16) = o; }
            }
            LAS bf16_t* Tp = (LAS bf16_t*)(lds + DNL_T) + (32 * r) * 72 + 32 * r + c;
#pragma unroll
            for (int i = 0; i < 32; ++i) Tp[i * 72] = (bf16_t)f2bf(x[i]);
            asm volatile("s_waitcnt lgkmcnt(0)" ::: "memory"); __builtin_amdgcn_wave_barrier();
            const int m = ln & 31, h = ln >> 5;
            f32x16 ax, a2;
#pragma unroll
            for (int q = 0; q < 16; ++q) { ax[q] = 0.f; a2[q] = 0.f; }
#pragma unroll
            for (int s = 0; s < 2; ++s) {
                const f32x4 l0 = *(const LAS f32x4*)(Lm + (32 + m) * 68 + 16 * s + 8 * h), l1 = *(const LAS f32x4*)(Lm + (32 + m) * 68 + 16 * s + 8 * h + 4);
                u32x4 av; av.x = cvt2(l0[0], l0[1]); av.y = cvt2(l0[2], l0[3]); av.z = cvt2(l1[0], l1[1]); av.w = cvt2(l1[2], l1[3]);
                const bf16x8 bv = *(const LAS bf16x8*)(lds + DNL_T11T + m * 80 + (16 * s + 8 * h) * 2);
                ax = __builtin_amdgcn_mfma_f32_32x32x16_bf16(__builtin_bit_cast(bf16x8, av), bv, ax, 0, 0, 0);
            }
#pragma unroll
            for (int s = 0; s < 2; ++s)
                a2 = __builtin_amdgcn_mfma_f32_32x32x16_bf16(lda_split(lds + DNL_T + (32 + m) * 144 + (32 + 16 * s + 4 * h) * 2), pack8(ax, s), a2, 0, 0, 0);
            LAS bf16_t* T21 = (LAS bf16_t*)(lds + DNL_T) + 32 * 72 + m;
#pragma unroll
            for (int q = 0; q < 16; ++q) T21[crow(q, h) * 72] = (bf16_t)f2bf(-a2[q]);
        } else {
            for (int idx = tid - 64; idx < 2048; idx += NTHR - 64) {
                const int c = idx & 127, jr = (idx >> 7) & 7, wh = idx >> 10;
                const LAS float* sp_ = (wh ? vs : ks) + c; const LAS float* sc = (wh ? sbeta : sbg) + 8 * jr;
                float v[8];
#pragma unroll
                for (int jj = 0; jj < 8; ++jj) v[jj] = sp_[(8 * jr + jj) * 128] * sc[jj];
                u32x4 o; o.x = cvt2(v[0], v[1]); o.y = cvt2(v[2], v[3]); o.z = cvt2(v[4], v[5]); o.w = cvt2(v[6], v[7]);
                *(LAS u32x4*)(lds + (wh ? DNL_VBT : DNL_KBT) + c * 144 + jr * 16) = o;
            }
        }
        }
        __syncthreads();
        {
            const bool isw = wave < 4;
            const LAS unsigned char* Bt = lds + (isw ? DNL_KBT : DNL_VBT) + (32 * (wave & 3) + n32) * 144 + h32 * 16;
            const LAS unsigned char* Ta = lds + DNL_T + n32 * 144 + h32 * 16;
            bf16x8 bv[4], t0[2], t1[4];
#pragma unroll
            for (int s = 0; s < 4; ++s) { bv[s] = *(const LAS bf16x8*)(Bt + s * 32); t1[s] = *(const LAS bf16x8*)(Ta + 32 * 144 + s * 32); }
#pragma unroll
            for (int s = 0; s < 2; ++s) t0[s] = *(const LAS bf16x8*)(Ta + s * 32);
            f32x16 c0, c1;
#pragma unroll
            for (int q = 0; q < 16; ++q) { c0[q] = 0.f; c1[q] = 0.f; }
            if (isw) {
#pragma unroll
                for (int s = 0; s < 2; ++s) c0 = __builtin_amdgcn_mfma_f32_32x32x16_bf16(bv[s], t0[s], c0, 0, 0, 0);
#pragma unroll
                for (int s = 0; s < 4; ++s) c1 = __builtin_amdgcn_mfma_f32_32x32x16_bf16(bv[s], t1[s], c1, 0, 0, 0);
                unsigned char* dst = rec + R_W + (size_t)(wave * 4096 + lane * 16);
                *(u32x4*)dst = __builtin_bit_cast(u32x4, pack8(c0, 0)); *(u32x4*)(dst + 1024) = __builtin_bit_cast(u32x4, pack8(c0, 1));
                *(u32x4*)(dst + 2048) = __builtin_bit_cast(u32x4, pack8(c1, 0)); *(u32x4*)(dst + 3072) = __builtin_bit_cast(u32x4, pack8(c1, 1));
            } else {
#pragma unroll
                for (int s = 0; s < 2; ++s) c0 = __builtin_amdgcn_mfma_f32_32x32x16_bf16(t0[s], bv[s], c0, 0, 0, 0);
#pragma unroll
                for (int s = 0; s < 4; ++s) c1 = __builtin_amdgcn_mfma_f32_32x32x16_bf16(t1[s], bv[s], c1, 0, 0, 0);
                unsigned char* dst = rec + R_U + (size_t)(((wave - 4) * 64 + lane) * 64);
                *(u32x4*)dst = __builtin_bit_cast(u32x4, pack8(c0, 0)); *(u32x4*)(dst + 16) = __builtin_bit_cast(u32x4, pack8(c0, 1));
                *(u32x4*)(dst + 32) = __builtin_bit_cast(u32x4, pack8(c1, 0)); *(u32x4*)(dst + 48) = __builtin_bit_cast(u32x4, pack8(c1, 1));
            }
        }
    }
    __syncthreads();
}

constexpr int DNB_W = 0, DNB_QD = 16896, DNB_KDT = 33792, DNB_ATT = 51200, DNB_U = 59904  , DNB_GL = 80384, DNB_SZ = 80400;
__device__ __forceinline__ void dn_issue_chunk(const unsigned char* rec, const float* glp, u32x4 (&v)[18], float& gl, int tl) {
    asm volatile("" : "+v"(tl));
#pragma unroll
    for (int i = 0; i < 18; ++i) v[i] = *(const u32x4*)(rec + (size_t)(tl + 256 * i) * 16);
    gl = *glp;
}
__device__ __forceinline__ void dn_write_chunk(const u32x4 (&v)[18], float gl, LAS unsigned char* buf, int tl) {
    asm volatile("" : "+v"(tl));
#pragma unroll
    for (int i = 0; i < 18; ++i) {
        const int q = tl + 256 * i;
        LAS unsigned char* d;
        if (i < 4) d = buf + DNB_W + q * 16;
        else if (i < 8) d = buf + DNB_QD + ((q - 1024) >> 4) * 264 + (q & 15) * 16;
        else if (i < 12) d = buf + DNB_KDT + ((q - 2048) >> 3) * 136 + (q & 7) * 16;
        else if (i < 14) d = buf + DNB_ATT + ((q - 3072) >> 3) * 136 + (q & 7) * 16;
        else d = buf + DNB_U + ((q - 3584) >> 2) * 80 + (q & 3) * 16;
        u32x2 lo, hi; lo.x = v[i].x; lo.y = v[i].y; hi.x = v[i].z; hi.y = v[i].w;
        *(LAS u32x2*)d = lo; *(LAS u32x2*)(d + 8) = hi;
    }
    if (tl == 0) *(LAS float*)(buf + DNB_GL) = gl;
}
__device__ __forceinline__ void dn_gate_norm(const Args& a) {
    const int lane = threadIdx.x & 63, wave = threadIdx.x >> 6;
    const int gw = blockIdx.x * NWAVE + wave, NGW = gridDim.x * NWAVE;
    const bf16_t* oraw = (const bf16_t*)a.out; const bf16_t* proj = (const bf16_t*)(a.ws + WS_PROJ); const bf16_t* mixed = (const bf16_t*)(a.ws + WS_ACT); const float* ogain = a.in[9];
    unsigned char* mq = a.ws + WS_MQ; float* ms = (float*)(a.ws + WS_MS);
    const f32x4 g0 = *(const f32x4*)(ogain + (lane & 15) * 8), g1 = *(const f32x4*)(ogain + (lane & 15) * 8 + 4);
    for (int tok0 = gw * 2; tok0 < T_TOK; tok0 += NGW * 2) {
        u32x4 ov[2], zv[2], sv[2];
#pragma unroll
        for (int q = 0; q < 2; ++q) { const size_t tok = (size_t)(tok0 + q);
            ov[q] = *(const u32x4*)(oraw + tok * 512 + lane * 8); zv[q] = *(const u32x4*)(proj + tok * NPROJ + 1536 + lane * 8); sv[q] = *(const u32x4*)(mixed + tok * DM + 512 + lane * 8); }
#pragma unroll
        for (int q = 0; q < 2; ++q) {
            float o[8], z[8], s[8];
#pragma unroll
            for (int c = 0; c < 4; ++c) { o[2 * c] = bf_lo(ov[q][c]); o[2 * c + 1] = bf_hi(ov[q][c]); z[2 * c] = bf_lo(zv[q][c]); z[2 * c + 1] = bf_hi(zv[q][c]); s[2 * c] = bf_lo(sv[q][c]); s[2 * c + 1] = bf_hi(sv[q][c]); }
            float ss = 0.f;
#pragma unroll
            for (int c = 0; c < 8; ++c) ss += o[c] * o[c];
            ss += dpp_<0xB1>(ss); ss += dpp_<0x4E>(ss); ss += dpp_<0x141>(ss); ss += dpp_<0x140>(ss);
            const float r = rsqrtf(ss * (1.0f / 128.0f) + EPS);
            float am = 0.f;
#pragma unroll
            for (int c = 0; c < 8; ++c) { o[c] = o[c] * r * (c < 4 ? g0[c] : g1[c - 4]) * siluf(z[c]); am = fmaxf(am, fmaxf(fabsf(o[c]), fabsf(s[c]))); }
            am = wave_max(am);
            const float inv = am > 0.f ? 127.0f / am : 0.f;
            u32x2 od, os;
            od.x = ((unsigned)(int)rintf(o[0] * inv) & 255u) | (((unsigned)(int)rintf(o[1] * inv) & 255u) << 8) | (((unsigned)(int)rintf(o[2] * inv) & 255u) << 16) | (((unsigned)(int)rintf(o[3] * inv) & 255u) << 24);
            od.y = ((unsigned)(int)rintf(o[4] * inv) & 255u) | (((unsigned)(int)rintf(o[5] * inv) & 255u) << 8) | (((unsigned)(int)rintf(o[6] * inv) & 255u) << 16) | (((unsigned)(int)rintf(o[7] * inv) & 255u) << 24);
            os.x = ((unsigned)(int)rintf(s[0] * inv) & 255u) | (((unsigned)(int)rintf(s[1] * inv) & 255u) << 8) | (((unsigned)(int)rintf(s[2] * inv) & 255u) << 16) | (((unsigned)(int)rintf(s[3] * inv) & 255u) << 24);
            os.y = ((unsigned)(int)rintf(s[4] * inv) & 255u) | (((unsigned)(int)rintf(s[5] * inv) & 255u) << 8) | (((unsigned)(int)rintf(s[6] * inv) & 255u) << 16) | (((unsigned)(int)rintf(s[7] * inv) & 255u) << 24);
            const size_t tok = (size_t)(tok0 + q);
            *(u32x2*)(mq + tok * 1024 + lane * 8) = od; *(u32x2*)(mq + tok * 1024 + 512 + lane * 8) = os;
            if (lane == 0) ms[tok] = am * (1.0f / 127.0f);
        }
    }
}
__device__ __forceinline__ void dn_scan2(const Args& a, LAS unsigned char* lds) {
    const int tid = threadIdx.x, lane = tid & 63, wave = __builtin_amdgcn_readfirstlane(tid >> 6);
    const int bh = blockIdx.x >> 1, dvh = blockIdx.x & 1, b = bh >> 2, hd = bh & 3;
    const unsigned char* recs = a.ws + WS_DN + (size_t)bh * 64 * DN_REC;
    const float* gls = (const float*)(a.ws + WS_GLS) + bh * 64;
    bf16_t* oraw = (bf16_t*)a.out;
    if (wave >= 4) {
        u32x4 pv[18]; float pgl;
        dn_issue_chunk(recs, gls, pv, pgl, tid - 256); dn_write_chunk(pv, pgl, lds, tid - 256); dn_issue_chunk(recs + DN_REC, gls + 1, pv, pgl, tid - 256);
        __syncthreads();
        for (int n = 0; n < 64; ++n) {
            if (n + 1 < 64) dn_write_chunk(pv, pgl, lds + ((n + 1) & 1) * DNB_SZ, tid - 256);
            if (n + 2 < 64) dn_issue_chunk(recs + (size_t)(n + 2) * DN_REC, gls + n + 2, pv, pgl, tid - 256);
            __syncthreads();
        }
        return;
    }
    if (wave >= 2) {
        __syncthreads();
        for (int n = 0; n < 64; ++n) __syncthreads();
        return;
    }
    const int cw = dvh * 2 + wave;
    f32x16 S[4]; bf16x8 BS[8];
#pragma unroll
    for (int kt = 0; kt < 4; ++kt)
#pragma unroll
        for (int r = 0; r < 16; ++r) S[kt][r] = 0.f;
#pragma unroll
    for (int ks = 0; ks < 8; ++ks) BS[ks] = (bf16x8){0, 0, 0, 0, 0, 0, 0, 0};
    __syncthreads();
    for (int n = 0; n < 64; ++n) {
        {
            int lane_o = lane; asm volatile("" : "+v"(lane_o));
            const int r32 = lane_o & 31, h = lane_o >> 5;
            const LAS unsigned char* B0 = lds + (n & 1) * DNB_SZ;
            const float gl = *(const LAS float*)(B0 + DNB_GL);
            const int koff = 8 * h;
            bf16x8 BV[4];
            {
                bf16x8 fa[16];
#pragma unroll
                for (int ks = 0; ks < 8; ++ks) { fa[2 * ks] = *(const LAS bf16x8*)(B0 + DNB_W + ((ks >> 1) * 4 + (ks & 1)) * 1024 + lane_o * 16); fa[2 * ks + 1] = *(const LAS bf16x8*)(B0 + DNB_W + ((ks >> 1) * 4 + 2 + (ks & 1)) * 1024 + lane_o * 16); }
                const LAS unsigned char* up = B0 + DNB_U + (cw * 64 + lane_o) * 80;
                u32x4 uq[4];
#pragma unroll
                for (int c = 0; c < 4; ++c) uq[c] = *(const LAS u32x4*)(up + c * 16);
                __builtin_amdgcn_sched_barrier(0);
                f32x16 X0, X1;
#pragma unroll
                for (int r = 0; r < 16; ++r) { X0[r] = 0.f; X1[r] = 0.f; }
#pragma unroll
                for (int ks = 0; ks < 8; ++ks) {
                    X0 = __builtin_amdgcn_mfma_f32_32x32x16_bf16(fa[2 * ks], BS[ks], X0, 0, 0, 0);
                    X1 = __builtin_amdgcn_mfma_f32_32x32x16_bf16(fa[2 * ks + 1], BS[ks], X1, 0, 0, 0);
                }
#pragma unroll
                for (int r = 0; r < 16; ++r) { const unsigned w0 = uq[r >> 3][(r >> 1) & 3], w1 = uq[2 + (r >> 3)][(r >> 1) & 3];
                    X0[r] = ((r & 1) ? bf_hi(w0) : bf_lo(w0)) - X0[r]; X1[r] = ((r & 1) ? bf_hi(w1) : bf_lo(w1)) - X1[r]; }
                BV[0] = pack8(X0, 0); BV[1] = pack8(X0, 1); BV[2] = pack8(X1, 0); BV[3] = pack8(X1, 1);
            }
            __builtin_amdgcn_sched_barrier(0);
            {
                bf16x8 fq[16], ft[8];
#pragma unroll
                for (int ks = 0; ks < 8; ++ks) { fq[2 * ks] = lda_split(B0 + DNB_QD + r32 * 264 + ks * 32 + koff); fq[2 * ks + 1] = lda_split(B0 + DNB_QD + (32 + r32) * 264 + ks * 32 + koff); }
                __builtin_amdgcn_sched_barrier(0);
                f32x16 O0, O1;
#pragma unroll
                for (int r = 0; r < 16; ++r) { O0[r] = 0.f; O1[r] = 0.f; }
#pragma unroll
                for (int ks = 0; ks < 4; ++ks) {
                    O0 = __builtin_amdgcn_mfma_f32_32x32x16_bf16(fq[2 * ks], BS[ks], O0, 0, 0, 0);
                    O1 = __builtin_amdgcn_mfma_f32_32x32x16_bf16(fq[2 * ks + 1], BS[ks], O1, 0, 0, 0);
                }
                __builtin_amdgcn_sched_barrier(0);
#pragma unroll
                for (int cs = 0; cs < 4; ++cs) { ft[2 * cs] = lda_split(B0 + DNB_ATT + r32 * 136 + cs * 32 + koff); ft[2 * cs + 1] = lda_split(B0 + DNB_ATT + (32 + r32) * 136 + cs * 32 + koff); }
                __builtin_amdgcn_sched_barrier(0);
#pragma unroll
                for (int ks = 4; ks < 8; ++ks) {
                    O0 = __builtin_amdgcn_mfma_f32_32x32x16_bf16(fq[2 * ks], BS[ks], O0, 0, 0, 0);
                    O1 = __builtin_amdgcn_mfma_f32_32x32x16_bf16(fq[2 * ks + 1], BS[ks], O1, 0, 0, 0);
                }
#pragma unroll
                for (int cs = 0; cs < 4; ++cs) {
                    O0 = __builtin_amdgcn_mfma_f32_32x32x16_bf16(ft[2 * cs], BV[cs], O0, 0, 0, 0);
                    O1 = __builtin_amdgcn_mfma_f32_32x32x16_bf16(ft[2 * cs + 1], BV[cs], O1, 0, 0, 0);
                }
                bf16_t* obu = oraw + ((size_t)b * SEQ + n * 64) * 512 + hd * 128 + 32 * cw;
                const unsigned lo = (unsigned)((4 * h) * 512 + r32);
#pragma unroll
                for (int r = 0; r < 16; ++r) { obu[lo + (unsigned)(((r & 3) + 8 * (r >> 2)) * 512)] = (bf16_t)f2bf(O0[r]); obu[lo + (unsigned)((32 + (r & 3) + 8 * (r >> 2)) * 512)] = (bf16_t)f2bf(O1[r]); }
            }
            __builtin_amdgcn_sched_barrier(0);
            {
                bf16x8 fk[16];
#pragma unroll
                for (int kt = 0; kt < 4; ++kt)
#pragma unroll
                    for (int cs = 0; cs < 4; ++cs) fk[kt * 4 + cs] = lda_split(B0 + DNB_KDT + (32 * kt + r32) * 136 + cs * 32 + koff);
#pragma unroll
                for (int kt = 0; kt < 4; ++kt)
#pragma unroll
                    for (int r = 0; r < 16; ++r) S[kt][r] *= gl;
                __builtin_amdgcn_sched_barrier(0);
#pragma unroll
                for (int cs = 0; cs < 4; ++cs)
#pragma unroll
                    for (int kt = 0; kt < 4; ++kt) S[kt] = __builtin_amdgcn_mfma_f32_32x32x16_bf16(fk[kt * 4 + cs], BV[cs], S[kt], 0, 0, 0);
            }
#pragma unroll
            for (int kt = 0; kt < 4; ++kt) { BS[2 * kt] = pack8(S[kt], 0); BS[2 * kt + 1] = pack8(S[kt], 1); }
        }
        __syncthreads();
    }
}

__device__ __forceinline__ void sb_prep(const Args& a) {
    const int lane = threadIdx.x & 63, wave = threadIdx.x >> 6;
    const int gw = blockIdx.x * NWAVE + wave, NGW = gridDim.x * NWAVE;
    bf16_t* proj = (bf16_t*)(a.ws + WS_PROJ);
    const float* gq = a.in[10]; const float* gk = a.in[11];
    {
        const int sub = lane & 7;
        float gsc[8];
#pragma unroll
        for (int j = 0; j < 8; ++j) gsc[j] = gq[sub * 8 + j] * gk[sub * 8 + j] * 0.125f;
        for (int r0 = gw * 8; r0 < T_TOK * 16; r0 += NGW * 8) {
            const int row = r0 + (lane >> 3); const int isk = row & 1, hd = (row >> 1) & 7; const size_t tok = (size_t)(row >> 4);
            u32x4* p = (u32x4*)(proj + tok * NPROJ + 2048 + isk * 512 + hd * 64 + sub * 8);
            const u32x4 w = *p;
            float ss = dot2(w.x, w.x, 0.f); ss = dot2(w.y, w.y, ss); ss = dot2(w.z, w.z, ss); ss = dot2(w.w, w.w, ss);
            ss += dppf<0xB1>(ss); ss += dppf<0x4E>(ss); ss += dppf<0x141>(ss);
            const float rs = rsqrtf(ss * (1.0f / 64.0f) + EPS);
            u32x4 o;
            if (isk) { o.x = pk2(bf_lo(w.x) * rs, bf_hi(w.x) * rs); o.y = pk2(bf_lo(w.y) * rs, bf_hi(w.y) * rs); o.z = pk2(bf_lo(w.z) * rs, bf_hi(w.z) * rs); o.w = pk2(bf_lo(w.w) * rs, bf_hi(w.w) * rs); }
            else { o.x = pk2(bf_lo(w.x) * rs * gsc[0], bf_hi(w.x) * rs * gsc[1]); o.y = pk2(bf_lo(w.y) * rs * gsc[2], bf_hi(w.y) * rs * gsc[3]);
                   o.z = pk2(bf_lo(w.z) * rs * gsc[4], bf_hi(w.z) * rs * gsc[5]); o.w = pk2(bf_lo(w.w) * rs * gsc[6], bf_hi(w.w) * rs * gsc[7]); }
            *p = o;
        }
    }
    {
        bf16_t* VT = (bf16_t*)((unsigned char*)a.out + VT_OFF);
        for (int item = gw; item < 64 * 64; item += NGW) {
            const int bh = item >> 6, kt = item & 63, b = bh >> 3, h = bh & 7;
            const u32x4* src = (const u32x4*)(proj + ((size_t)b * SEQ + kt * 64 + lane) * NPROJ + 3072 + h * 64);
            u32x4 v[8];
#pragma unroll
            for (int j = 0; j < 8; ++j) v[j] = src[j];
            bf16_t* dst = VT + ((size_t)bh * 64) * SEQ + kt * 64 + lane;
#pragma unroll
            for (int j = 0; j < 8; ++j)
#pragma unroll
                for (int c = 0; c < 4; ++c) { dst[(size_t)(j * 8 + 2 * c) * SEQ] = (bf16_t)(v[j][c] & 0xffffu); dst[(size_t)(j * 8 + 2 * c + 1) * SEQ] = (bf16_t)(v[j][c] >> 16); }
        }
    }
}

__device__ __forceinline__ void sb_attn(const Args& a, int wave_id, int n_waves) {
    const int lane = threadIdx.x & 63, r32 = lane & 31, hh = lane >> 5;
    const bf16_t* proj = (const bf16_t*)(a.ws + WS_PROJ); bf16_t* mixed = (bf16_t*)(a.ws + WS_ACT);
    const bf16_t* VT = (const bf16_t*)((const unsigned char*)a.out + VT_OFF);
    const float* go = a.in[12];
    const int krow_l = (r32 & 19) | ((r32 & 4) << 1) | ((r32 & 8) >> 1);
    for (int item = wave_id; item < 64 * 128; item += n_waves) {
        const int tile = 127 - (item >> 6), bh = item & 63, b = bh >> 3, h = bh & 7;
        const int t0 = tile * 32, t = t0 + r32; const size_t tokb = (size_t)b * SEQ;
        bf16x8 qf[4];
#pragma unroll
        for (int ks = 0; ks < 4; ++ks) qf[ks] = *(const bf16x8*)(proj + (tokb + t) * NPROJ + 2048 + h * 64 + 16 * ks + 8 * hh);
        f32x16 O0, O1;
#pragma unroll
        for (int r = 0; r < 16; ++r) { O0[r] = 0.f; O1[r] = 0.f; }
        float R = 0.f;
        const bf16_t* kbase = proj + (tokb + krow_l) * NPROJ + 2560 + h * 64 + 8 * hh;
        const bf16_t* vbase = VT + ((size_t)bh * 64 + r32) * SEQ + 8 * hh;
        for (int kb = tile; kb >= 0; --kb) {
            const int k0 = kb * 32;
            bf16x8 kf[4], vf[4];
#pragma unroll
            for (int ks = 0; ks < 4; ++ks) kf[ks] = *(const bf16x8*)(kbase + (size_t)k0 * NPROJ + 16 * ks);
#pragma unroll
            for (int mt = 0; mt < 2; ++mt)
#pragma unroll
                for (int s = 0; s < 2; ++s) vf[mt * 2 + s] = *(const bf16x8*)(vbase + (size_t)(32 * mt) * SEQ + k0 + 16 * s);
            f32x16 Z;
#pragma unroll
            for (int r = 0; r < 16; ++r) Z[r] = 0.f;
#pragma unroll
            for (int ks = 0; ks < 4; ++ks) Z = __builtin_amdgcn_mfma_f32_32x32x16_bf16(kf[ks], qf[ks], Z, 0, 0, 0);
            float l1[16], lb[16];
#pragma unroll
            for (int r = 0; r < 16; ++r) {
                const float z = Z[r];
                const float lp = __logf(1.0f + __expf(-fabsf(z)));
                const bool valid = (k0 + 16 * (r >> 3) + 8 * hh + (r & 7)) < t;
                l1[r] = valid ? -(fmaxf(z, 0.f) + lp) : 0.f;
                lb[r] = valid ? (fminf(z, 0.f) - lp) : -1.0e30f;
            }
            float sufA[8], sufB[8];
            sufA[7] = 0.f; sufB[7] = 0.f;
#pragma unroll
            for (int p = 6; p >= 0; --p) { sufA[p] = sufA[p + 1] + l1[p + 1]; sufB[p] = sufB[p + 1] + l1[8 + p + 1]; }
            const float sA = sufA[0] + l1[0], sB = sufB[0] + l1[8];
            const float pA = __shfl_xor(sA, 32), pB = __shfl_xor(sB, 32);
            const float aboveB = hh ? 0.f : pB;
            const float aboveA = hh ? (sB + pB) : (pB + sB + pA);
            const float RA = R + aboveA, RB = R + aboveB;
#pragma unroll
            for (int p = 0; p < 8; ++p) { Z[p] = __expf(lb[p] + RA + sufA[p]); Z[8 + p] = __expf(lb[8 + p] + RB + sufB[p]); }
            R += (sA + sB) + (pA + pB);
            const bf16x8 p0 = pack8(Z, 0), p1 = pack8(Z, 1);
            O0 = __builtin_amdgcn_mfma_f32_32x32x16_bf16(vf[0], p0, O0, 0, 0, 0);
            O0 = __builtin_amdgcn_mfma_f32_32x32x16_bf16(vf[1], p1, O0, 0, 0, 0);
            O1 = __builtin_amdgcn_mfma_f32_32x32x16_bf16(vf[2], p0, O1, 0, 0, 0);
            O1 = __builtin_amdgcn_mfma_f32_32x32x16_bf16(vf[3], p1, O1, 0, 0, 0);
            if (__all(R < -110.0f)) break;
        }
        float ss = 0.f;
#pragma unroll
        for (int r = 0; r < 16; ++r) ss += O0[r] * O0[r] + O1[r] * O1[r];
        ss += __shfl_xor(ss, 32);
        const float rn = rsqrtf(ss * (1.0f / 64.0f) + EPS);
        bf16_t* dst = mixed + (tokb + t) * DM + 512 + h * 64;
#pragma unroll
        for (int g = 0; g < 4; ++g) {
            const int d = 8 * g + 4 * hh;
            const f32x4 gv0 = *(const f32x4*)(go + d), gv1 = *(const f32x4*)(go + 32 + d);
            u32x2 w0, w1;
            w0.x = pk2(O0[4 * g] * rn * gv0[0], O0[4 * g + 1] * rn * gv0[1]); w0.y = pk2(O0[4 * g + 2] * rn * gv0[2], O0[4 * g + 3] * rn * gv0[3]);
            w1.x = pk2(O1[4 * g] * rn * gv1[0], O1[4 * g + 1] * rn * gv1[1]); w1.y = pk2(O1[4 * g + 2] * rn * gv1[2], O1[4 * g + 3] * rn * gv1[3]);
            *(u32x2*)(dst + d) = w0; *(u32x2*)(dst + 32 + d) = w1;
        }
    }
}

__device__ __forceinline__ void topk_insert(float (&L)[16], float x) {
#pragma unroll
    for (int i = 15; i >= 1; --i) L[i] = __builtin_amdgcn_fmed3f(L[i - 1], L[i], x);
    L[0] = fmaxf(L[0], x);
}
template <int I, int J> __device__ __forceinline__ void cand_ins(float (&M)[16], const float (&L0)[16], const float (&L1)[16]) {
    const float s = __uint_as_float(__float_as_uint(L0[I]) & ~127u) + __uint_as_float(__float_as_uint(L1[J]) & ~127u);
    topk_insert(M, __uint_as_float((__float_as_uint(s) & ~255u) | (unsigned)(I * 16 + J)));
}
template <int I, int... Js> __device__ __forceinline__ void cand_row(float (&M)[16], const float (&L0)[16], const float (&L1)[16], std::integer_sequence<int, Js...>) {
    (cand_ins<I, Js>(M, L0, L1), ...);
}
template <int... Is> __device__ __forceinline__ void cand_all(float (&M)[16], const float (&L0)[16], const float (&L1)[16], std::integer_sequence<int, Is...>) {
    (cand_row<Is>(M, L0, L1, std::make_integer_sequence<int, 16 / (Is + 1)>{}), ...);
}
__device__ __forceinline__ unsigned sel16(const float (&L)[16], int i) {
    unsigned r = __float_as_uint(L[0]);
#pragma unroll
    for (int k = 1; k < 16; ++k) { r = (i == k) ? __float_as_uint(L[k]) : r; asm volatile("" : "+v"(r)); }
    return r;
}
__device__ __forceinline__ void phase_scores(const Args& a, LAS unsigned char* lds, const pg8::StaticOrder& S) {
    const bf16_t* qp = (const bf16_t*)(a.ws + WS_QPEER); const bf16_t* kb = (const bf16_t*)(a.ws + WS_SUBK);
    unsigned* sel_e = (unsigned*)(a.ws + WS_SELE); float* sel_g = (float*)(a.ws + WS_SELG);
    pg8::Unit un;
    for (int ui = 0; S.next(ui, un); ++ui) {
        int tid = threadIdx.x; asm volatile("" : "+v"(tid));
        const int lane = tid & 63, wave = tid >> 6, r32 = lane & 31, hh = lane >> 5;
        const int h = un.pn, tile = un.pm;
        __syncthreads();
        for (int c = tid; c < 4096; c += NTHR) { const int r = c >> 4, cc = c & 15;
            *(LAS u32x4*)(lds + r * 272 + cc * 16) = *(const u32x4*)(kb + ((size_t)h * 256 + r) * 128 + cc * 8); }
        __syncthreads();
        const size_t tok = (size_t)tile * 256 + wave * 32 + r32;
        float L0[16], L1[16];
#pragma unroll
        for (int p = 0; p < 2; ++p) {
            bf16x8 bq[8];
#pragma unroll
            for (int ks = 0; ks < 8; ++ks) bq[ks] = *(const bf16x8*)(qp + tok * 2048 + (h * 2 + p) * 128 + 16 * ks + 8 * hh);
            float L[16];
#pragma unroll
            for (int i = 0; i < 16; ++i) L[i] = -3.0e38f;
#pragma unroll
            for (int kt = 0; kt < 4; ++kt) {
                f32x16 acc;
#pragma unroll
                for (int r = 0; r < 16; ++r) acc[r] = 0.f;
                const LAS unsigned char* Ab = lds + (p * 128 + 32 * kt + r32) * 272 + hh * 16;
#pragma unroll
                for (int ks = 0; ks < 8; ++ks) acc = __builtin_amdgcn_mfma_f32_32x32x16_bf16(*(const LAS bf16x8*)(Ab + ks * 32), bq[ks], acc, 0, 0, 0);
#pragma unroll
                for (int r = 0; r < 16; ++r) {
                    const unsigned key = (unsigned)(32 * kt + (r & 3) + 8 * (r >> 2)) + 4u * (unsigned)hh;
                    topk_insert(L, __uint_as_float((__float_as_uint(acc[r]) & ~127u) | key));
                }
            }
            float P[16];
#pragma unroll
            for (int i = 0; i < 16; ++i) P[i] = __shfl_xor(L[i], 32);
#pragma unroll
            for (int i = 0; i < 16; ++i) topk_insert(L, P[i]);
#pragma unroll
            for (int i = 0; i < 16; ++i) { if (p == 0) L0[i] = L[i]; else L1[i] = L[i]; }
        }
        float M[16];
#pragma unroll
        for (int i = 0; i < 16; ++i) M[i] = -3.0e38f;
        cand_all(M, L0, L1, std::make_integer_sequence<int, 16>{});
        const float m0 = __uint_as_float(__float_as_uint(M[0]) & ~255u);
        float den = 0.f;
#pragma unroll
        for (int i = 0; i < 16; ++i) den += __expf(__uint_as_float(__float_as_uint(M[i]) & ~255u) - m0);
        const float rden = 1.0f / den;
        unsigned eo[8]; float go[8];
#pragma unroll
        for (int q = 0; q < 8; ++q) {
            unsigned mlo = __float_as_uint(M[q]), mhi = __float_as_uint(M[8 + q]); asm volatile("" : "+v"(mlo), "+v"(mhi));
            const unsigned mb = hh ? mhi : mlo;
            const int ci = (mb >> 4) & 15, cj = mb & 15;
            eo[q] = (sel16(L0, ci) & 127u) * 128u + (sel16(L1, cj) & 127u);
            go[q] = __expf(__uint_as_float(mb & ~255u) - m0) * rden;
        }
        const size_t ob = (tok * 8 + h) * 16 + 8 * hh;
        *(u32x4*)(sel_e + ob) = (u32x4){eo[0], eo[1], eo[2], eo[3]}; *(u32x4*)(sel_e + ob + 4) = (u32x4){eo[4], eo[5], eo[6], eo[7]};
        *(f32x4*)(sel_g + ob) = (f32x4){go[0], go[1], go[2], go[3]}; *(f32x4*)(sel_g + ob + 4) = (f32x4){go[4], go[5], go[6], go[7]};
    }
}


template <int CTRL> __device__ __forceinline__ int dppi(int x) { return __builtin_amdgcn_update_dpp(0, x, CTRL, 0xF, 0xF, true); }
__device__ __forceinline__ void peer_gather(u32x4 (&w)[16], const LAS unsigned* idp, const unsigned char* tab) {
    u32x4 id[4];
#pragma unroll
    for (int c = 0; c < 4; ++c) id[c] = *(const LAS u32x4*)(idp + 4 * c);
#pragma unroll
    for (int i = 0; i < 16; ++i) w[i] = *(const u32x4*)(tab + (size_t)id[i >> 2][i & 3] * 128);
}
__device__ __forceinline__ void peer_u_reduce(const u32x4 (&w)[16], const u32x4 hq, LAS int* pp, bool first, bool b2, bool b1, bool b0) {
    int p[16];
#pragma unroll
    for (int i = 0; i < 16; ++i) {
        int acc = __builtin_amdgcn_sdot4((int)w[i].x, (int)hq.x, 0, false);
        acc = __builtin_amdgcn_sdot4((int)w[i].y, (int)hq.y, acc, false);
        acc = __builtin_amdgcn_sdot4((int)w[i].z, (int)hq.z, acc, false);
        p[i] = __builtin_amdgcn_sdot4((int)w[i].w, (int)hq.w, acc, false);
    }
    int q8[8], q4[4], q2[2];
#pragma unroll
    for (int k = 0; k < 8; ++k) { const int keep = b2 ? p[8 + k] : p[k], send = b2 ? p[k] : p[8 + k]; q8[k] = keep + dppi<0x141>(send); }
#pragma unroll
    for (int k = 0; k < 4; ++k) { const int keep = b1 ? q8[4 + k] : q8[k], send = b1 ? q8[k] : q8[4 + k]; q4[k] = keep + dppi<0x4E>(send); }
#pragma unroll
    for (int k = 0; k < 2; ++k) { const int keep = b0 ? q4[2 + k] : q4[k], send = b0 ? q4[k] : q4[2 + k]; q2[k] = keep + dppi<0xB1>(send); }
    if (first) { pp[0] = q2[0]; pp[8] = q2[1]; } else { pp[0] += q2[0]; pp[8] += q2[1]; }
}
__device__ __forceinline__ void peer_v_reduce(const u32x4 (&w)[16], const LAS unsigned* ap, float asc, float* op, const unsigned* xp, f32x2 gv, bool e0, bool e1, bool e2) {
    const u32x4 aq = *(const LAS u32x4*)ap;
    int y[16];
#pragma unroll
    for (int k = 0; k < 16; ++k) y[k] = 0;
#pragma unroll
    for (int g = 0; g < 4; ++g)
#pragma unroll
        for (int c = 0; c < 4; ++c) {
            const unsigned W0 = w[4 * g][c], W1 = w[4 * g + 1][c], W2 = w[4 * g + 2][c], W3 = w[4 * g + 3][c];
            const unsigned p01l = __builtin_amdgcn_perm(W1, W0, 0x05010400u), p01h = __builtin_amdgcn_perm(W1, W0, 0x07030602u);
            const unsigned p23l = __builtin_amdgcn_perm(W3, W2, 0x05010400u), p23h = __builtin_amdgcn_perm(W3, W2, 0x07030602u);
            const unsigned T0 = __builtin_amdgcn_perm(p23l, p01l, 0x05040100u), T1 = __builtin_amdgcn_perm(p23l, p01l, 0x07060302u);
            const unsigned T2 = __builtin_amdgcn_perm(p23h, p01h, 0x05040100u), T3 = __builtin_amdgcn_perm(p23h, p01h, 0x07060302u);
            y[4 * c + 0] = __builtin_amdgcn_sdot4((int)T0, (int)aq[g], y[4 * c + 0], false);
            y[4 * c + 1] = __builtin_amdgcn_sdot4((int)T1, (int)aq[g], y[4 * c + 1], false);
            y[4 * c + 2] = __builtin_amdgcn_sdot4((int)T2, (int)aq[g], y[4 * c + 2], false);
            y[4 * c + 3] = __builtin_amdgcn_sdot4((int)T3, (int)aq[g], y[4 * c + 3], false);
        }
    int z8[8], z4[4], z2[2];
#pragma unroll
    for (int k = 0; k < 8; ++k) { const int keep = e0 ? y[8 + k] : y[k], send = e0 ? y[k] : y[8 + k]; z8[k] = keep + dppi<0x128>(send); }
#pragma unroll
    for (int k = 0; k < 4; ++k) { const int keep = e1 ? z8[4 + k] : z8[k], send = e1 ? z8[k] : z8[4 + k]; z4[k] = keep + __shfl_xor(send, 16); }
#pragma unroll
    for (int k = 0; k < 2; ++k) { const int keep = e2 ? z4[2 + k] : z4[k], send = e2 ? z4[k] : z4[2 + k]; z2[k] = keep + __shfl_xor(send, 32); }
    const unsigned xw = *xp; const f32x2 xv = (f32x2){bf_lo(xw), bf_hi(xw)};
    *(f32x2*)op = xv + gv * (f32x2){(float)z2[0] * asc, (float)z2[1] * asc};
}
__device__ __forceinline__ void phase_peer(const Args& a, LAS unsigned char* lds) {
    const int wave = threadIdx.x >> 6;
    const int gw = blockIdx.x * NWAVE + wave, NGW = gridDim.x * NWAVE;
    const unsigned* gsel_e = (const unsigned*)(a.ws + WS_SELE); const float* gsel_g = (const float*)(a.ws + WS_SELG);
    const unsigned char* hq = a.ws + WS_HQ; const float* hsc = (const float*)(a.ws + WS_HS);
    const unsigned char* Uq = a.ws + WS_UT; const unsigned char* Vq = a.ws + WS_VT;
    const float* uscale = (const float*)(a.ws + WS_US); const float* vscale = (const float*)(a.ws + WS_VS);
    const float* mod = (const float*)(a.ws + WS_MOD); float* out = a.out; const bf16_t* x1b = (const bf16_t*)(a.ws + WS_X1B);
    LAS unsigned* ids = (LAS unsigned*)(lds + wave * 16384);
    LAS int* pre = (LAS int*)(lds + wave * 16384 + 8192);
    for (int grp = gw; grp * 16 < T_TOK; grp += NGW) {
        int lane = threadIdx.x & 63; asm volatile("" : "+v"(lane));
        const int sub = lane & 7, eg = lane >> 3;
        const bool b2 = (sub & 4) != 0, b1 = (sub & 2) != 0, b0 = (sub & 1) != 0;
        const bool e0 = (eg & 1) != 0, e1 = (eg & 2) != 0, e2 = (eg & 4) != 0;
        const size_t tok0 = (size_t)grp * 16;
#pragma unroll
        for (int j = 0; j < 8; ++j) {
            const int q = lane + 64 * j;
            const u32x4 v = *(const u32x4*)(gsel_e + tok0 * 128 + (size_t)q * 4);
            const int t = q >> 5, k = (q & 31) * 4;
#pragma unroll
            for (int c = 0; c < 4; ++c) ids[t * 128 + ((k + c) & 7) * 16 + ((k + c) >> 3)] = v[c];
        }
        LDS_WAIT();
        for (int s = 0; s < 8; ++s) {
            const unsigned char* Us = Uq + (size_t)s * 16384 * 128 + 16 * sub;
            const unsigned char* hs = hq + tok0 * DM + 128 * s + 16 * sub;
            u32x4 wA[16], wB[16], hA, hB;
            peer_gather(wA, ids + eg * 16, Us); hA = *(const u32x4*)(hs);
            for (int t = 0; t < 16; t += 2) {
                peer_gather(wB, ids + (t + 1) * 128 + eg * 16, Us); hB = *(const u32x4*)(hs + (t + 1) * DM);
                peer_u_reduce(wA, hA, pre + t * 128 + 16 * sub + eg, s == 0, b2, b1, b0);
                if (t + 2 < 16) { peer_gather(wA, ids + (t + 2) * 128 + eg * 16, Us); hA = *(const u32x4*)(hs + (t + 2) * DM); }
                peer_u_reduce(wB, hB, pre + (t + 1) * 128 + 16 * sub + eg, s == 0, b2, b1, b0);
            }
        }
        LDS_WAIT();
        for (int t = 0; t < 16; ++t) {
            float r[2]; const float hs_t = hsc[tok0 + t];
#pragma unroll
            for (int c = 0; c < 2; ++c) {
                const int k = lane + 64 * c;
                const unsigned e = ids[t * 128 + (k & 7) * 16 + (k >> 3)];
                const float pv = (float)pre[t * 128 + k] * (uscale[e] * hs_t);
                r[c] = 0.5f * pv * (1.0f + erff(pv * 0.70710678118654752f)) * gsel_g[(tok0 + t) * 128 + k] * vscale[e];
            }
            const float am = wave_max(fmaxf(fabsf(r[0]), fabsf(r[1])));
            const float inv = am > 0.f ? 127.0f / am : 0.f;
            LDS_WAIT();
            LAS unsigned char* ab = (LAS unsigned char*)(pre + t * 128);
#pragma unroll
            for (int c = 0; c < 2; ++c) { const int k = lane + 64 * c; ab[(k & 7) * 16 + (k >> 3)] = (unsigned char)((int)rintf(r[c] * inv) & 255); }
            if (lane == 0) *(LAS float*)(ab + 128) = am * (1.0f / 127.0f);
        }
        LDS_WAIT();
        for (int s = 0; s < 8; ++s) {
            const unsigned char* Vs = Vq + (size_t)s * 16384 * 128 + 16 * sub;
            const int d = 128 * s + 16 * sub + (e0 ? 8 : 0) + (e1 ? 4 : 0) + (e2 ? 2 : 0);
            const f32x2 gv = *(const f32x2*)(mod + (tok0 >> 12) * NMODC + 5120 + d);
            u32x4 wA[16], wB[16];
            peer_gather(wA, ids + eg * 16, Vs);
            for (int t = 0; t < 16; t += 2) {
                peer_gather(wB, ids + (t + 1) * 128 + eg * 16, Vs);
                peer_v_reduce(wA, (const LAS unsigned*)(pre + t * 128) + eg * 4, *(const LAS float*)((const LAS unsigned char*)(pre + t * 128) + 128), out + (tok0 + t) * DM + d, (const unsigned*)(x1b + (tok0 + t) * DM + d), gv, e0, e1, e2);
                if (t + 2 < 16) peer_gather(wA, ids + (t + 2) * 128 + eg * 16, Vs);
                peer_v_reduce(wB, (const LAS unsigned*)(pre + (t + 1) * 128) + eg * 4, *(const LAS float*)((const LAS unsigned char*)(pre + (t + 1) * 128) + 128), out + (tok0 + t + 1) * DM + d, (const unsigned*)(x1b + (tok0 + t + 1) * DM + d), gv, e0, e1, e2);
            }
        }
        LDS_WAIT();
    }
}

__device__ __forceinline__ void grid_barrier(unsigned* cnt, unsigned nblocks) {
    __syncthreads();
    if (threadIdx.x == 0) {
        __builtin_amdgcn_fence(__ATOMIC_RELEASE, "agent");
        asm volatile("s_waitcnt vmcnt(0)" ::: "memory");
        __hip_atomic_fetch_add(cnt, 1u, __ATOMIC_RELAXED, __HIP_MEMORY_SCOPE_AGENT);
        while (__hip_atomic_load(cnt, __ATOMIC_RELAXED, __HIP_MEMORY_SCOPE_AGENT) < nblocks) __builtin_amdgcn_s_sleep(2);
        __builtin_amdgcn_fence(__ATOMIC_ACQUIRE, "agent");
        asm volatile("s_waitcnt vmcnt(0)" ::: "memory");
    }
    __syncthreads();
}

#define XB_TMO      128
#define XB_XCNT(j)  (256  + 64 * (j))
#define XB_XSUB(j)  (1280 + 64 * (j))
#define XB_XGEN(j)  (2304 + 64 * (j))
#define XB_TOP      3328
#define XB_TOPGEN   3392
#define XB_SPIN_CAP (1u << 22)
__device__ __forceinline__ unsigned xb_ld(unsigned* p)              { return __hip_atomic_load(p, __ATOMIC_RELAXED, __HIP_MEMORY_SCOPE_AGENT); }
__device__ __forceinline__ unsigned xb_add(unsigned* p, unsigned v) { return __hip_atomic_fetch_add(p, v, __ATOMIC_RELAXED, __HIP_MEMORY_SCOPE_AGENT); }
__device__ __forceinline__ unsigned xb_xcc_id() { return (unsigned)__builtin_amdgcn_s_getreg((3 << 11) | 20) & 0xFu; }
#define XB_SPIN(cond, bar) do { unsigned _sp = 0; while (cond) { __builtin_amdgcn_s_sleep(1); \
    if ((++_sp & 255u) == 0u) { if (xb_ld(&(bar)[XB_TMO])) break; if (_sp > XB_SPIN_CAP) { atomicAdd(&(bar)[XB_TMO], 1u); break; } } } } while (0)
struct XcdBarrier { unsigned* bar; unsigned x; volatile LAS unsigned* st; };
__device__ __forceinline__ XcdBarrier xcd_barrier_post(unsigned* bar, volatile LAS unsigned* st) {
    XcdBarrier b; b.bar = bar; b.x = xb_xcc_id(); b.st = st;
    if (threadIdx.x == 0) (void)xb_add(&bar[XB_XCNT(b.x)], 1u);
    return b;
}
__device__ __forceinline__ void xcd_barrier_complete(unsigned* bar, unsigned x, unsigned& nloc, unsigned& nx) {
    const unsigned G = gridDim.x * gridDim.y * gridDim.z;
    unsigned sum, cnt, mine, sp = 0u;
    for (;;) {
        sum = 0u; cnt = 0u; mine = 0u;
#pragma unroll
        for (unsigned j = 0; j < 16; ++j) { const unsigned c = xb_ld(&bar[XB_XCNT(j)]); sum += c; cnt += (c > 0u) ? 1u : 0u; mine = (j == x) ? c : mine; }
        if (sum == G) break;
        __builtin_amdgcn_s_sleep(1);
        if ((++sp & 255u) == 0u) { if (xb_ld(&bar[XB_TMO])) break; if (sp > XB_SPIN_CAP) { atomicAdd(&bar[XB_TMO], 1u); break; } }
    }
    nloc = mine > 0u ? mine : 1u; nx = cnt > 0u ? cnt : 1u;
}
__device__ __forceinline__ void xcd_barrier(const XcdBarrier& b) {
    asm volatile("s_waitcnt vmcnt(0)" ::: "memory");
    __syncthreads();
    if (threadIdx.x == 0) {
        unsigned* bar = b.bar;
        __builtin_amdgcn_s_waitcnt(0);
        unsigned nloc = b.st[0], nx = b.st[1];
        if (nloc == 0u) { xcd_barrier_complete(bar, b.x, nloc, nx); b.st[0] = nloc; b.st[1] = nx; }
        const unsigned old = xb_add(&bar[XB_XSUB(b.x)], 1u);
        const unsigned gen = old / nloc;
        if (old + 1u == (gen + 1u) * nloc) {
            __builtin_amdgcn_fence(__ATOMIC_RELEASE, "agent");
            asm volatile("s_waitcnt vmcnt(0)" ::: "memory");
            const unsigned og = xb_add(&bar[XB_TOP], 1u);
            const unsigned tg = og / nx;
            if (og + 1u == (tg + 1u) * nx) xb_add(&bar[XB_TOPGEN], 1u);
            else XB_SPIN(xb_ld(&bar[XB_TOPGEN]) == tg, bar);
            __builtin_amdgcn_fence(__ATOMIC_ACQUIRE, "agent");
            xb_add(&bar[XB_XGEN(b.x)], 1u);
            asm volatile("s_waitcnt vmcnt(0)" ::: "memory");
        } else {
            XB_SPIN(xb_ld(&bar[XB_XGEN(b.x)]) == gen, bar);
            __builtin_amdgcn_fence(__ATOMIC_ACQUIRE, "agent");
            asm volatile("s_waitcnt vmcnt(0)" ::: "memory");
        }
    }
    __syncthreads();
}

__global__ void __launch_bounds__(NTHR, 2) mega(Args a) {
    extern __shared__ __attribute__((aligned(16))) unsigned char smem[];
    LAS unsigned char* lds = (LAS unsigned char*)smem;
    const int lo = a.ph_lo, hi = a.ph_hi;
    const int G = gridDim.x;
    if (threadIdx.x < 4) ((LAS unsigned*)(lds + LDS_BYTES - 16))[threadIdx.x] = 0u;
    XcdBarrier xb; xb.bar = (unsigned*)(a.ws + WS_XB); xb.x = 0; xb.st = (volatile LAS unsigned*)(lds + LDS_BYTES - 16);
#define IN(k) (lo <= (k) && (k) < hi)
#ifndef DUP_MASK
#define DUP_MASK 0
#endif
#define REP(k) for (int rep_ = 0; rep_ < 1 + ((DUP_MASK >> (k)) & 1); ++rep_, (((DUP_MASK >> 23) & 1) && ((DUP_MASK >> (k)) & 1) && (k) < 16 && rep_ == 1 ? grid_barrier((unsigned*)(a.ws + WS_BAR) + 64 * ((k) > 15 ? 15 : (k)) + 16, (unsigned)G) : (void)0))
#define SYNC(k) do { if (IN(k) && IN((k) + 1)) { if ((k) == 0) { cg::this_grid().sync(); xb = xcd_barrier_post((unsigned*)(a.ws + WS_XB), (volatile LAS unsigned*)(lds + LDS_BYTES - 16)); } else { xcd_barrier(xb); if ((DUP_MASK >> 22) & 1) xcd_barrier(xb); } } } while (0)
    if (IN(0)) REP(0) phase0(a, lds);
    SYNC(0);
    if (IN(1)) REP(1) { phase_norm<true>(a, a.in[0], a.in[4], 0, 1024); phase0b(a, lds); }
    SYNC(1);
#if INPROJ_I8
    if (IN(2)) REP(2) { pg8::Gemm g{(const bf16_t*)(a.ws + WS_ACT), (const bf16_t*)(a.ws + WS_WIN_T), T_TOK, NPROJ, 512}; pg8::StaticOrder S; S.init(T_TOK, NPROJ, G, (int)blockIdx.x);
        pg8::EpiBf16S E{(bf16_t*)(a.ws + WS_PROJ), NPROJ, (const float*)(a.ws + WS_H1S), (const float*)(a.ws + WS_WINS)}; pg8::gemm_phase<pg8::EpiBf16S, true>(lds, g, S, E); }
#else
    if (IN(2)) REP(2) { pg8::Gemm g{(const bf16_t*)(a.ws + WS_ACT), (const bf16_t*)(a.ws + WS_WIN_T), T_TOK, NPROJ, 1024}; pg8::StaticOrder S; S.init(T_TOK, NPROJ, G, (int)blockIdx.x);
        pg8::EpiBf16 E{(bf16_t*)(a.ws + WS_PROJ), NPROJ}; pg8::gemm_phase(lds, g, S, E); }
#endif
    SYNC(2);
    if (IN(3)) { REP(3) dn_prep(a, lds); sb_prep(a); }
    SYNC(3);
    if (IN(4)) {
        if ((int)blockIdx.x < DN_BLOCKS) { REP(16) dn_scan2(a, lds); }
        else { REP(17) sb_attn(a, ((int)blockIdx.x - DN_BLOCKS) * NWAVE + (int)(threadIdx.x >> 6), (G - DN_BLOCKS) * NWAVE);
               late_prep(a, lds, ((int)blockIdx.x - DN_BLOCKS) * NWAVE + (int)(threadIdx.x >> 6), (G - DN_BLOCKS) * NWAVE); }
    }
    SYNC(4);
    if (IN(5)) REP(5) dn_gate_norm(a);
    SYNC(5);
    if (IN(6)) REP(6) { pg8::Gemm g{(const bf16_t*)(a.ws + WS_MQ), (const bf16_t*)(a.ws + WS_WOUT_T), T_TOK, 1024, 512}; pg8::StaticOrder S; S.init(T_TOK, 1024, G, (int)blockIdx.x);
        pg8::EpiResidS E{a.in[0], (const float*)(a.ws + WS_MOD), (bf16_t*)(a.ws + WS_X1B), (const float*)(a.ws + WS_MS), (const float*)(a.ws + WS_WOS)}; pg8::gemm_phase<pg8::EpiResidS, true>(lds, g, S, E); }
    SYNC(6);
    if (IN(7)) REP(7) phase_norm<false>(a, a.out, a.in[14], 3072, 4096);
    SYNC(7);
    if (IN(8)) REP(8) {
#if QUERY_I8
        pg8::Gemm g{(const bf16_t*)(a.ws + WS_HQ), (const bf16_t*)(a.ws + WS_WQ_T), T_TOK, 2048, 512}; pg8::StaticOrder S; S.init(T_TOK, 2048, G, (int)blockIdx.x);
        pg8::EpiBf16S E{(bf16_t*)(a.ws + WS_QPEER), 2048, (const float*)(a.ws + WS_HS), (const float*)(a.ws + WS_WQS)}; pg8::gemm_phase<pg8::EpiBf16S, true>(lds, g, S, E);
#else
        pg8::Gemm g{(const bf16_t*)(a.ws + WS_ACT), (const bf16_t*)(a.ws + WS_WQ_T), T_TOK, 2048, 1024}; pg8::StaticOrder S; S.init(T_TOK, 2048, G, (int)blockIdx.x);
        pg8::EpiBf16 E{(bf16_t*)(a.ws + WS_QPEER), 2048}; pg8::gemm_phase(lds, g, S, E);
#endif
        asm volatile("s_waitcnt vmcnt(0)" ::: "memory"); __syncthreads();
        phase_scores(a, lds, S); }
    SYNC(8);
    if (IN(10)) phase_peer(a, lds);
#undef IN
#undef SYNC
}

#ifndef ONE_LAUNCH
#define ONE_LAUNCH 1
#endif

extern "C" void kernel_launch(void* const* d_in, const int* in_sizes, int n_in, void* d_out, int out_size, void* d_ws, size_t ws_size, hipStream_t stream) {
    static int grid = 0;
    if (grid == 0) {
        int dev = 0, cus = 0, per_cu = 0;
        (void)hipGetDevice(&dev);
        (void)hipDeviceGetAttribute(&cus, hipDeviceAttributeMultiprocessorCount, dev);
        (void)hipFuncSetAttribute((const void*)mega, hipFuncAttributeMaxDynamicSharedMemorySize, LDS_BYTES);
        (void)hipOccupancyMaxActiveBlocksPerMultiprocessor(&per_cu, (const void*)mega, NTHR, LDS_BYTES);
        if (per_cu < 1) { fprintf(stderr, "kernel_launch: occupancy query says %d blocks/CU\n", per_cu); per_cu = 1; }
        if (per_cu > 1) per_cu = 1;
        grid = cus * per_cu;
        if (ws_size < WS_END3) fprintf(stderr, "kernel_launch: workspace too small: %zu < %zu\n", ws_size, (size_t)WS_END3);
    }
    Args a{};
    for (int i = 0; i < 19; ++i) a.in[i] = (const float*)d_in[i];
    a.out = (float*)d_out; a.ws = (unsigned char*)d_ws;
#if ONE_LAUNCH
    a.ph_lo = 0; a.ph_hi = N_PHASES;
    void* args[] = {&a};
    hipError_t e = hipLaunchCooperativeKernel((const void*)mega, dim3(grid), dim3(NTHR), args, LDS_BYTES, stream);
    if (e != hipSuccess) fprintf(stderr, "cooperative launch failed: %s (grid %d)\n", hipGetErrorString(e), grid);
#else
    for (int p = 0; p < N_PHASES; ++p) {
        a.ph_lo = p; a.ph_hi = p + 1;
        hipLaunchKernelGGL(mega, dim3(grid), dim3(NTHR), LDS_BYTES, stream, a);
    }
#endif
}
```

```cpp
#include <hip/hip_runtime.h>
#include <hip/hip_cooperative_groups.h>
#include <cstdio>
#include <utility>
#include <type_traits>
namespace cg = cooperative_groups;
#ifndef INPROJ_I8
#define INPROJ_I8 1
#endif
#ifndef QUERY_I8
#define QUERY_I8 1
#endif

#define LAS __attribute__((address_space(3)))
typedef unsigned short bf16_t;
typedef short bf16x8 __attribute__((ext_vector_type(8)));
typedef float f32x4 __attribute__((ext_vector_type(4)));
typedef float f32x2 __attribute__((ext_vector_type(2)));
typedef unsigned u32x4 __attribute__((ext_vector_type(4)));
typedef unsigned u32x2 __attribute__((ext_vector_type(2)));
using bf16x2 = __attribute__((ext_vector_type(2))) __bf16;

constexpr int T_TOK = 32768, SEQ = 4096, DM = 1024, NMODC = 6144;
constexpr int NPROJ = 3584, LDW_IN = 3592;
constexpr int NTHR = 512, NWAVE = 8;
constexpr int LDS_BYTES = 160 * 1024;
constexpr int N_PHASES = 11;
constexpr int DN_BLOCKS = 64;
constexpr float EPS = 1e-6f;

constexpr size_t WS_MOD = 0;
constexpr size_t WS_WSM = WS_MOD + 8 * 6144 * 4;
constexpr size_t WS_SMALL = WS_WSM + 8 * 1024 * 4;
constexpr size_t WS_WIN_T = WS_SMALL + (size_t)T_TOK * 8 * 4;
constexpr size_t WS_WOUT_T = WS_WIN_T + (size_t)NPROJ * 1024 * 2;
constexpr size_t WS_WQ_T = WS_WOUT_T + (size_t)1024 * 1024 * 2;
constexpr size_t WS_SUBK = WS_WQ_T + (size_t)2048 * 1024 * 2;
constexpr size_t WS_UT = WS_SUBK + (size_t)16 * 128 * 128 * 2;
constexpr size_t WS_VT = WS_UT + (size_t)16384 * 1024 * 2;
constexpr size_t WS_US = WS_UT + (size_t)16384 * 1024;
constexpr size_t WS_VS = WS_US + 65536;
constexpr size_t WS_H1S = WS_VS + 65536;
constexpr size_t WS_WINS = WS_H1S + (size_t)T_TOK * 4;
constexpr size_t WS_WQS = WS_WINS + 16384;
constexpr size_t WS_WOS = WS_WQS + 8192;
constexpr size_t WS_MS = WS_WOS + 4096;
constexpr size_t WS_ACT = WS_VT + (size_t)16384 * 1024 * 2;
constexpr size_t WS_PROJ = WS_ACT + (size_t)T_TOK * 1024 * 2;
constexpr size_t WS_QPEER = WS_PROJ;
constexpr size_t WS_SELE = WS_PROJ + (size_t)T_TOK * 2048 * 2;
constexpr size_t WS_SELG = WS_SELE + (size_t)T_TOK * 128 * 4;
constexpr size_t WS_HQ = WS_SELG + (size_t)T_TOK * 128 * 4;
constexpr size_t WS_HS = WS_HQ + (size_t)T_TOK * 1024;
constexpr size_t WS_END = WS_PROJ + (size_t)T_TOK * NPROJ * 2;
constexpr size_t DN_REC = 73728;
constexpr size_t WS_DN = WS_END;
constexpr size_t WS_X1B = WS_DN;
constexpr size_t WS_MQ = WS_DN + (size_t)T_TOK * 1024 * 2;
constexpr size_t WS_GLS = WS_DN + 2048 * DN_REC;
constexpr size_t WS_END2 = WS_GLS + 8192;
constexpr size_t WS_BAR = WS_END2;
constexpr size_t WS_XB = WS_BAR + 16 * 256;
constexpr size_t WS_END3 = WS_XB + 3456 * 4;
constexpr size_t VT_OFF = (size_t)T_TOK * 512 * 4;

struct Args { const float* in[19]; float* out; unsigned char* ws; int ph_lo, ph_hi; };

template <int CTRL> __device__ __forceinline__ float dpp_(float x) {
    return __builtin_bit_cast(float, __builtin_amdgcn_update_dpp(0, __builtin_bit_cast(int, x), CTRL, 0xF, 0xF, true));
}
__device__ __forceinline__ float wave_sum(float v) {
    v += dpp_<0xB1>(v); v += dpp_<0x4E>(v); v += dpp_<0x141>(v); v += dpp_<0x140>(v);
    v += __shfl_xor(v, 16); v += __shfl_xor(v, 32);
    return v;
}
__device__ __forceinline__ float wave_max(float v) {
    v = fmaxf(v, dpp_<0xB1>(v)); v = fmaxf(v, dpp_<0x4E>(v)); v = fmaxf(v, dpp_<0x141>(v)); v = fmaxf(v, dpp_<0x140>(v));
    v = fmaxf(v, __shfl_xor(v, 16)); v = fmaxf(v, __shfl_xor(v, 32));
    return v;
}
__device__ __forceinline__ unsigned pk2(float lo, float hi) {
    typedef __bf16 bf2v_t __attribute__((ext_vector_type(2)));
    bf2v_t v; v[0] = (__bf16)lo; v[1] = (__bf16)hi; return __builtin_bit_cast(unsigned, v);
}
__device__ __forceinline__ unsigned f2bf(float f) { return pk2(f, 0.f) & 0xffffu; }
__device__ __forceinline__ float bf_lo(unsigned w) { return __uint_as_float(w << 16); }
__device__ __forceinline__ float bf_hi(unsigned w) { return __uint_as_float(w & 0xffff0000u); }
__device__ __forceinline__ float dot2(unsigned a, unsigned b, float acc) {
    return __builtin_amdgcn_fdot2_f32_bf16(__builtin_bit_cast(bf16x2, a), __builtin_bit_cast(bf16x2, b), acc, false);
}
__device__ __forceinline__ float siluf(float x) { return x * __builtin_amdgcn_rcpf(1.0f + __expf(-x)); }
template <int CTRL> __device__ __forceinline__ float dppf(float x) {
    return __builtin_bit_cast(float, __builtin_amdgcn_update_dpp(0, __builtin_bit_cast(int, x), CTRL, 0xF, 0xF, true));
}
#define LDS_WAIT() asm volatile("s_waitcnt lgkmcnt(0)" ::: "memory")

namespace pg8 {
typedef int i32x4 __attribute__((ext_vector_type(4)));
constexpr int BM = 256, BK = 64, HALF = 128, HTB = HALF * BK * 2, STAGE_BYTES = 8 * HTB, NXCD = 8, WGM = 4;
__device__ __forceinline__ int lds_byte(int r, int c) { const int st = (r >> 4) * 2 + (c >> 5), rr = r & 15, cc = c & 31, ob = rr * 64 + cc * 2; return st * 1024 + (ob ^ (((ob >> 9) & 1) << 5)); }
__device__ __forceinline__ void stage_rc(int b, int& R, int& C) { const int st = b / 1024, sb = b % 1024, swz = sb ^ (((sb >> 9) & 1) << 5); R = (st >> 1) * 16 + swz / 64; C = (st & 1) * 32 + (swz % 64) / 2; }
__device__ __forceinline__ int perm32(int rho) { const int n = rho >> 4, i = rho & 15; return 8 * (i >> 2) + 4 * n + (i & 3); }
struct Unit { int pm, pn; };
struct Gemm { const bf16_t* A; const bf16_t* Bt; int M, N, K; };
struct StaticOrder {
    int nM, nN, nwg, G, c;
    __device__ void init(int M, int N, int G_, int c_) { nM = M / BM; nN = N / BM; nwg = nM * nN; G = G_; c = c_; }
    __device__ bool next(int i, Unit& u) const {
        const long L = (long)i * G + c; if (L >= nwg) return false;
        int wgid = (int)L; { const int q = nwg / NXCD, r = nwg % NXCD, xcd = wgid % NXCD, off = wgid / NXCD; wgid = (xcd < r ? xcd * (q + 1) : r * (q + 1) + (xcd - r) * q) + off; }
        const int nig = WGM * nN, gid = wgid / nig, fm = gid * WGM, gsz = (nM - fm) < WGM ? (nM - fm) : WGM;
        u.pm = fm + ((wgid % nig) % gsz); u.pn = (wgid % nig) / gsz; return true;
    }
};
__device__ __forceinline__ unsigned cvt_pk_bf16(float lo, float hi) { unsigned r; asm volatile("v_cvt_pk_bf16_f32 %0, %1, %2" : "=v"(r) : "v"(lo), "v"(hi)); return r; }

struct EpiBf16 {
    static constexpr bool PERM = true;
    bf16_t* O; int ldc;
    __device__ __forceinline__ void operator()(const f32x4 (&acc)[2][2][4][2], const Unit& u, int wr, int wc, int fr, int fq) const {
        const int row0 = u.pm * BM + wr * 64 + fr; const int col0 = u.pn * BM + wc * 32 + 8 * fq;
#pragma unroll
        for (int ai = 0; ai < 2; ++ai)
#pragma unroll
            for (int m = 0; m < 4; ++m) { bf16_t* rowp = O + (size_t)(row0 + ai * HALF + m * 16) * ldc + col0;
#pragma unroll
                for (int bj = 0; bj < 2; ++bj) { const f32x4 v0 = acc[ai][bj][m][0], v1 = acc[ai][bj][m][1];
                    u32x4 w; w.x = cvt_pk_bf16(v0[0], v0[1]); w.y = cvt_pk_bf16(v0[2], v0[3]); w.z = cvt_pk_bf16(v1[0], v1[1]); w.w = cvt_pk_bf16(v1[2], v1[3]);
                    *(u32x4*)(rowp + bj * HALF) = w; } }
    }
};
struct EpiBf16S {
    static constexpr bool PERM = true;
    bf16_t* O; int ldc; const float* ascale; const float* bscale;
    __device__ __forceinline__ void operator()(const i32x4 (&acc)[2][2][4][2], const Unit& u, int wr, int wc, int fr, int fq) const {
        const int row0 = u.pm * BM + wr * 64 + fr; const int col0 = u.pn * BM + wc * 32 + 8 * fq;
        f32x4 bs[2][2];
#pragma unroll
        for (int bj = 0; bj < 2; ++bj) { bs[bj][0] = *(const f32x4*)(bscale + col0 + bj * HALF); bs[bj][1] = *(const f32x4*)(bscale + col0 + bj * HALF + 4); }
#pragma unroll
        for (int ai = 0; ai < 2; ++ai)
#pragma unroll
            for (int m = 0; m < 4; ++m) { const int row = row0 + ai * HALF + m * 16; const float as = ascale[row]; bf16_t* rowp = O + (size_t)row * ldc + col0;
#pragma unroll
                for (int bj = 0; bj < 2; ++bj) { const i32x4 a0 = acc[ai][bj][m][0], a1 = acc[ai][bj][m][1];
                    const f32x4 v0 = (f32x4){(float)a0[0], (float)a0[1], (float)a0[2], (float)a0[3]} * bs[bj][0] * as;
                    const f32x4 v1 = (f32x4){(float)a1[0], (float)a1[1], (float)a1[2], (float)a1[3]} * bs[bj][1] * as;
                    u32x4 w; w.x = cvt_pk_bf16(v0[0], v0[1]); w.y = cvt_pk_bf16(v0[2], v0[3]); w.z = cvt_pk_bf16(v1[0], v1[1]); w.w = cvt_pk_bf16(v1[2], v1[3]);
                    *(u32x4*)(rowp + bj * HALF) = w; } }
    }
};
struct EpiResidS {
    static constexpr bool PERM = false;
    const float* x; const float* mod; bf16_t* out; const float* ascale; const float* bscale;
    __device__ __forceinline__ void operator()(const i32x4 (&acc)[2][2][4][2], const Unit& u, int wr, int wc, int fr, int fq) const {
        const int row0 = u.pm * BM + wr * 64 + fr, col0 = u.pn * BM + wc * 32 + 4 * fq;
        const int b = (u.pm * BM) >> 12;
        f32x4 gv[2][2];
#pragma unroll
        for (int bj = 0; bj < 2; ++bj)
#pragma unroll
            for (int n = 0; n < 2; ++n) gv[bj][n] = *(const f32x4*)(mod + (size_t)b * NMODC + 2048 + col0 + bj * HALF + n * 16) * *(const f32x4*)(bscale + col0 + bj * HALF + n * 16);
#pragma unroll
        for (int ai = 0; ai < 2; ++ai) {
            f32x4 xv[4][2][2]; float as[4];
#pragma unroll
            for (int m = 0; m < 4; ++m) { const int row = row0 + ai * HALF + m * 16; const size_t off = (size_t)row * DM + col0; as[m] = ascale[row];
#pragma unroll
                for (int bj = 0; bj < 2; ++bj)
#pragma unroll
                    for (int n = 0; n < 2; ++n) xv[m][bj][n] = *(const f32x4*)(x + off + bj * HALF + n * 16); }
            __builtin_amdgcn_sched_barrier(0);
#pragma unroll
            for (int m = 0; m < 4; ++m) { const int row = row0 + ai * HALF + m * 16; const size_t off = (size_t)row * DM + col0;
#pragma unroll
                for (int bj = 0; bj < 2; ++bj)
#pragma unroll
                    for (int n = 0; n < 2; ++n) { const i32x4 ai4 = acc[ai][bj][m][n];
                        const f32x4 r = xv[m][bj][n] + gv[bj][n] * ((f32x4){(float)ai4[0], (float)ai4[1], (float)ai4[2], (float)ai4[3]} * as[m]);
                        u32x2 w; w.x = cvt_pk_bf16(r[0], r[1]); w.y = cvt_pk_bf16(r[2], r[3]);
                        *(u32x2*)(out + off + bj * HALF + n * 16) = w; } }
        }
    }
};
struct EpiResid {
    static constexpr bool PERM = false;
    const float* x; const float* mod; bf16_t* out;
    __device__ __forceinline__ void operator()(const f32x4 (&acc)[2][2][4][2], const Unit& u, int wr, int wc, int fr, int fq) const {
        const int row0 = u.pm * BM + wr * 64 + fr, col0 = u.pn * BM + wc * 32 + 4 * fq;
        const int b = (u.pm * BM) >> 12;
        f32x4 gv[2][2];
#pragma unroll
        for (int bj = 0; bj < 2; ++bj)
#pragma unroll
            for (int n = 0; n < 2; ++n) gv[bj][n] = *(const f32x4*)(mod + (size_t)b * NMODC + 2048 + col0 + bj * HALF + n * 16);
#pragma unroll
        for (int ai = 0; ai < 2; ++ai)
#pragma unroll
            for (int m = 0; m < 4; ++m) { const size_t off = (size_t)(row0 + ai * HALF + m * 16) * DM + col0;
#pragma unroll
                for (int bj = 0; bj < 2; ++bj)
#pragma unroll
                    for (int n = 0; n < 2; ++n) { const f32x4 xv = *(const f32x4*)(x + off + bj * HALF + n * 16);
                        const f32x4 r = xv + gv[bj][n] * acc[ai][bj][m][n];
                        u32x2 w; w.x = cvt_pk_bf16(r[0], r[1]); w.y = cvt_pk_bf16(r[2], r[3]);
                        *(u32x2*)(out + off + bj * HALF + n * 16) = w; } }
    }
};

__device__ __forceinline__ f32x4 mma16(bf16x8 a, bf16x8 b, f32x4 c) { return __builtin_amdgcn_mfma_f32_16x16x32_bf16(a, b, c, 0, 0, 0); }
__device__ __forceinline__ i32x4 mma16(bf16x8 a, bf16x8 b, i32x4 c) { return __builtin_amdgcn_mfma_i32_16x16x64_i8(__builtin_bit_cast(i32x4, a), __builtin_bit_cast(i32x4, b), c, 0, 0, 0); }
template <class Epi, bool I8 = false>
__device__ __forceinline__ void gemm_phase(LAS unsigned char* lds, const Gemm g, const StaticOrder& S, const Epi& E) {
    typedef typename std::conditional<I8, i32x4, f32x4>::type acc_t;
    const int tid = threadIdx.x, wid = __builtin_amdgcn_readfirstlane(tid >> 6), lane = tid & 63, wr = wid >> 2, wc = wid & 3, fr = lane & 15, fq = lane >> 4;
    const int K = g.K, nt = K / BK;
    unsigned voffA[2], voffB[2];
#pragma unroll
    for (int i = 0; i < 2; ++i) { int R, C; stage_rc(tid * 16 + i * 8192, R, C); const int Rb = Epi::PERM ? ((R & ~31) + perm32(R & 31)) : R;
        voffA[i] = (unsigned)(R * K + C) * 2u; voffB[i] = (unsigned)(Rb * K + C) * 2u; }
    const size_t kstep = (size_t)(BK * 2);
    const size_t hstep = (size_t)HALF * K * 2;
    const size_t tstep = 2 * hstep;
    const unsigned ldsw = (unsigned)wid * 1024u;
    const int aoff = lds_byte(wr * 64 + fr, fq * 8), boff = lds_byte(wc * 32 + fr, fq * 8);
#define PG8_SA(b, h) (((b) * 2 + (h)) * HTB)
#define PG8_SB(b, h) ((4 + (b) * 2 + (h)) * HTB)
#define PG8_STAGE(bufoff, gbase, voff) do { _Pragma("unroll") for (int _i = 0; _i < 2; ++_i) \
        __builtin_amdgcn_global_load_lds((const unsigned*)((const char*)(gbase) + (voff)[_i]), (LAS unsigned*)(lds + (bufoff) + ldsw + _i * 8192), 16, 0, 0); } while (0)
#define PG8_LDA(dst, b, h) do { _Pragma("unroll") for (int m = 0; m < 4; ++m) _Pragma("unroll") for (int k = 0; k < 2; ++k) dst[m][k] = *(const LAS bf16x8*)(lds + PG8_SA(b, h) + aoff + m * 2048 + k * 1024); } while (0)
#define PG8_LDB(dst, b, h) do { _Pragma("unroll") for (int n = 0; n < 2; ++n) _Pragma("unroll") for (int k = 0; k < 2; ++k) dst[n][k] = *(const LAS bf16x8*)(lds + PG8_SB(b, h) + boff + n * 2048 + k * 1024); } while (0)
#define PG8_MMA(ai, bj, At, Bt) do { __builtin_amdgcn_s_setprio(1); _Pragma("unroll") for (int m = 0; m < 4; ++m) _Pragma("unroll") for (int n = 0; n < 2; ++n) _Pragma("unroll") for (int k = 0; k < 2; ++k) \
        acc[ai][bj][m][n] = mma16(Bt[n][k], At[m][k], acc[ai][bj][m][n]); __builtin_amdgcn_s_setprio(0); } while (0)
#define PG8_WAIT_V(n) asm volatile("s_waitcnt vmcnt(" #n ")" ::: "memory")
#define PG8_WAIT_L(n) asm volatile("s_waitcnt lgkmcnt(" #n ")" ::: "memory")
#define PG8_BAR __builtin_amdgcn_s_barrier()
#define PG8_SCHED __builtin_amdgcn_sched_barrier(0)
    Unit cur, nxt; int ui = 0;
    if (!S.next(0, cur)) return;
    acc_t acc[2][2][4][2];
#pragma unroll
    for (int a = 0; a < 2; ++a)
#pragma unroll
        for (int b = 0; b < 2; ++b)
#pragma unroll
            for (int m = 0; m < 4; ++m)
#pragma unroll
                for (int n = 0; n < 2; ++n) acc[a][b][m][n] = (acc_t){0, 0, 0, 0};
    bf16x8 At[4][2], B0[2][2], B1[2][2];
    const char* cA = (const char*)g.A + (size_t)cur.pm * tstep; const char* cB = (const char*)g.Bt + (size_t)cur.pn * tstep;
    PG8_STAGE(PG8_SB(0, 0), cB, voffB); PG8_STAGE(PG8_SA(0, 0), cA, voffA); PG8_STAGE(PG8_SB(0, 1), cB + hstep, voffB); PG8_STAGE(PG8_SA(0, 1), cA + hstep, voffA);
    if (wr == 1) PG8_BAR;
    PG8_WAIT_V(4); PG8_BAR;
    PG8_STAGE(PG8_SB(1, 0), cB + kstep, voffB); PG8_STAGE(PG8_SA(1, 0), cA + kstep, voffA); PG8_STAGE(PG8_SB(1, 1), cB + hstep + kstep, voffB);
    PG8_WAIT_V(6); PG8_BAR;
    for (;;) {
        const bool has_next = S.next(ui + 1, nxt);
        const char* nA = has_next ? (const char*)g.A + (size_t)nxt.pm * tstep : cA; const char* nB = has_next ? (const char*)g.Bt + (size_t)nxt.pn * tstep : cB;
        for (int t = 0; t < nt; t += 2) {
            const bool last = (t == nt - 2);
            const char* a1 = cA + (size_t)(t + 1) * kstep;
            const char* a2 = last ? nA : cA + (size_t)(t + 2) * kstep; const char* b2 = last ? nB : cB + (size_t)(t + 2) * kstep;
            const char* a3 = a2 + kstep; const char* b3 = b2 + kstep;
            PG8_LDB(B0, 0, 0); PG8_SCHED; PG8_LDA(At, 0, 0); PG8_STAGE(PG8_SA(1, 1), a1 + hstep, voffA);
            PG8_WAIT_L(8); PG8_BAR; PG8_WAIT_L(0); PG8_MMA(0, 0, At, B0); PG8_BAR; PG8_SCHED;
            PG8_LDB(B1, 0, 1); PG8_STAGE(PG8_SB(0, 0), b2, voffB);
            PG8_BAR; PG8_WAIT_L(0); PG8_MMA(0, 1, At, B1); PG8_BAR;
            PG8_LDA(At, 0, 1); PG8_STAGE(PG8_SA(0, 0), a2, voffA);
            PG8_BAR; PG8_WAIT_L(0); PG8_MMA(1, 0, At, B0); PG8_BAR; PG8_SCHED;
            PG8_STAGE(PG8_SB(0, 1), b2 + hstep, voffB);
            PG8_WAIT_V(6); PG8_BAR; PG8_MMA(1, 1, At, B1); PG8_BAR;
            PG8_LDB(B0, 1, 0); PG8_SCHED; PG8_LDA(At, 1, 0); PG8_STAGE(PG8_SA(0, 1), a2 + hstep, voffA);
            PG8_WAIT_L(8); PG8_BAR; PG8_WAIT_L(0); PG8_MMA(0, 0, At, B0); PG8_BAR; PG8_SCHED;
            PG8_LDB(B1, 1, 1); PG8_STAGE(PG8_SB(1, 0), b3, voffB);
            PG8_BAR; PG8_WAIT_L(0); PG8_MMA(0, 1, At, B1); PG8_BAR;
            PG8_LDA(At, 1, 1); PG8_STAGE(PG8_SA(1, 0), a3, voffA);
            PG8_BAR; PG8_WAIT_L(0); PG8_MMA(1, 0, At, B0); PG8_BAR; PG8_SCHED;
            PG8_STAGE(PG8_SB(1, 1), b3 + hstep, voffB);
            PG8_WAIT_V(6); PG8_BAR; PG8_MMA(1, 1, At, B1); PG8_BAR;
        }
        E(acc, cur, wr, wc, fr, fq);
        if (!has_next) break;
#pragma unroll
        for (int a = 0; a < 2; ++a)
#pragma unroll
            for (int b = 0; b < 2; ++b)
#pragma unroll
                for (int m = 0; m < 4; ++m)
#pragma unroll
                    for (int n = 0; n < 2; ++n) acc[a][b][m][n] = (acc_t){0, 0, 0, 0};
        cur = nxt; cA = nA; cB = nB; ++ui;
    }
    PG8_WAIT_V(0);
    if (wr == 0) PG8_BAR;
    PG8_BAR;
#undef PG8_SA
#undef PG8_SB
#undef PG8_STAGE
#undef PG8_LDA
#undef PG8_LDB
#undef PG8_MMA
#undef PG8_WAIT_V
#undef PG8_WAIT_L
#undef PG8_BAR
#undef PG8_SCHED
}
}

__device__ __forceinline__ void transpose_item(const float* W, int ldw, int K, bf16_t* WT, LAS float* scr, int kb, int src_col0, int dst_row0, int lane) {
    const int k0 = 64 * kb;
#pragma unroll 8
    for (int i = 0; i < 32; ++i) { const int kk = 2 * i + (lane >> 5); scr[kk * 33 + (lane & 31)] = W[(size_t)(k0 + kk) * ldw + src_col0 + (lane & 31)]; }
    LDS_WAIT();
    const int c = lane & 7;
#pragma unroll
    for (int j = 0; j < 4; ++j) { const int n = (lane >> 3) + 8 * j; const LAS float* s = scr + (8 * c) * 33 + n;
        u32x4 o; o.x = pk2(s[0 * 33], s[1 * 33]); o.y = pk2(s[2 * 33], s[3 * 33]); o.z = pk2(s[4 * 33], s[5 * 33]); o.w = pk2(s[6 * 33], s[7 * 33]);
        *(u32x4*)(WT + (size_t)(dst_row0 + n) * K + k0 + 8 * c) = o; }
    LDS_WAIT();
}

__device__ __forceinline__ void transpose_item_q(const float* W, int ldw, int K, signed char* WT, LAS float* scr, int kb, int src_col0, int dst_row0, int lane, const float* scale) {
    const int k0 = 64 * kb;
#pragma unroll 8
    for (int i = 0; i < 32; ++i) { const int kk = 2 * i + (lane >> 5); scr[kk * 33 + (lane & 31)] = W[(size_t)(k0 + kk) * ldw + src_col0 + (lane & 31)]; }
    LDS_WAIT();
    const int c = lane & 7;
#pragma unroll
    for (int j = 0; j < 4; ++j) { const int n = (lane >> 3) + 8 * j; const LAS float* s = scr + (8 * c) * 33 + n;
        const float sc = scale[dst_row0 + n], inv = sc > 0.f ? 1.0f / sc : 0.f;
        u32x2 o;
        o.x = ((unsigned)(int)rintf(s[0 * 33] * inv) & 255u) | (((unsigned)(int)rintf(s[1 * 33] * inv) & 255u) << 8) | (((unsigned)(int)rintf(s[2 * 33] * inv) & 255u) << 16) | (((unsigned)(int)rintf(s[3 * 33] * inv) & 255u) << 24);
        o.y = ((unsigned)(int)rintf(s[4 * 33] * inv) & 255u) | (((unsigned)(int)rintf(s[5 * 33] * inv) & 255u) << 8) | (((unsigned)(int)rintf(s[6 * 33] * inv) & 255u) << 16) | (((unsigned)(int)rintf(s[7 * 33] * inv) & 255u) << 24);
        *(u32x2*)(WT + (size_t)(dst_row0 + n) * K + k0 + 8 * c) = o; }
    LDS_WAIT();
}

__device__ __forceinline__ void phase0(const Args& a, LAS unsigned char* lds) {
    const int tid = threadIdx.x, lane = tid & 63, wave = tid >> 6, G = gridDim.x;
    unsigned char* ws = a.ws;
    if (blockIdx.x == 0 && tid < 64) ((unsigned*)(ws + WS_BAR))[16 * tid] = 0u;
    if (blockIdx.x == 1) for (int i = tid; i < 3456; i += NTHR) ((unsigned*)(ws + WS_XB))[i] = 0u;
    {
        const float* c = a.in[1]; const float* w_ada = a.in[2]; const float* b_ada = a.in[3]; float* mod = (float*)(ws + WS_MOD);
        LAS float* sc = (LAS float*)lds;
        LAS float* red = (LAS float*)(lds + 32768);
        if ((int)blockIdx.x < 96) {
            for (int i = tid; i < 8192; i += NTHR) sc[i] = siluf(c[i]);
            __syncthreads();
            for (int item = blockIdx.x; item < 96; item += G) {
                const int n = item * 64 + lane; float acc[8];
#pragma unroll
                for (int b = 0; b < 8; ++b) acc[b] = 0.f;
                for (int k4 = 0; k4 < 32; ++k4) {
                    const int k = wave * 128 + k4 * 4;
                    float wv[4];
#pragma unroll
                    for (int j = 0; j < 4; ++j) wv[j] = w_ada[(size_t)(k + j) * NMODC + n];
#pragma unroll
                    for (int b = 0; b < 8; ++b) { const f32x4 s = *(const LAS f32x4*)(sc + b * 1024 + k);
                        acc[b] += s[0] * wv[0] + s[1] * wv[1] + s[2] * wv[2] + s[3] * wv[3]; }
                }
#pragma unroll
                for (int b = 0; b < 8; ++b) red[(wave * 8 + b) * 64 + lane] = acc[b];
                __syncthreads();
                { const int b = tid >> 6; float s = 0.f;
#pragma unroll
                  for (int w = 0; w < 8; ++w) s += red[(w * 8 + b) * 64 + lane];
                  mod[b * NMODC + n] = s + b_ada[n]; }
                __syncthreads();
            }
        }
        __syncthreads();
    }
    if ((int)blockIdx.x >= 96) {
        LAS float* red = (LAS float*)lds;
        for (int cb = (int)blockIdx.x - 96; cb < 104; cb += G - 96) {
            const bool isq = cb >= 56 && cb < 88, iso = cb >= 88; const int n = (iso ? cb - 88 : (isq ? cb - 56 : cb)) * 64 + lane;
            const float* W = iso ? a.in[13] : (isq ? a.in[15] : a.in[5]); const int ldw = iso ? 1024 : (isq ? 2048 : LDW_IN); const int col = (isq || iso) ? n : n + (n >= 2048 ? 8 : 0);
            float m = 0.f;
            for (int k = wave * 128; k < wave * 128 + 128; ++k) m = fmaxf(m, fabsf(W[(size_t)k * ldw + col]));
            red[wave * 64 + lane] = m;
            __syncthreads();
            if (wave == 0) {
#pragma unroll
                for (int w = 1; w < 8; ++w) m = fmaxf(m, red[w * 64 + lane]);
                ((float*)(ws + (iso ? WS_WOS : (isq ? WS_WQS : WS_WINS))))[n] = m * (1.0f / 127.0f);
            }
            __syncthreads();
        }
    }
    {
        const size_t gt = (size_t)blockIdx.x * NTHR + tid, NGT = (size_t)G * NTHR;
        float* wsm = (float*)(ws + WS_WSM);
        for (size_t i = gt; i < 8 * 1024; i += NGT) { const int j = (int)(i >> 10), k = (int)(i & 1023); wsm[i] = a.in[5][(size_t)k * LDW_IN + 2048 + j]; }
    }
}
__device__ __forceinline__ void phase0b(const Args& a, LAS unsigned char* lds) {
    const int tid = threadIdx.x, lane = tid & 63, wave = tid >> 6, G = gridDim.x;
    unsigned char* ws = a.ws;
    {
        const int gw = blockIdx.x * NWAVE + wave, NGW = G * NWAVE;
        LAS float* scr = (LAS float*)(lds + wave * 8704);
        bf16_t* win_t = (bf16_t*)(ws + WS_WIN_T);
        constexpr int I_IN = 16 * (NPROJ / 32);
        for (int it = gw; it < I_IN; it += NGW) {
            const int kb = it / (NPROJ / 32), nb = it % (NPROJ / 32), n0 = nb * 32; if (INPROJ_I8) transpose_item_q(a.in[5], LDW_IN, 1024, (signed char*)win_t, scr, kb, n0 + (n0 >= 2048 ? 8 : 0), n0, lane, (const float*)(ws + WS_WINS));
            else transpose_item(a.in[5], LDW_IN, 1024, win_t, scr, kb, n0 + (n0 >= 2048 ? 8 : 0), n0, lane);
        }
    }
    {
        const size_t gt = (size_t)blockIdx.x * NTHR + tid, NGT = (size_t)G * NTHR;
        const float* sk = a.in[16]; unsigned* o = (unsigned*)(ws + WS_SUBK);
        for (size_t i = gt; i < 16 * 128 * 128 / 2; i += NGT) o[i] = pk2(sk[2 * i], sk[2 * i + 1]);
    }
}

__device__ __forceinline__ void late_prep(const Args& a, LAS unsigned char* lds, int widx, int nw) {
    const int lane = threadIdx.x & 63, wave = threadIdx.x >> 6;
    unsigned char* ws = a.ws;
    {
        LAS float* scr = (LAS float*)(lds + wave * 8704);
        bf16_t* wout_t = (bf16_t*)(ws + WS_WOUT_T); bf16_t* wq_t = (bf16_t*)(ws + WS_WQ_T);
        constexpr int I_OUT = 16 * 32, I_Q = 16 * 64;
        for (int it = widx; it < I_OUT + I_Q; it += nw) {
            if (it < I_OUT) { const int kb = it / 32, nb = it % 32; transpose_item_q(a.in[13], 1024, 1024, (signed char*)wout_t, scr, kb, nb * 32, nb * 32, lane, (const float*)(ws + WS_WOS)); }
            else { const int r = it - I_OUT, kb = r / 64, nb = r % 64;
                if (QUERY_I8) transpose_item_q(a.in[15], 2048, 1024, (signed char*)wq_t, scr, kb, nb * 32, nb * 32, lane, (const float*)(ws + WS_WQS));
                else transpose_item(a.in[15], 2048, 1024, wq_t, scr, kb, nb * 32, nb * 32, lane); }
        }
    }
    {
        const int G = 0; (void)G;
        { const int gw = widx, NGW = nw;
          for (int row = gw; row < 2 * 16384; row += NGW) {
              const bool isv = row >= 16384; const int e = row & 16383;
              const f32x4* src = (const f32x4*)((isv ? a.in[18] : a.in[17]) + (size_t)e * 1024) + lane;
              f32x4 v[4]; float am = 0.f;
#pragma unroll
              for (int j = 0; j < 4; ++j) { v[j] = src[64 * j]; am = fmaxf(am, fmaxf(fmaxf(fabsf(v[j][0]), fabsf(v[j][1])), fmaxf(fabsf(v[j][2]), fabsf(v[j][3])))); }
              am = wave_max(am);
              const float inv = am > 0.f ? 127.0f / am : 0.f;
              unsigned char* dst = ws + (isv ? WS_VT : WS_UT);
#pragma unroll
              for (int j = 0; j < 4; ++j) {
                  const unsigned pk = ((unsigned)(int)rintf(v[j][0] * inv) & 255u) | (((unsigned)(int)rintf(v[j][1] * inv) & 255u) << 8) |
                                      (((unsigned)(int)rintf(v[j][2] * inv) & 255u) << 16) | (((unsigned)(int)rintf(v[j][3] * inv) & 255u) << 24);
                  const int sl = 2 * j + (lane >> 5);
                  *(unsigned*)(dst + ((size_t)sl * 16384 + e) * 128 + ((4 * lane) & 127)) = pk;
              }
              if (lane == 0) ((float*)(ws + (isv ? WS_VS : WS_US)))[e] = am * (1.0f / 127.0f);
          } }
    }
}

template <bool FIRST>
__device__ __forceinline__ void phase_norm(const Args& a, const float* src, const float* gain, int shift_off, int scale_off) {
    const bf16_t* srcb = (const bf16_t*)(a.ws + WS_X1B);
    constexpr int R = FIRST ? 2 : 4;
    const int wave = threadIdx.x >> 6;
    const int gw = blockIdx.x * NWAVE + wave, NGW = gridDim.x * NWAVE;
    const float* mod = (const float*)(a.ws + WS_MOD); const float* wsm = (const float*)(a.ws + WS_WSM);
    bf16_t* dst = (bf16_t*)(a.ws + WS_ACT); float* small = (float*)(a.ws + WS_SMALL);
    for (int tok0 = gw * R; tok0 < T_TOK; tok0 += NGW * R) {
        int lane = threadIdx.x & 63; asm volatile("" : "+v"(lane));
        f32x4 v[R][4]; float rstd[R];
#pragma unroll
        for (int q = 0; q < R; ++q)
#pragma unroll
            for (int j = 0; j < 4; ++j) {
                if (FIRST) v[q][j] = ((const f32x4*)(src + (size_t)(tok0 + q) * DM) + lane)[64 * j];
                else { const u32x2 w = ((const u32x2*)(srcb + (size_t)(tok0 + q) * DM) + lane)[64 * j]; v[q][j] = (f32x4){bf_lo(w.x), bf_hi(w.x), bf_lo(w.y), bf_hi(w.y)}; }
            }
#pragma unroll
        for (int q = 0; q < R; ++q) { float ss = 0.f;
#pragma unroll
            for (int j = 0; j < 4; ++j) ss += (v[q][j][0] * v[q][j][0] + v[q][j][1] * v[q][j][1]) + (v[q][j][2] * v[q][j][2] + v[q][j][3] * v[q][j][3]);
            rstd[q] = ss; }
#pragma unroll
        for (int q = 0; q < R; ++q) rstd[q] = rsqrtf(wave_sum(rstd[q]) * (1.0f / DM) + EPS);
        const float* mrow = mod + (size_t)(tok0 >> 12) * NMODC;
        float sa[R][8];
#pragma unroll
        for (int q = 0; q < R; ++q)
#pragma unroll
            for (int c = 0; c < 8; ++c) sa[q][c] = 0.f;
#pragma unroll
        for (int j = 0; j < 4; ++j) {
            const int d = 4 * lane + 256 * j;
            const f32x4 g = *(const f32x4*)(gain + d), sc = *(const f32x4*)(mrow + scale_off + d), sh = *(const f32x4*)(mrow + shift_off + d);
            const f32x4 gs = g * (1.0f + sc);
#pragma unroll
            for (int q = 0; q < R; ++q) {
                v[q][j] = v[q][j] * rstd[q] * gs + sh;
                if ((FIRST && !INPROJ_I8) || (!FIRST && !QUERY_I8)) { u32x2 o; o.x = pk2(v[q][j][0], v[q][j][1]); o.y = pk2(v[q][j][2], v[q][j][3]); *(u32x2*)(dst + (size_t)(tok0 + q) * DM + d) = o; }
            }
            if (FIRST) {
#pragma unroll
                for (int c = 0; c < 8; ++c) { const f32x4 w = *(const f32x4*)(wsm + c * 1024 + d);
#pragma unroll
                    for (int q = 0; q < R; ++q) sa[q][c] += (v[q][j][0] * w[0] + v[q][j][1] * w[1]) + (v[q][j][2] * w[2] + v[q][j][3] * w[3]); }
            }
            __builtin_amdgcn_sched_barrier(0);
        }
        if (!FIRST || INPROJ_I8) {
#pragma unroll
            for (int q = 0; q < R; ++q) {
                float am = 0.f;
#pragma unroll
                for (int j = 0; j < 4; ++j) am = fmaxf(am, fmaxf(fmaxf(fabsf(v[q][j][0]), fabsf(v[q][j][1])), fmaxf(fabsf(v[q][j][2]), fabsf(v[q][j][3]))));
                am = wave_max(am);
                const float inv = am > 0.f ? 127.0f / am : 0.f;
                unsigned* hq = (unsigned*)(a.ws + (FIRST ? WS_ACT : WS_HQ)) + (size_t)(tok0 + q) * 256;
#pragma unroll
                for (int j = 0; j < 4; ++j)
                    hq[lane + 64 * j] = ((unsigned)(int)rintf(v[q][j][0] * inv) & 255u) | (((unsigned)(int)rintf(v[q][j][1] * inv) & 255u) << 8) |
                                        (((unsigned)(int)rintf(v[q][j][2] * inv) & 255u) << 16) | (((unsigned)(int)rintf(v[q][j][3] * inv) & 255u) << 24);
                if (lane == 0) ((float*)(a.ws + (FIRST ? WS_H1S : WS_HS)))[tok0 + q] = am * (1.0f / 127.0f);
            }
        }
        if (FIRST) {
#pragma unroll
            for (int q = 0; q < R; ++q) {
                float ov = 0.f;
#pragma unroll
                for (int c = 0; c < 8; ++c) { const float s = wave_sum(sa[q][c]); if (lane == c) ov = s; }
                if (lane < 8) small[(size_t)(tok0 + q) * 8 + lane] = ov;
            }
        }
    }
}

typedef float f32x16 __attribute__((ext_vector_type(16)));
__device__ __forceinline__ unsigned cvt2(float lo, float hi) {
    typedef __bf16 bf2_t __attribute__((ext_vector_type(2)));
    bf2_t v; v[0] = (__bf16)lo; v[1] = (__bf16)hi; return __builtin_bit_cast(unsigned, v);
}
__device__ __forceinline__ int crow(int reg, int h) { return (reg & 3) + 8 * (reg >> 2) + 4 * h; }
constexpr int R_W = 0, R_QD = 16384, R_KDT = 32768, R_ATT = 49152, R_U = 57344;

template <int I> __device__ __forceinline__ void tsolve_load(f32x4 (&l)[8], const LAS float* Lb) {
#pragma unroll
    for (int j4 = 0; j4 < (I + 3) / 4; ++j4) l[j4] = *(const LAS f32x4*)(Lb + I * 68 + 4 * j4);
}
template <int I> __device__ __forceinline__ void tsolve_row(float (&x)[32], const LAS float* Lb, int c, f32x4 (&cur)[8], f32x4 (&nxt)[8]) {
    if constexpr (I + 1 < 32) { tsolve_load<I + 1>(nxt, Lb); __builtin_amdgcn_sched_barrier(0); }
    float a0 = 0.f, a1 = 0.f, a2 = 0.f, a3 = 0.f;
#pragma unroll
    for (int j4 = 0; j4 < (I + 3) / 4; ++j4) {
        const f32x4 l = cur[j4];
        if (4 * j4 + 0 < I) a0 += l[0] * x[4 * j4 + 0];
        if (4 * j4 + 1 < I) a1 += l[1] * x[4 * j4 + 1];
        if (4 * j4 + 2 < I) a2 += l[2] * x[4 * j4 + 2];
        if (4 * j4 + 3 < I) a3 += l[3] * x[4 * j4 + 3];
    }
    x[I] = (I == c ? 1.0f : 0.0f) - ((a0 + a1) + (a2 + a3));
}
template <int... Is> __device__ __forceinline__ void tsolve_all(float (&x)[32], const LAS float* Lb, int c, std::integer_sequence<int, Is...>) {
    f32x4 la[8], lb[8];
    tsolve_load<0>(la, Lb);
    ((Is % 2 == 0 ? tsolve_row<Is>(x, Lb, c, la, lb) : tsolve_row<Is>(x, Lb, c, lb, la)), ...);
}
__device__ __forceinline__ bf16x8 lda_split(const LAS unsigned char* p) {
    const u32x2 lo = *(const LAS u32x2*)p, hi = *(const LAS u32x2*)(p + 16);
    u32x4 v; v.x = lo.x; v.y = lo.y; v.z = hi.x; v.w = hi.y; return __builtin_bit_cast(bf16x8, v);
}
__device__ __forceinline__ bf16x8 pack8(const f32x16& x, int s) {
    u32x4 v; v.x = cvt2(x[8 * s], x[8 * s + 1]); v.y = cvt2(x[8 * s + 2], x[8 * s + 3]); v.z = cvt2(x[8 * s + 4], x[8 * s + 5]); v.w = cvt2(x[8 * s + 6], x[8 * s + 7]);
    return __builtin_bit_cast(bf16x8, v);
}

#ifndef DNP_DUP
#define DNP_DUP 0
#endif
#define DNP_REP(k) _Pragma("nounroll") for (int drep_ = 0; drep_ < 1 + ((DNP_DUP >> (k)) & 1); ++drep_)
constexpr int DNL_KBT = 98304, DNL_VBT = 116736, DNL_T = 135168, DNL_T11T = 144384;
__device__ __forceinline__ void dn_prep(const Args& a, LAS unsigned char* lds) {
    const bf16_t* proj = (const bf16_t*)(a.ws + WS_PROJ); const float* small = (const float*)(a.ws + WS_SMALL);
    const float* convw = a.in[6];
    LAS float* qs = (LAS float*)lds;
    LAS float* ks = (LAS float*)(lds + 32768);
    LAS float* vs = (LAS float*)(lds + 65536);
    LAS unsigned char* q16 = lds + 98304;
    LAS unsigned char* k16 = lds + 115712;
    LAS unsigned char* kb16 = lds + 133120;
    LAS float* sbeta = (LAS float*)(lds + 150528);
    LAS float* sG = sbeta + 64;
    LAS float* seG = sG + 64;
    LAS float* sbg = seG + 64;
    LAS float* Lm = (LAS float*)lds;
    float* gls = (float*)(a.ws + WS_GLS);
    u32x2 rawn[19];
    float bln = 0.f, dln = 0.f;
    f32x4 w[4]; int whd = -1;
    {
        const int tid0 = threadIdx.x, ci0 = blockIdx.x;
        if (tid0 < 384 && ci0 < 2048) {
            const int cgp = tid0 % 96, seg = tid0 / 96, which = cgp >> 5, c4 = (cgp & 31) * 4, col = which * 512 + ((ci0 >> 6) & 3) * 128 + c4;
#pragma unroll
            for (int r = 0; r < 19; ++r) { const int sp = (ci0 & 63) * 64 + 16 * seg - 3 + r;
                rawn[r] = *(const u32x2*)(proj + ((size_t)(ci0 >> 8) * SEQ + (sp < 0 ? 0 : sp)) * NPROJ + col); }
        }
        if (tid0 >= 448 && ci0 < 2048) { const size_t tk = (size_t)(ci0 >> 8) * SEQ + (ci0 & 63) * 64 + (tid0 - 448); bln = small[tk * 8 + ((ci0 >> 6) & 3)]; dln = small[tk * 8 + 4 + ((ci0 >> 6) & 3)]; }
#pragma unroll
        for (int j = 0; j < 4; ++j) w[j] = (f32x4){0.f, 0.f, 0.f, 0.f};
    }
    for (int ci = blockIdx.x; ci < 2048; ci += gridDim.x) {
        int tid = threadIdx.x; asm volatile("" : "+v"(tid));
        const int lane = tid & 63, wave = tid >> 6;
        const int b = ci >> 8, hd = (ci >> 6) & 3, n = ci & 63, s0 = n * 64; const size_t tok0 = (size_t)b * SEQ + s0;
        unsigned char* rec = a.ws + WS_DN + (size_t)ci * DN_REC;
        if (hd != whd) { whd = hd;
            if (tid < 384) { const int cgp = tid % 96, which = cgp >> 5, c4 = (cgp & 31) * 4, col = which * 512 + hd * 128 + c4;
#pragma unroll
                for (int j = 0; j < 4; ++j) w[j] = *(const f32x4*)(convw + j * 1536 + col); } }
        const float bl = bln, dl = dln;
        DNP_REP(0) if (tid < 384) {
            const int cgp = tid % 96, seg = tid / 96, which = cgp >> 5, c4 = (cgp & 31) * 4;
            u32x2 raw[19];
#pragma unroll
            for (int r = 0; r < 19; ++r) {
                const int sp = s0 + 16 * seg - 3 + r;
                raw[r] = (sp >= 0) ? rawn[r] : (u32x2){0u, 0u};
            }
            LAS float* dstp = (which == 0 ? qs : (which == 1 ? ks : vs)) + (16 * seg) * 128 + c4;
#pragma unroll
            for (int i = 0; i < 16; ++i) {
                f32x4 y = (f32x4){0.f, 0.f, 0.f, 0.f};
#pragma unroll
                for (int j = 0; j < 4; ++j) { const u32x2 u = raw[i + j];
                    y[0] += w[j][0] * bf_lo(u.x); y[1] += w[j][1] * bf_hi(u.x); y[2] += w[j][2] * bf_lo(u.y); y[3] += w[j][3] * bf_hi(u.y); }
                f32x4 r; r[0] = siluf(y[0]); r[1] = siluf(y[1]); r[2] = siluf(y[2]); r[3] = siluf(y[3]);
                *(LAS f32x4*)(dstp + i * 128) = r;
            }
        }
        if (wave == 7) {
            const float Aexp = __expf(a.in[7][hd]), dtb = a.in[8][hd];
            const float dlb = dl + dtb;
            const float sp = fmaxf(dlb, 0.f) + log1pf(expf(-fabsf(dlb)));
            float Gc = -Aexp * sp;
#pragma unroll
            for (int o = 1; o < 64; o <<= 1) { const float t = __shfl_up(Gc, o); if (lane >= o) Gc += t; }
            const float bt = 1.0f / (1.0f + expf(-bl)), eg = expf(Gc);
            sbeta[lane] = bt; sG[lane] = Gc; seG[lane] = eg; sbg[lane] = bt * eg;
        }
        __syncthreads();
        {
            const int cn = ci + (int)gridDim.x;
            if (tid < 384 && cn < 2048) {
                const int cgp = tid % 96, seg = tid / 96, which = cgp >> 5, c4 = (cgp & 31) * 4, col = which * 512 + ((cn >> 6) & 3) * 128 + c4;
#pragma unroll
                for (int r = 0; r < 19; ++r) { const int sp = (cn & 63) * 64 + 16 * seg - 3 + r;
                    rawn[r] = *(const u32x2*)(proj + ((size_t)(cn >> 8) * SEQ + (sp < 0 ? 0 : sp)) * NPROJ + col); }
            }
            if (tid >= 448 && cn < 2048) { const size_t tk = (size_t)(cn >> 8) * SEQ + (cn & 63) * 64 + (tid - 448); bln = small[tk * 8 + ((cn >> 6) & 3)]; dln = small[tk * 8 + 4 + ((cn >> 6) & 3)]; }
        }
        {
            const bool isk = wave >= 4;
            LAS float* pb = (isk ? ks : qs) + ((wave & 3) * 16) * 128 + 2 * lane;
#pragma unroll
            for (int r4 = 0; r4 < 4; ++r4) {
                f32x2 v[4]; float ss[4];
#pragma unroll
                for (int q = 0; q < 4; ++q) { v[q] = *(LAS f32x2*)(pb + (r4 * 4 + q) * 128); ss[q] = v[q][0] * v[q][0] + v[q][1] * v[q][1]; }
#pragma unroll
                for (int q = 0; q < 4; ++q) ss[q] = wave_sum(ss[q]);
#pragma unroll
                for (int q = 0; q < 4; ++q) { const float sc = rsqrtf(ss[q] + EPS) * (isk ? 1.0f : 0.08838834764831845f);
                    v[q][0] *= sc; v[q][1] *= sc; *(LAS f32x2*)(pb + (r4 * 4 + q) * 128) = v[q]; }
            }
        }
        __syncthreads();
        DNP_REP(1) for (int idx = tid; idx < 1024; idx += NTHR) {
            const int i = idx >> 4, d0 = (idx & 15) * 8; const float bt = sbeta[i], eg = seG[i];
            const f32x4 q0 = *(const LAS f32x4*)(qs + i * 128 + d0), q1 = *(const LAS f32x4*)(qs + i * 128 + d0 + 4);
            const f32x4 k0 = *(const LAS f32x4*)(ks + i * 128 + d0), k1 = *(const LAS f32x4*)(ks + i * 128 + d0 + 4);
            u32x4 o;
            o.x = cvt2(q0[0], q0[1]); o.y = cvt2(q0[2], q0[3]); o.z = cvt2(q1[0], q1[1]); o.w = cvt2(q1[2], q1[3]); *(LAS u32x4*)(q16 + i * 272 + d0 * 2) = o;
            o.x = cvt2(k0[0], k0[1]); o.y = cvt2(k0[2], k0[3]); o.z = cvt2(k1[0], k1[1]); o.w = cvt2(k1[2], k1[3]); *(LAS u32x4*)(k16 + i * 272 + d0 * 2) = o;
            o.x = cvt2(k0[0] * bt, k0[1] * bt); o.y = cvt2(k0[2] * bt, k0[3] * bt); o.z = cvt2(k1[0] * bt, k1[1] * bt); o.w = cvt2(k1[2] * bt, k1[3] * bt); *(LAS u32x4*)(kb16 + i * 272 + d0 * 2) = o;
            o.x = cvt2(q0[0] * eg, q0[1] * eg); o.y = cvt2(q0[2] * eg, q0[3] * eg); o.z = cvt2(q1[0] * eg, q1[1] * eg); o.w = cvt2(q1[2] * eg, q1[3] * eg);
            *(u32x4*)(rec + R_QD + (i * 128 + d0) * 2) = o;
        }
        DNP_REP(1) for (int idx = tid; idx < 1024; idx += NTHR) {
            const int d = idx & 127, i0 = (idx >> 7) * 8; const float G63 = sG[63];
            float v[8];
#pragma unroll
            for (int jj = 0; jj < 8; ++jj) v[jj] = ks[(i0 + jj) * 128 + d] * __expf(G63 - sG[i0 + jj]);
            u32x4 o; o.x = cvt2(v[0], v[1]); o.y = cvt2(v[2], v[3]); o.z = cvt2(v[4], v[5]); o.w = cvt2(v[6], v[7]);
            *(u32x4*)(rec + R_KDT + (d * 64 + i0) * 2) = o;
        }
        if (tid == 0) gls[ci] = seG[63];
        __syncthreads();
        DNP_REP(2) {
            const int which = wave >> 2, mt = (wave >> 1) & 1, nt = wave & 1, r32 = lane & 31, h = lane >> 5;
            const LAS unsigned char* Ab = (which ? q16 : kb16) + (32 * mt + r32) * 272 + h * 16;
            const LAS unsigned char* Bb = k16 + (32 * nt + r32) * 272 + h * 16;
            f32x16 acc;
#pragma unroll
            for (int r = 0; r < 16; ++r) acc[r] = 0.f;
#pragma unroll
            for (int kk = 0; kk < 8; ++kk) {
                const bf16x8 av = *(const LAS bf16x8*)(Ab + kk * 32), bv = *(const LAS bf16x8*)(Bb + kk * 32);
                acc = __builtin_amdgcn_mfma_f32_32x32x16_bf16(av, bv, acc, 0, 0, 0);
            }
            const int j = 32 * nt + r32; const float Gj = sG[j];
#pragma unroll
            for (int r = 0; r < 16; ++r) {
                const int i = 32 * mt + crow(r, h);
                const float val = acc[r] * __expf(sG[i] - Gj);
                if (which == 0) Lm[i * 68 + j] = (i > j) ? val : 0.f;
                else *(bf16_t*)(rec + R_ATT + (i * 64 + j) * 2) = (bf16_t)((i >= j) ? f2bf(val) : 0u);
            }
        }
        __syncthreads();
        const int n32 = lane & 31, h32 = lane >> 5;
        DNP_REP(3) {
        if (wave == 0) {
            int ln = lane; asm volatile("" : "+v"(ln));
            const int r = ln >> 5, c = ln & 31;
            float x[32];
            tsolve_all(x, Lm + (32 * r) * 68 + 32 * r, c, std::make_integer_sequence<int, 32>{});
            if (r == 0) {
#pragma unroll
                for (int q = 0; q < 4; ++q) { u32x4 o; o.x = cvt2(x[8 * q], x[8 * q + 1]); o.y = cvt2(x[8 * q + 2], x[8 * q + 3]); o.z = cvt2(x[8 * q + 4], x[8 * q + 5]); o.w = cvt2(x[8 * q + 6], x[8 * q + 7]);
                    *(LAS u32x4*)(lds + DNL_T11T + c * 80 + q * 16) = o; }
            }
            LAS bf16_t* Tp = (LAS bf16_t*)(lds + DNL_T) + (32 * r) * 72 + 32 * r + c;
#pragma unroll
            for (int i = 0; i < 32; ++i) Tp[i * 72] = (bf16_t)f2bf(x[i]);
            asm volatile("s_waitcnt lgkmcnt(0)" ::: "memory"); __builtin_amdgcn_wave_barrier();
            const int m = ln & 31, h = ln >> 5;
            f32x16 ax, a2;
#pragma unroll
            for (int q = 0; q < 16; ++q) { ax[q] = 0.f; a2[q] = 0.f; }
#pragma unroll
            for (int s = 0; s < 2; ++s) {
                const f32x4 l0 = *(const LAS f32x4*)(Lm + (32 + m) * 68 + 16 * s + 8 * h), l1 = *(const LAS f32x4*)(Lm + (32 + m) * 68 + 16 * s + 8 * h + 4);
                u32x4 av; av.x = cvt2(l0[0], l0[1]); av.y = cvt2(l0[2], l0[3]); av.z = cvt2(l1[0], l1[1]); av.w = cvt2(l1[2], l1[3]);
                const bf16x8 bv = *(const LAS bf16x8*)(lds + DNL_T11T + m * 80 + (16 * s + 8 * h) * 2);
                ax = __builtin_amdgcn_mfma_f32_32x32x16_bf16(__builtin_bit_cast(bf16x8, av), bv, ax, 0, 0, 0);
            }
#pragma unroll
            for (int s = 0; s < 2; ++s)
                a2 = __builtin_amdgcn_mfma_f32_32x32x16_bf16(lda_split(lds + DNL_T + (32 + m) * 144 + (32 + 16 * s + 4 * h) * 2), pack8(ax, s), a2, 0, 0, 0);
            LAS bf16_t* T21 = (LAS bf16_t*)(lds + DNL_T) + 32 * 72 + m;
#pragma unroll
            for (int q = 0; q < 16; ++q) T21[crow(q, h) * 72] = (bf16_t)f2bf(-a2[q]);
        } else {
            for (int idx = tid - 64; idx < 2048; idx += NTHR - 64) {
                const int c = idx & 127, jr = (idx >> 7) & 7, wh = idx >> 10;
                const LAS float* sp_ = (wh ? vs : ks) + c; const LAS float* sc = (wh ? sbeta : sbg) + 8 * jr;
                float v[8];
#pragma unroll
                for (int jj = 0; jj < 8; ++jj) v[jj] = sp_[(8 * jr + jj) * 128] * sc[jj];
                u32x4 o; o.x = cvt2(v[0], v[1]); o.y = cvt2(v[2], v[3]); o.z = cvt2(v[4], v[5]); o.w = cvt2(v[6], v[7]);
                *(LAS u32x4*)(lds + (wh ? DNL_VBT : DNL_KBT) + c * 144 + jr * 16) = o;
            }
        }
        }
        __syncthreads();
        {
            const bool isw = wave < 4;
            const LAS unsigned char* Bt = lds + (isw ? DNL_KBT : DNL_VBT) + (32 * (wave & 3) + n32) * 144 + h32 * 16;
            const LAS unsigned char* Ta = lds + DNL_T + n32 * 144 + h32 * 16;
            bf16x8 bv[4], t0[2], t1[4];
#pragma unroll
            for (int s = 0; s < 4; ++s) { bv[s] = *(const LAS bf16x8*)(Bt + s * 32); t1[s] = *(const LAS bf16x8*)(Ta + 32 * 144 + s * 32); }
#pragma unroll
            for (int s = 0; s < 2; ++s) t0[s] = *(const LAS bf16x8*)(Ta + s * 32);
            f32x16 c0, c1;
#pragma unroll
            for (int q = 0; q < 16; ++q) { c0[q] = 0.f; c1[q] = 0.f; }
            if (isw) {
#pragma unroll
                for (int s = 0; s < 2; ++s) c0 = __builtin_amdgcn_mfma_f32_32x32x16_bf16(bv[s], t0[s], c0, 0, 0, 0);
#pragma unroll
                for (int s = 0; s < 4; ++s) c1 = __builtin_amdgcn_mfma_f32_32x32x16_bf16(bv[s], t1[s], c1, 0, 0, 0);
                unsigned char* dst = rec + R_W + (size_t)(wave * 4096 + lane * 16);
                *(u32x4*)dst = __builtin_bit_cast(u32x4, pack8(c0, 0)); *(u32x4*)(dst + 1024) = __builtin_bit_cast(u32x4, pack8(c0, 1));
                *(u32x4*)(dst + 2048) = __builtin_bit_cast(u32x4, pack8(c1, 0)); *(u32x4*)(dst + 3072) = __builtin_bit_cast(u32x4, pack8(c1, 1));
            } else {
#pragma unroll
                for (int s = 0; s < 2; ++s) c0 = __builtin_amdgcn_mfma_f32_32x32x16_bf16(t0[s], bv[s], c0, 0, 0, 0);
#pragma unroll
                for (int s = 0; s < 4; ++s) c1 = __builtin_amdgcn_mfma_f32_32x32x16_bf16(t1[s], bv[s], c1, 0, 0, 0);
                unsigned char* dst = rec + R_U + (size_t)(((wave - 4) * 64 + lane) * 64);
                *(u32x4*)dst = __builtin_bit_cast(u32x4, pack8(c0, 0)); *(u32x4*)(dst + 16) = __builtin_bit_cast(u32x4, pack8(c0, 1));
                *(u32x4*)(dst + 32) = __builtin_bit_cast(u32x4, pack8(c1, 0)); *(u32x4*)(dst + 48) = __builtin_bit_cast(u32x4, pack8(c1, 1));
            }
        }
    }
    __syncthreads();
}

constexpr int DNB_W = 0, DNB_QD = 16896, DNB_KDT = 33792, DNB_ATT = 51200, DNB_U = 59904  , DNB_GL = 80384, DNB_SZ = 80400;
__device__ __forceinline__ void dn_issue_chunk(const unsigned char* rec, const float* glp, u32x4 (&v)[18], float& gl, int tl) {
    asm volatile("" : "+v"(tl));
#pragma unroll
    for (int i = 0; i < 18; ++i) v[i] = *(const u32x4*)(rec + (size_t)(tl + 256 * i) * 16);
    gl = *glp;
}
__device__ __forceinline__ void dn_write_chunk(const u32x4 (&v)[18], float gl, LAS unsigned char* buf, int tl) {
    asm volatile("" : "+v"(tl));
#pragma unroll
    for (int i = 0; i < 18; ++i) {
        const int q = tl + 256 * i;
        LAS unsigned char* d;
        if (i < 4) d = buf + DNB_W + q * 16;
        else if (i < 8) d = buf + DNB_QD + ((q - 1024) >> 4) * 264 + (q & 15) * 16;
        else if (i < 12) d = buf + DNB_KDT + ((q - 2048) >> 3) * 136 + (q & 7) * 16;
        else if (i < 14) d = buf + DNB_ATT + ((q - 3072) >> 3) * 136 + (q & 7) * 16;
        else d = buf + DNB_U + ((q - 3584) >> 2) * 80 + (q & 3) * 16;
        u32x2 lo, hi; lo.x = v[i].x; lo.y = v[i].y; hi.x = v[i].z; hi.y = v[i].w;
        *(LAS u32x2*)d = lo; *(LAS u32x2*)(d + 8) = hi;
    }
    if (tl == 0) *(LAS float*)(buf + DNB_GL) = gl;
}
__device__ __forceinline__ void dn_gate_norm(const Args& a) {
    const int lane = threadIdx.x & 63, wave = threadIdx.x >> 6;
    const int gw = blockIdx.x * NWAVE + wave, NGW = gridDim.x * NWAVE;
    const bf16_t* oraw = (const bf16_t*)a.out; const bf16_t* proj = (const bf16_t*)(a.ws + WS_PROJ); const bf16_t* mixed = (const bf16_t*)(a.ws + WS_ACT); const float* ogain = a.in[9];
    unsigned char* mq = a.ws + WS_MQ; float* ms = (float*)(a.ws + WS_MS);
    const f32x4 g0 = *(const f32x4*)(ogain + (lane & 15) * 8), g1 = *(const f32x4*)(ogain + (lane & 15) * 8 + 4);
    for (int tok0 = gw * 2; tok0 < T_TOK; tok0 += NGW * 2) {
        u32x4 ov[2], zv[2], sv[2];
#pragma unroll
        for (int q = 0; q < 2; ++q) { const size_t tok = (size_t)(tok0 + q);
            ov[q] = *(const u32x4*)(oraw + tok * 512 + lane * 8); zv[q] = *(const u32x4*)(proj + tok * NPROJ + 1536 + lane * 8); sv[q] = *(const u32x4*)(mixed + tok * DM + 512 + lane * 8); }
#pragma unroll
        for (int q = 0; q < 2; ++q) {
            float o[8], z[8], s[8];
#pragma unroll
            for (int c = 0; c < 4; ++c) { o[2 * c] = bf_lo(ov[q][c]); o[2 * c + 1] = bf_hi(ov[q][c]); z[2 * c] = bf_lo(zv[q][c]); z[2 * c + 1] = bf_hi(zv[q][c]); s[2 * c] = bf_lo(sv[q][c]); s[2 * c + 1] = bf_hi(sv[q][c]); }
            float ss = 0.f;
#pragma unroll
            for (int c = 0; c < 8; ++c) ss += o[c] * o[c];
            ss += dpp_<0xB1>(ss); ss += dpp_<0x4E>(ss); ss += dpp_<0x141>(ss); ss += dpp_<0x140>(ss);
            const float r = rsqrtf(ss * (1.0f / 128.0f) + EPS);
            float am = 0.f;
#pragma unroll
            for (int c = 0; c < 8; ++c) { o[c] = o[c] * r * (c < 4 ? g0[c] : g1[c - 4]) * siluf(z[c]); am = fmaxf(am, fmaxf(fabsf(o[c]), fabsf(s[c]))); }
            am = wave_max(am);
            const float inv = am > 0.f ? 127.0f / am : 0.f;
            u32x2 od, os;
            od.x = ((unsigned)(int)rintf(o[0] * inv) & 255u) | (((unsigned)(int)rintf(o[1] * inv) & 255u) << 8) | (((unsigned)(int)rintf(o[2] * inv) & 255u) << 16) | (((unsigned)(int)rintf(o[3] * inv) & 255u) << 24);
            od.y = ((unsigned)(int)rintf(o[4] * inv) & 255u) | (((unsigned)(int)rintf(o[5] * inv) & 255u) << 8) | (((unsigned)(int)rintf(o[6] * inv) & 255u) << 16) | (((unsigned)(int)rintf(o[7] * inv) & 255u) << 24);
            os.x = ((unsigned)(int)rintf(s[0] * inv) & 255u) | (((unsigned)(int)rintf(s[1] * inv) & 255u) << 8) | (((unsigned)(int)rintf(s[2] * inv) & 255u) << 16) | (((unsigned)(int)rintf(s[3] * inv) & 255u) << 24);
            os.y = ((unsigned)(int)rintf(s[4] * inv) & 255u) | (((unsigned)(int)rintf(s[5] * inv) & 255u) << 8) | (((unsigned)(int)rintf(s[6] * inv) & 255u) << 16) | (((unsigned)(int)rintf(s[7] * inv) & 255u) << 24);
            const size_t tok = (size_t)(tok0 + q);
            *(u32x2*)(mq + tok * 1024 + lane * 8) = od; *(u32x2*)(mq + tok * 1024 + 512 + lane * 8) = os;
            if (lane == 0) ms[tok] = am * (1.0f / 127.0f);
        }
    }
}
__device__ __forceinline__ void dn_scan2(const Args& a, LAS unsigned char* lds) {
    const int tid = threadIdx.x, lane = tid & 63, wave = __builtin_amdgcn_readfirstlane(tid >> 6);
    const int bh = blockIdx.x >> 1, dvh = blockIdx.x & 1, b = bh >> 2, hd = bh & 3;
    const unsigned char* recs = a.ws + WS_DN + (size_t)bh * 64 * DN_REC;
    const float* gls = (const float*)(a.ws + WS_GLS) + bh * 64;
    bf16_t* oraw = (bf16_t*)a.out;
    if (wave >= 4) {
        u32x4 pv[18]; float pgl;
        dn_issue_chunk(recs, gls, pv, pgl, tid - 256); dn_write_chunk(pv, pgl, lds, tid - 256); dn_issue_chunk(recs + DN_REC, gls + 1, pv, pgl, tid - 256);
        __syncthreads();
        for (int n = 0; n < 64; ++n) {
            if (n + 1 < 64) dn_write_chunk(pv, pgl, lds + ((n + 1) & 1) * DNB_SZ, tid - 256);
            if (n + 2 < 64) dn_issue_chunk(recs + (size_t)(n + 2) * DN_REC, gls + n + 2, pv, pgl, tid - 256);
            __syncthreads();
        }
        return;
    }
    if (wave >= 2) {
        __syncthreads();
        for (int n = 0; n < 64; ++n) __syncthreads();
        return;
    }
    const int cw = dvh * 2 + wave;
    f32x16 S[4]; bf16x8 BS[8];
#pragma unroll
    for (int kt = 0; kt < 4; ++kt)
#pragma unroll
        for (int r = 0; r < 16; ++r) S[kt][r] = 0.f;
#pragma unroll
    for (int ks = 0; ks < 8; ++ks) BS[ks] = (bf16x8){0, 0, 0, 0, 0, 0, 0, 0};
    __syncthreads();
    for (int n = 0; n < 64; ++n) {
        {
            int lane_o = lane; asm volatile("" : "+v"(lane_o));
            const int r32 = lane_o & 31, h = lane_o >> 5;
            const LAS unsigned char* B0 = lds + (n & 1) * DNB_SZ;
            const float gl = *(const LAS float*)(B0 + DNB_GL);
            const int koff = 8 * h;
            bf16x8 BV[4];
            {
                bf16x8 fa[16];
#pragma unroll
                for (int ks = 0; ks < 8; ++ks) { fa[2 * ks] = *(const LAS bf16x8*)(B0 + DNB_W + ((ks >> 1) * 4 + (ks & 1)) * 1024 + lane_o * 16); fa[2 * ks + 1] = *(const LAS bf16x8*)(B0 + DNB_W + ((ks >> 1) * 4 + 2 + (ks & 1)) * 1024 + lane_o * 16); }
                const LAS unsigned char* up = B0 + DNB_U + (cw * 64 + lane_o) * 80;
                u32x4 uq[4];
#pragma unroll
                for (int c = 0; c < 4; ++c) uq[c] = *(const LAS u32x4*)(up + c * 16);
                __builtin_amdgcn_sched_barrier(0);
                f32x16 X0, X1;
#pragma unroll
                for (int r = 0; r < 16; ++r) { X0[r] = 0.f; X1[r] = 0.f; }
#pragma unroll
                for (int ks = 0; ks < 8; ++ks) {
                    X0 = __builtin_amdgcn_mfma_f32_32x32x16_bf16(fa[2 * ks], BS[ks], X0, 0, 0, 0);
                    X1 = __builtin_amdgcn_mfma_f32_32x32x16_bf16(fa[2 * ks + 1], BS[ks], X1, 0, 0, 0);
                }
#pragma unroll
                for (int r = 0; r < 16; ++r) { const unsigned w0 = uq[r >> 3][(r >> 1) & 3], w1 = uq[2 + (r >> 3)][(r >> 1) & 3];
                    X0[r] = ((r & 1) ? bf_hi(w0) : bf_lo(w0)) - X0[r]; X1[r] = ((r & 1) ? bf_hi(w1) : bf_lo(w1)) - X1[r]; }
                BV[0] = pack8(X0, 0); BV[1] = pack8(X0, 1); BV[2] = pack8(X1, 0); BV[3] = pack8(X1, 1);
            }
            __builtin_amdgcn_sched_barrier(0);
            {
                bf16x8 fq[16], ft[8];
#pragma unroll
                for (int ks = 0; ks < 8; ++ks) { fq[2 * ks] = lda_split(B0 + DNB_QD + r32 * 264 + ks * 32 + koff); fq[2 * ks + 1] = lda_split(B0 + DNB_QD + (32 + r32) * 264 + ks * 32 + koff); }
                __builtin_amdgcn_sched_barrier(0);
                f32x16 O0, O1;
#pragma unroll
                for (int r = 0; r < 16; ++r) { O0[r] = 0.f; O1[r] = 0.f; }
#pragma unroll
                for (int ks = 0; ks < 4; ++ks) {
                    O0 = __builtin_amdgcn_mfma_f32_32x32x16_bf16(fq[2 * ks], BS[ks], O0, 0, 0, 0);
                    O1 = __builtin_amdgcn_mfma_f32_32x32x16_bf16(fq[2 * ks + 1], BS[ks], O1, 0, 0, 0);
                }
                __builtin_amdgcn_sched_barrier(0);
#pragma unroll
                for (int cs = 0; cs < 4; ++cs) { ft[2 * cs] = lda_split(B0 + DNB_ATT + r32 * 136 + cs * 32 + koff); ft[2 * cs + 1] = lda_split(B0 + DNB_ATT + (32 + r32) * 136 + cs * 32 + koff); }
                __builtin_amdgcn_sched_barrier(0);
#pragma unroll
                for (int ks = 4; ks < 8; ++ks) {
                    O0 = __builtin_amdgcn_mfma_f32_32x32x16_bf16(fq[2 * ks], BS[ks], O0, 0, 0, 0);
                    O1 = __builtin_amdgcn_mfma_f32_32x32x16_bf16(fq[2 * ks + 1], BS[ks], O1, 0, 0, 0);
                }
#pragma unroll
                for (int cs = 0; cs < 4; ++cs) {
                    O0 = __builtin_amdgcn_mfma_f32_32x32x16_bf16(ft[2 * cs], BV[cs], O0, 0, 0, 0);
                    O1 = __builtin_amdgcn_mfma_f32_32x32x16_bf16(ft[2 * cs + 1], BV[cs], O1, 0, 0, 0);
                }
                bf16_t* obu = oraw + ((size_t)b * SEQ + n * 64) * 512 + hd * 128 + 32 * cw;
                const unsigned lo = (unsigned)((4 * h) * 512 + r32);
#pragma unroll
                for (int r = 0; r < 16; ++r) { obu[lo + (unsigned)(((r & 3) + 8 * (r >> 2)) * 512)] = (bf16_t)f2bf(O0[r]); obu[lo + (unsigned)((32 + (r & 3) + 8 * (r >> 2)) * 512)] = (bf16_t)f2bf(O1[r]); }
            }
            __builtin_amdgcn_sched_barrier(0);
            {
                bf16x8 fk[16];
#pragma unroll
                for (int kt = 0; kt < 4; ++kt)
#pragma unroll
                    for (int cs = 0; cs < 4; ++cs) fk[kt * 4 + cs] = lda_split(B0 + DNB_KDT + (32 * kt + r32) * 136 + cs * 32 + koff);
#pragma unroll
                for (int kt = 0; kt < 4; ++kt)
#pragma unroll
                    for (int r = 0; r < 16; ++r) S[kt][r] *= gl;
                __builtin_amdgcn_sched_barrier(0);
#pragma unroll
                for (int cs = 0; cs < 4; ++cs)
#pragma unroll
                    for (int kt = 0; kt < 4; ++kt) S[kt] = __builtin_amdgcn_mfma_f32_32x32x16_bf16(fk[kt * 4 + cs], BV[cs], S[kt], 0, 0, 0);
            }
#pragma unroll
            for (int kt = 0; kt < 4; ++kt) { BS[2 * kt] = pack8(S[kt], 0); BS[2 * kt + 1] = pack8(S[kt], 1); }
        }
        __syncthreads();
    }
}

__device__ __forceinline__ void sb_prep(const Args& a) {
    const int lane = threadIdx.x & 63, wave = threadIdx.x >> 6;
    const int gw = blockIdx.x * NWAVE + wave, NGW = gridDim.x * NWAVE;
    bf16_t* proj = (bf16_t*)(a.ws + WS_PROJ);
    const float* gq = a.in[10]; const float* gk = a.in[11];
    {
        const int sub = lane & 7;
        float gsc[8];
#pragma unroll
        for (int j = 0; j < 8; ++j) gsc[j] = gq[sub * 8 + j] * gk[sub * 8 + j] * 0.125f;
        for (int r0 = gw * 8; r0 < T_TOK * 16; r0 += NGW * 8) {
            const int row = r0 + (lane >> 3); const int isk = row & 1, hd = (row >> 1) & 7; const size_t tok = (size_t)(row >> 4);
            u32x4* p = (u32x4*)(proj + tok * NPROJ + 2048 + isk * 512 + hd * 64 + sub * 8);
            const u32x4 w = *p;
            float ss = dot2(w.x, w.x, 0.f); ss = dot2(w.y, w.y, ss); ss = dot2(w.z, w.z, ss); ss = dot2(w.w, w.w, ss);
            ss += dppf<0xB1>(ss); ss += dppf<0x4E>(ss); ss += dppf<0x141>(ss);
            const float rs = rsqrtf(ss * (1.0f / 64.0f) + EPS);
            u32x4 o;
            if (isk) { o.x = pk2(bf_lo(w.x) * rs, bf_hi(w.x) * rs); o.y = pk2(bf_lo(w.y) * rs, bf_hi(w.y) * rs); o.z = pk2(bf_lo(w.z) * rs, bf_hi(w.z) * rs); o.w = pk2(bf_lo(w.w) * rs, bf_hi(w.w) * rs); }
            else { o.x = pk2(bf_lo(w.x) * rs * gsc[0], bf_hi(w.x) * rs * gsc[1]); o.y = pk2(bf_lo(w.y) * rs * gsc[2], bf_hi(w.y) * rs * gsc[3]);
                   o.z = pk2(bf_lo(w.z) * rs * gsc[4], bf_hi(w.z) * rs * gsc[5]); o.w = pk2(bf_lo(w.w) * rs * gsc[6], bf_hi(w.w) * rs * gsc[7]); }
            *p = o;
        }
    }
    {
        bf16_t* VT = (bf16_t*)((unsigned char*)a.out + VT_OFF);
        for (int item = gw; item < 64 * 64; item += NGW) {
            const int bh = item >> 6, kt = item & 63, b = bh >> 3, h = bh & 7;
            const u32x4* src = (const u32x4*)(proj + ((size_t)b * SEQ + kt * 64 + lane) * NPROJ + 3072 + h * 64);
            u32x4 v[8];
#pragma unroll
            for (int j = 0; j < 8; ++j) v[j] = src[j];
            bf16_t* dst = VT + ((size_t)bh * 64) * SEQ + kt * 64 + lane;
#pragma unroll
            for (int j = 0; j < 8; ++j)
#pragma unroll
                for (int c = 0; c < 4; ++c) { dst[(size_t)(j * 8 + 2 * c) * SEQ] = (bf16_t)(v[j][c] & 0xffffu); dst[(size_t)(j * 8 + 2 * c + 1) * SEQ] = (bf16_t)(v[j][c] >> 16); }
        }
    }
}

__device__ __forceinline__ void sb_attn(const Args& a, int wave_id, int n_waves) {
    const int lane = threadIdx.x & 63, r32 = lane & 31, hh = lane >> 5;
    const bf16_t* proj = (const bf16_t*)(a.ws + WS_PROJ); bf16_t* mixed = (bf16_t*)(a.ws + WS_ACT);
    const bf16_t* VT = (const bf16_t*)((const unsigned char*)a.out + VT_OFF);
    const float* go = a.in[12];
    const int krow_l = (r32 & 19) | ((r32 & 4) << 1) | ((r32 & 8) >> 1);
    for (int item = wave_id; item < 64 * 128; item += n_waves) {
        const int tile = 127 - (item >> 6), bh = item & 63, b = bh >> 3, h = bh & 7;
        const int t0 = tile * 32, t = t0 + r32; const size_t tokb = (size_t)b * SEQ;
        bf16x8 qf[4];
#pragma unroll
        for (int ks = 0; ks < 4; ++ks) qf[ks] = *(const bf16x8*)(proj + (tokb + t) * NPROJ + 2048 + h * 64 + 16 * ks + 8 * hh);
        f32x16 O0, O1;
#pragma unroll
        for (int r = 0; r < 16; ++r) { O0[r] = 0.f; O1[r] = 0.f; }
        float R = 0.f;
        const bf16_t* kbase = proj + (tokb + krow_l) * NPROJ + 2560 + h * 64 + 8 * hh;
        const bf16_t* vbase = VT + ((size_t)bh * 64 + r32) * SEQ + 8 * hh;
        for (int kb = tile; kb >= 0; --kb) {
            const int k0 = kb * 32;
            bf16x8 kf[4], vf[4];
#pragma unroll
            for (int ks = 0; ks < 4; ++ks) kf[ks] = *(const bf16x8*)(kbase + (size_t)k0 * NPROJ + 16 * ks);
#pragma unroll
            for (int mt = 0; mt < 2; ++mt)
#pragma unroll
                for (int s = 0; s < 2; ++s) vf[mt * 2 + s] = *(const bf16x8*)(vbase + (size_t)(32 * mt) * SEQ + k0 + 16 * s);
            f32x16 Z;
#pragma unroll
            for (int r = 0; r < 16; ++r) Z[r] = 0.f;
#pragma unroll
            for (int ks = 0; ks < 4; ++ks) Z = __builtin_amdgcn_mfma_f32_32x32x16_bf16(kf[ks], qf[ks], Z, 0, 0, 0);
            float l1[16], lb[16];
#pragma unroll
            for (int r = 0; r < 16; ++r) {
                const float z = Z[r];
                const float lp = __logf(1.0f + __expf(-fabsf(z)));
                const bool valid = (k0 + 16 * (r >> 3) + 8 * hh + (r & 7)) < t;
                l1[r] = valid ? -(fmaxf(z, 0.f) + lp) : 0.f;
                lb[r] = valid ? (fminf(z, 0.f) - lp) : -1.0e30f;
            }
            float sufA[8], sufB[8];
            sufA[7] = 0.f; sufB[7] = 0.f;
#pragma unroll
            for (int p = 6; p >= 0; --p) { sufA[p] = sufA[p + 1] + l1[p + 1]; sufB[p] = sufB[p + 1] + l1[8 + p + 1]; }
            const float sA = sufA[0] + l1[0], sB = sufB[0] + l1[8];
            const float pA = __shfl_xor(sA, 32), pB = __shfl_xor(sB, 32);
            const float aboveB = hh ? 0.f : pB;
            const float aboveA = hh ? (sB + pB) : (pB + sB + pA);
            const float RA = R + aboveA, RB = R + aboveB;
#pragma unroll
            for (int p = 0; p < 8; ++p) { Z[p] = __expf(lb[p] + RA + sufA[p]); Z[8 + p] = __expf(lb[8 + p] + RB + sufB[p]); }
            R += (sA + sB) + (pA + pB);
            const bf16x8 p0 = pack8(Z, 0), p1 = pack8(Z, 1);
            O0 = __builtin_amdgcn_mfma_f32_32x32x16_bf16(vf[0], p0, O0, 0, 0, 0);
            O0 = __builtin_amdgcn_mfma_f32_32x32x16_bf16(vf[1], p1, O0, 0, 0, 0);
            O1 = __builtin_amdgcn_mfma_f32_32x32x16_bf16(vf[2], p0, O1, 0, 0, 0);
            O1 = __builtin_amdgcn_mfma_f32_32x32x16_bf16(vf[3], p1, O1, 0, 0, 0);
            if (__all(R < -110.0f)) break;
        }
        float ss = 0.f;
#pragma unroll
        for (int r = 0; r < 16; ++r) ss += O0[r] * O0[r] + O1[r] * O1[r];
        ss += __shfl_xor(ss, 32);
        const float rn = rsqrtf(ss * (1.0f / 64.0f) + EPS);
        bf16_t* dst = mixed + (tokb + t) * DM + 512 + h * 64;
#pragma unroll
        for (int g = 0; g < 4; ++g) {
            const int d = 8 * g + 4 * hh;
            const f32x4 gv0 = *(const f32x4*)(go + d), gv1 = *(const f32x4*)(go + 32 + d);
            u32x2 w0, w1;
            w0.x = pk2(O0[4 * g] * rn * gv0[0], O0[4 * g + 1] * rn * gv0[1]); w0.y = pk2(O0[4 * g + 2] * rn * gv0[2], O0[4 * g + 3] * rn * gv0[3]);
            w1.x = pk2(O1[4 * g] * rn * gv1[0], O1[4 * g + 1] * rn * gv1[1]); w1.y = pk2(O1[4 * g + 2] * rn * gv1[2], O1[4 * g + 3] * rn * gv1[3]);
            *(u32x2*)(dst + d) = w0; *(u32x2*)(dst + 32 + d) = w1;
        }
    }
}

__device__ __forceinline__ void topk_insert(float (&L)[16], float x) {
#pragma unroll
    for (int i = 15; i >= 1; --i) L[i] = __builtin_amdgcn_fmed3f(L[i - 1], L[i], x);
    L[0] = fmaxf(L[0], x);
}
template <int I, int J> __device__ __forceinline__ void cand_ins(float (&M)[16], const float (&L0)[16], const float (&L1)[16]) {
    const float s = __uint_as_float(__float_as_uint(L0[I]) & ~127u) + __uint_as_float(__float_as_uint(L1[J]) & ~127u);
    topk_insert(M, __uint_as_float((__float_as_uint(s) & ~255u) | (unsigned)(I * 16 + J)));
}
template <int I, int... Js> __device__ __forceinline__ void cand_row(float (&M)[16], const float (&L0)[16], const float (&L1)[16], std::integer_sequence<int, Js...>) {
    (cand_ins<I, Js>(M, L0, L1), ...);
}
template <int... Is> __device__ __forceinline__ void cand_all(float (&M)[16], const float (&L0)[16], const float (&L1)[16], std::integer_sequence<int, Is...>) {
    (cand_row<Is>(M, L0, L1, std::make_integer_sequence<int, 16 / (Is + 1)>{}), ...);
}
__device__ __forceinline__ unsigned sel16(const float (&L)[16], int i) {
    unsigned r = __float_as_uint(L[0]);
#pragma unroll
    for (int k = 1; k < 16; ++k) { r = (i == k) ? __float_as_uint(L[k]) : r; asm volatile("" : "+v"(r)); }
    return r;
}
__device__ __forceinline__ void phase_scores(const Args& a, LAS unsigned char* lds, const pg8::StaticOrder& S) {
    const bf16_t* qp = (const bf16_t*)(a.ws + WS_QPEER); const bf16_t* kb = (const bf16_t*)(a.ws + WS_SUBK);
    unsigned* sel_e = (unsigned*)(a.ws + WS_SELE); float* sel_g = (float*)(a.ws + WS_SELG);
    pg8::Unit un;
    for (int ui = 0; S.next(ui, un); ++ui) {
        int tid = threadIdx.x; asm volatile("" : "+v"(tid));
        const int lane = tid & 63, wave = tid >> 6, r32 = lane & 31, hh = lane >> 5;
        const int h = un.pn, tile = un.pm;
        __syncthreads();
        for (int c = tid; c < 4096; c += NTHR) { const int r = c >> 4, cc = c & 15;
            *(LAS u32x4*)(lds + r * 272 + cc * 16) = *(const u32x4*)(kb + ((size_t)h * 256 + r) * 128 + cc * 8); }
        __syncthreads();
        const size_t tok = (size_t)tile * 256 + wave * 32 + r32;
        float L0[16], L1[16];
#pragma unroll
        for (int p = 0; p < 2; ++p) {
            bf16x8 bq[8];
#pragma unroll
            for (int ks = 0; ks < 8; ++ks) bq[ks] = *(const bf16x8*)(qp + tok * 2048 + (h * 2 + p) * 128 + 16 * ks + 8 * hh);
            float L[16];
#pragma unroll
            for (int i = 0; i < 16; ++i) L[i] = -3.0e38f;
#pragma unroll
            for (int kt = 0; kt < 4; ++kt) {
                f32x16 acc;
#pragma unroll
                for (int r = 0; r < 16; ++r) acc[r] = 0.f;
                const LAS unsigned char* Ab = lds + (p * 128 + 32 * kt + r32) * 272 + hh * 16;
#pragma unroll
                for (int ks = 0; ks < 8; ++ks) acc = __builtin_amdgcn_mfma_f32_32x32x16_bf16(*(const LAS bf16x8*)(Ab + ks * 32), bq[ks], acc, 0, 0, 0);
#pragma unroll
                for (int r = 0; r < 16; ++r) {
                    const unsigned key = (unsigned)(32 * kt + (r & 3) + 8 * (r >> 2)) + 4u * (unsigned)hh;
                    topk_insert(L, __uint_as_float((__float_as_uint(acc[r]) & ~127u) | key));
                }
            }
            float P[16];
#pragma unroll
            for (int i = 0; i < 16; ++i) P[i] = __shfl_xor(L[i], 32);
#pragma unroll
            for (int i = 0; i < 16; ++i) topk_insert(L, P[i]);
#pragma unroll
            for (int i = 0; i < 16; ++i) { if (p == 0) L0[i] = L[i]; else L1[i] = L[i]; }
        }
        float M[16];
#pragma unroll
        for (int i = 0; i < 16; ++i) M[i] = -3.0e38f;
        cand_all(M, L0, L1, std::make_integer_sequence<int, 16>{});
        const float m0 = __uint_as_float(__float_as_uint(M[0]) & ~255u);
        float den = 0.f;
#pragma unroll
        for (int i = 0; i < 16; ++i) den += __expf(__uint_as_float(__float_as_uint(M[i]) & ~255u) - m0);
        const float rden = 1.0f / den;
        unsigned eo[8]; float go[8];
#pragma unroll
        for (int q = 0; q < 8; ++q) {
            unsigned mlo = __float_as_uint(M[q]), mhi = __float_as_uint(M[8 + q]); asm volatile("" : "+v"(mlo), "+v"(mhi));
            const unsigned mb = hh ? mhi : mlo;
            const int ci = (mb >> 4) & 15, cj = mb & 15;
            eo[q] = (sel16(L0, ci) & 127u) * 128u + (sel16(L1, cj) & 127u);
            go[q] = __expf(__uint_as_float(mb & ~255u) - m0) * rden;
        }
        const size_t ob = (tok * 8 + h) * 16 + 8 * hh;
        *(u32x4*)(sel_e + ob) = (u32x4){eo[0], eo[1], eo[2], eo[3]}; *(u32x4*)(sel_e + ob + 4) = (u32x4){eo[4], eo[5], eo[6], eo[7]};
        *(f32x4*)(sel_g + ob) = (f32x4){go[0], go[1], go[2], go[3]}; *(f32x4*)(sel_g + ob + 4) = (f32x4){go[4], go[5], go[6], go[7]};
    }
}


template <int CTRL> __device__ __forceinline__ int dppi(int x) { return __builtin_amdgcn_update_dpp(0, x, CTRL, 0xF, 0xF, true); }
__device__ __forceinline__ void peer_gather(u32x4 (&w)[16], const LAS unsigned* idp, const unsigned char* tab) {
    u32x4 id[4];
#pragma unroll
    for (int c = 0; c < 4; ++c) id[c] = *(const LAS u32x4*)(idp + 4 * c);
#pragma unroll
    for (int i = 0; i < 16; ++i) w[i] = *(const u32x4*)(tab + (size_t)id[i >> 2][i & 3] * 128);
}
__device__ __forceinline__ void peer_u_reduce(const u32x4 (&w)[16], const u32x4 hq, LAS int* pp, bool first, bool b2, bool b1, bool b0) {
    int p[16];
#pragma unroll
    for (int i = 0; i < 16; ++i) {
        int acc = __builtin_amdgcn_sdot4((int)w[i].x, (int)hq.x, 0, false);
        acc = __builtin_amdgcn_sdot4((int)w[i].y, (int)hq.y, acc, false);
        acc = __builtin_amdgcn_sdot4((int)w[i].z, (int)hq.z, acc, false);
        p[i] = __builtin_amdgcn_sdot4((int)w[i].w, (int)hq.w, acc, false);
    }
    int q8[8], q4[4], q2[2];
#pragma unroll
    for (int k = 0; k < 8; ++k) { const int keep = b2 ? p[8 + k] : p[k], send = b2 ? p[k] : p[8 + k]; q8[k] = keep + dppi<0x141>(send); }
#pragma unroll
    for (int k = 0; k < 4; ++k) { const int keep = b1 ? q8[4 + k] : q8[k], send = b1 ? q8[k] : q8[4 + k]; q4[k] = keep + dppi<0x4E>(send); }
#pragma unroll
    for (int k = 0; k < 2; ++k) { const int keep = b0 ? q4[2 + k] : q4[k], send = b0 ? q4[k] : q4[2 + k]; q2[k] = keep + dppi<0xB1>(send); }
    if (first) { pp[0] = q2[0]; pp[8] = q2[1]; } else { pp[0] += q2[0]; pp[8] += q2[1]; }
}
__device__ __forceinline__ void peer_v_reduce(const u32x4 (&w)[16], const LAS unsigned* ap, float asc, float* op, const unsigned* xp, f32x2 gv, bool e0, bool e1, bool e2) {
    const u32x4 aq = *(const LAS u32x4*)ap;
    int y[16];
#pragma unroll
    for (int k = 0; k < 16; ++k) y[k] = 0;
#pragma unroll
    for (int g = 0; g < 4; ++g)
#pragma unroll
        for (int c = 0; c < 4; ++c) {
            const unsigned W0 = w[4 * g][c], W1 = w[4 * g + 1][c], W2 = w[4 * g + 2][c], W3 = w[4 * g + 3][c];
            const unsigned p01l = __builtin_amdgcn_perm(W1, W0, 0x05010400u), p01h = __builtin_amdgcn_perm(W1, W0, 0x07030602u);
            const unsigned p23l = __builtin_amdgcn_perm(W3, W2, 0x05010400u), p23h = __builtin_amdgcn_perm(W3, W2, 0x07030602u);
            const unsigned T0 = __builtin_amdgcn_perm(p23l, p01l, 0x05040100u), T1 = __builtin_amdgcn_perm(p23l, p01l, 0x07060302u);
            const unsigned T2 = __builtin_amdgcn_perm(p23h, p01h, 0x05040100u), T3 = __builtin_amdgcn_perm(p23h, p01h, 0x07060302u);
            y[4 * c + 0] = __builtin_amdgcn_sdot4((int)T0, (int)aq[g], y[4 * c + 0], false);
            y[4 * c + 1] = __builtin_amdgcn_sdot4((int)T1, (int)aq[g], y[4 * c + 1], false);
            y[4 * c + 2] = __builtin_amdgcn_sdot4((int)T2, (int)aq[g], y[4 * c + 2], false);
            y[4 * c + 3] = __builtin_amdgcn_sdot4((int)T3, (int)aq[g], y[4 * c + 3], false);
        }
    int z8[8], z4[4], z2[2];
#pragma unroll
    for (int k = 0; k < 8; ++k) { const int keep = e0 ? y[8 + k] : y[k], send = e0 ? y[k] : y[8 + k]; z8[k] = keep + dppi<0x128>(send); }
#pragma unroll
    for (int k = 0; k < 4; ++k) { const int keep = e1 ? z8[4 + k] : z8[k], send = e1 ? z8[k] : z8[4 + k]; z4[k] = keep + __shfl_xor(send, 16); }
#pragma unroll
    for (int k = 0; k < 2; ++k) { const int keep = e2 ? z4[2 + k] : z4[k], send = e2 ? z4[k] : z4[2 + k]; z2[k] = keep + __shfl_xor(send, 32); }
    const unsigned xw = *xp; const f32x2 xv = (f32x2){bf_lo(xw), bf_hi(xw)};
    *(f32x2*)op = xv + gv * (f32x2){(float)z2[0] * asc, (float)z2[1] * asc};
}
__device__ __forceinline__ void phase_peer(const Args& a, LAS unsigned char* lds) {
    const int wave = threadIdx.x >> 6;
    const int gw = blockIdx.x * NWAVE + wave, NGW = gridDim.x * NWAVE;
    const unsigned* gsel_e = (const unsigned*)(a.ws + WS_SELE); const float* gsel_g = (const float*)(a.ws + WS_SELG);
    const unsigned char* hq = a.ws + WS_HQ; const float* hsc = (const float*)(a.ws + WS_HS);
    const unsigned char* Uq = a.ws + WS_UT; const unsigned char* Vq = a.ws + WS_VT;
    const float* uscale = (const float*)(a.ws + WS_US); const float* vscale = (const float*)(a.ws + WS_VS);
    const float* mod = (const float*)(a.ws + WS_MOD); float* out = a.out; const bf16_t* x1b = (const bf16_t*)(a.ws + WS_X1B);
    LAS unsigned* ids = (LAS unsigned*)(lds + wave * 16384);
    LAS int* pre = (LAS int*)(lds + wave * 16384 + 8192);
    for (int grp = gw; grp * 16 < T_TOK; grp += NGW) {
        int lane = threadIdx.x & 63; asm volatile("" : "+v"(lane));
        const int sub = lane & 7, eg = lane >> 3;
        const bool b2 = (sub & 4) != 0, b1 = (sub & 2) != 0, b0 = (sub & 1) != 0;
        const bool e0 = (eg & 1) != 0, e1 = (eg & 2) != 0, e2 = (eg & 4) != 0;
        const size_t tok0 = (size_t)grp * 16;
#pragma unroll
        for (int j = 0; j < 8; ++j) {
            const int q = lane + 64 * j;
            const u32x4 v = *(const u32x4*)(gsel_e + tok0 * 128 + (size_t)q * 4);
            const int t = q >> 5, k = (q & 31) * 4;
#pragma unroll
            for (int c = 0; c < 4; ++c) ids[t * 128 + ((k + c) & 7) * 16 + ((k + c) >> 3)] = v[c];
        }
        LDS_WAIT();
        for (int s = 0; s < 8; ++s) {
            const unsigned char* Us = Uq + (size_t)s * 16384 * 128 + 16 * sub;
            const unsigned char* hs = hq + tok0 * DM + 128 * s + 16 * sub;
            u32x4 wA[16], wB[16], hA, hB;
            peer_gather(wA, ids + eg * 16, Us); hA = *(const u32x4*)(hs);
            for (int t = 0; t < 16; t += 2) {
                peer_gather(wB, ids + (t + 1) * 128 + eg * 16, Us); hB = *(const u32x4*)(hs + (t + 1) * DM);
                peer_u_reduce(wA, hA, pre + t * 128 + 16 * sub + eg, s == 0, b2, b1, b0);
                if (t + 2 < 16) { peer_gather(wA, ids + (t + 2) * 128 + eg * 16, Us); hA = *(const u32x4*)(hs + (t + 2) * DM); }
                peer_u_reduce(wB, hB, pre + (t + 1) * 128 + 16 * sub + eg, s == 0, b2, b1, b0);
            }
        }
        LDS_WAIT();
        for (int t = 0; t < 16; ++t) {
            float r[2]; const float hs_t = hsc[tok0 + t];
#pragma unroll
            for (int c = 0; c < 2; ++c) {
                const int k = lane + 64 * c;
                const unsigned e = ids[t * 128 + (k & 7) * 16 + (k >> 3)];
                const float pv = (float)pre[t * 128 + k] * (uscale[e] * hs_t);
                r[c] = 0.5f * pv * (1.0f + erff(pv * 0.70710678118654752f)) * gsel_g[(tok0 + t) * 128 + k] * vscale[e];
            }
            const float am = wave_max(fmaxf(fabsf(r[0]), fabsf(r[1])));
            const float inv = am > 0.f ? 127.0f / am : 0.f;
            LDS_WAIT();
            LAS unsigned char* ab = (LAS unsigned char*)(pre + t * 128);
#pragma unroll
            for (int c = 0; c < 2; ++c) { const int k = lane + 64 * c; ab[(k & 7) * 16 + (k >> 3)] = (unsigned char)((int)rintf(r[c] * inv) & 255); }
            if (lane == 0) *(LAS float*)(ab + 128) = am * (1.0f / 127.0f);
        }
        LDS_WAIT();
        for (int s = 0; s < 8; ++s) {
            const unsigned char* Vs = Vq + (size_t)s * 16384 * 128 + 16 * sub;
            const int d = 128 * s + 16 * sub + (e0 ? 8 : 0) + (e1 ? 4 : 0) + (e2 ? 2 : 0);
            const f32x2 gv = *(const f32x2*)(mod + (tok0 >> 12) * NMODC + 5120 + d);
            u32x4 wA[16], wB[16];
            peer_gather(wA, ids + eg * 16, Vs);
            for (int t = 0; t < 16; t += 2) {
                peer_gather(wB, ids + (t + 1) * 128 + eg * 16, Vs);
                peer_v_reduce(wA, (const LAS unsigned*)(pre + t * 128) + eg * 4, *(const LAS float*)((const LAS unsigned char*)(pre + t * 128) + 128), out + (tok0 + t) * DM + d, (const unsigned*)(x1b + (tok0 + t) * DM + d), gv, e0, e1, e2);
                if (t + 2 < 16) peer_gather(wA, ids + (t + 2) * 128 + eg * 16, Vs);
                peer_v_reduce(wB, (const LAS unsigned*)(pre + (t + 1) * 128) + eg * 4, *(const LAS float*)((const LAS unsigned char*)(pre + (t + 1) * 128) + 128), out + (tok0 + t + 1) * DM + d, (const unsigned*)(x1b + (tok0 + t + 1) * DM + d), gv, e0, e1, e2);
            }
        }
        LDS_WAIT();
    }
}

__device__ __forceinline__ void grid_barrier(unsigned* cnt, unsigned nblocks) {
    __syncthreads();
    if (threadIdx.x == 0) {
        __builtin_amdgcn_fence(__ATOMIC_RELEASE, "agent");
        asm volatile("s_waitcnt vmcnt(0)" ::: "memory");
        __hip_atomic_fetch_add(cnt, 1u, __ATOMIC_RELAXED, __HIP_MEMORY_SCOPE_AGENT);
        while (__hip_atomic_load(cnt, __ATOMIC_RELAXED, __HIP_MEMORY_SCOPE_AGENT) < nblocks) __builtin_amdgcn_s_sleep(2);
        __builtin_amdgcn_fence(__ATOMIC_ACQUIRE, "agent");
        asm volatile("s_waitcnt vmcnt(0)" ::: "memory");
    }
    __syncthreads();
}

#define XB_TMO      128
#define XB_XCNT(j)  (256  + 64 * (j))
#define XB_XSUB(j)  (1280 + 64 * (j))
#define XB_XGEN(j)  (2304 + 64 * (j))
#define XB_TOP      3328
#define XB_TOPGEN   3392
#define XB_SPIN_CAP (1u << 22)
__device__ __forceinline__ unsigned xb_ld(unsigned* p)              { return __hip_atomic_load(p, __ATOMIC_RELAXED, __HIP_MEMORY_SCOPE_AGENT); }
__device__ __forceinline__ unsigned xb_add(unsigned* p, unsigned v) { return __hip_atomic_fetch_add(p, v, __ATOMIC_RELAXED, __HIP_MEMORY_SCOPE_AGENT); }
__device__ __forceinline__ unsigned xb_xcc_id() { return (unsigned)__builtin_amdgcn_s_getreg((3 << 11) | 20) & 0xFu; }
#define XB_SPIN(cond, bar) do { unsigned _sp = 0; while (cond) { __builtin_amdgcn_s_sleep(1); \
    if ((++_sp & 255u) == 0u) { if (xb_ld(&(bar)[XB_TMO])) break; if (_sp > XB_SPIN_CAP) { atomicAdd(&(bar)[XB_TMO], 1u); break; } } } } while (0)
struct XcdBarrier { unsigned* bar; unsigned x; volatile LAS unsigned* st; };
__device__ __forceinline__ XcdBarrier xcd_barrier_post(unsigned* bar, volatile LAS unsigned* st) {
    XcdBarrier b; b.bar = bar; b.x = xb_xcc_id(); b.st = st;
    if (threadIdx.x == 0) (void)xb_add(&bar[XB_XCNT(b.x)], 1u);
    return b;
}
__device__ __forceinline__ void xcd_barrier_complete(unsigned* bar, unsigned x, unsigned& nloc, unsigned& nx) {
    const unsigned G = gridDim.x * gridDim.y * gridDim.z;
    unsigned sum, cnt, mine, sp = 0u;
    for (;;) {
        sum = 0u; cnt = 0u; mine = 0u;
#pragma unroll
        for (unsigned j = 0; j < 16; ++j) { const unsigned c = xb_ld(&bar[XB_XCNT(j)]); sum += c; cnt += (c > 0u) ? 1u : 0u; mine = (j == x) ? c : mine; }
        if (sum == G) break;
        __builtin_amdgcn_s_sleep(1);
        if ((++sp & 255u) == 0u) { if (xb_ld(&bar[XB_TMO])) break; if (sp > XB_SPIN_CAP) { atomicAdd(&bar[XB_TMO], 1u); break; } }
    }
    nloc = mine > 0u ? mine : 1u; nx = cnt > 0u ? cnt : 1u;
}
__device__ __forceinline__ void xcd_barrier(const XcdBarrier& b) {
    asm volatile("s_waitcnt vmcnt(0)" ::: "memory");
    __syncthreads();
    if (threadIdx.x == 0) {
        unsigned* bar = b.bar;
        __builtin_amdgcn_s_waitcnt(0);
        unsigned nloc = b.st[0], nx = b.st[1];
        if (nloc == 0u) { xcd_barrier_complete(bar, b.x, nloc, nx); b.st[0] = nloc; b.st[1] = nx; }
        const unsigned old = xb_add(&bar[XB_XSUB(b.x)], 1u);
        const unsigned gen = old / nloc;
        if (old + 1u == (gen + 1u) * nloc) {
            __builtin_amdgcn_fence(__ATOMIC_RELEASE, "agent");
            asm volatile("s_waitcnt vmcnt(0)" ::: "memory");
            const unsigned og = xb_add(&bar[XB_TOP], 1u);
            const unsigned tg = og / nx;
            if (og + 1u == (tg + 1u) * nx) xb_add(&bar[XB_TOPGEN], 1u);
            else XB_SPIN(xb_ld(&bar[XB_TOPGEN]) == tg, bar);
            __builtin_amdgcn_fence(__ATOMIC_ACQUIRE, "agent");
            xb_add(&bar[XB_XGEN(b.x)], 1u);
            asm volatile("s_waitcnt vmcnt(0)" ::: "memory");
        } else {
            XB_SPIN(xb_ld(&bar[XB_XGEN(b.x)]) == gen, bar);
            __builtin_amdgcn_fence(__ATOMIC_ACQUIRE, "agent");
            asm volatile("s_waitcnt vmcnt(0)" ::: "memory");
        }
    }
    __syncthreads();
}

__global__ void __launch_bounds__(NTHR, 2) mega(Args a) {
    extern __shared__ __attribute__((aligned(16))) unsigned char smem[];
    LAS unsigned char* lds = (LAS unsigned char*)smem;
    const int lo = a.ph_lo, hi = a.ph_hi;
    const int G = gridDim.x;
    if (threadIdx.x < 4) ((LAS unsigned*)(lds + LDS_BYTES - 16))[threadIdx.x] = 0u;
    XcdBarrier xb; xb.bar = (unsigned*)(a.ws + WS_XB); xb.x = 0; xb.st = (volatile LAS unsigned*)(lds + LDS_BYTES - 16);
#define IN(k) (lo <= (k) && (k) < hi)
#ifndef DUP_MASK
#define DUP_MASK 0
#endif
#define REP(k) for (int rep_ = 0; rep_ < 1 + ((DUP_MASK >> (k)) & 1); ++rep_, (((DUP_MASK >> 23) & 1) && ((DUP_MASK >> (k)) & 1) && (k) < 16 && rep_ == 1 ? grid_barrier((unsigned*)(a.ws + WS_BAR) + 64 * ((k) > 15 ? 15 : (k)) + 16, (unsigned)G) : (void)0))
#define SYNC(k) do { if (IN(k) && IN((k) + 1)) { if ((k) == 0) { cg::this_grid().sync(); xb = xcd_barrier_post((unsigned*)(a.ws + WS_XB), (volatile LAS unsigned*)(lds + LDS_BYTES - 16)); } else { xcd_barrier(xb); if ((DUP_MASK >> 22) & 1) xcd_barrier(xb); } } } while (0)
    if (IN(0)) REP(0) phase0(a, lds);
    SYNC(0);
    if (IN(1)) REP(1) { phase_norm<true>(a, a.in[0], a.in[4], 0, 1024); phase0b(a, lds); }
    SYNC(1);
#if INPROJ_I8
    if (IN(2)) REP(2) { pg8::Gemm g{(const bf16_t*)(a.ws + WS_ACT), (const bf16_t*)(a.ws + WS_WIN_T), T_TOK, NPROJ, 512}; pg8::StaticOrder S; S.init(T_TOK, NPROJ, G, (int)blockIdx.x);
        pg8::EpiBf16S E{(bf16_t*)(a.ws + WS_PROJ), NPROJ, (const float*)(a.ws + WS_H1S), (const float*)(a.ws + WS_WINS)}; pg8::gemm_phase<pg8::EpiBf16S, true>(lds, g, S, E); }
#else
    if (IN(2)) REP(2) { pg8::Gemm g{(const bf16_t*)(a.ws + WS_ACT), (const bf16_t*)(a.ws + WS_WIN_T), T_TOK, NPROJ, 1024}; pg8::StaticOrder S; S.init(T_TOK, NPROJ, G, (int)blockIdx.x);
        pg8::EpiBf16 E{(bf16_t*)(a.ws + WS_PROJ), NPROJ}; pg8::gemm_phase(lds, g, S, E); }
#endif
    SYNC(2);
    if (IN(3)) { REP(3) dn_prep(a, lds); REP(18) sb_prep(a); }
    SYNC(3);
    if (IN(4)) {
        if ((int)blockIdx.x < DN_BLOCKS) { REP(16) dn_scan2(a, lds); }
        else { REP(17) sb_attn(a, ((int)blockIdx.x - DN_BLOCKS) * NWAVE + (int)(threadIdx.x >> 6), (G - DN_BLOCKS) * NWAVE);
               late_prep(a, lds, ((int)blockIdx.x - DN_BLOCKS) * NWAVE + (int)(threadIdx.x >> 6), (G - DN_BLOCKS) * NWAVE); }
    }
    SYNC(4);
    if (IN(5)) REP(5) dn_gate_norm(a);
    SYNC(5);
    if (IN(6)) REP(6) { pg8::Gemm g{(const bf16_t*)(a.ws + WS_MQ), (const bf16_t*)(a.ws + WS_WOUT_T), T_TOK, 1024, 512}; pg8::StaticOrder S; S.init(T_TOK, 1024, G, (int)blockIdx.x);
        pg8::EpiResidS E{a.in[0], (const float*)(a.ws + WS_MOD), (bf16_t*)(a.ws + WS_X1B), (const float*)(a.ws + WS_MS), (const float*)(a.ws + WS_WOS)}; pg8::gemm_phase<pg8::EpiResidS, true>(lds, g, S, E); }
    SYNC(6);
    if (IN(7)) REP(7) phase_norm<false>(a, a.out, a.in[14], 3072, 4096);
    SYNC(7);
    if (IN(8)) REP(8) {
#if QUERY_I8
        pg8::Gemm g{(const bf16_t*)(a.ws + WS_HQ), (const bf16_t*)(a.ws + WS_WQ_T), T_TOK, 2048, 512}; pg8::StaticOrder S; S.init(T_TOK, 2048, G, (int)blockIdx.x);
        pg8::EpiBf16S E{(bf16_t*)(a.ws + WS_QPEER), 2048, (const float*)(a.ws + WS_HS), (const float*)(a.ws + WS_WQS)}; pg8::gemm_phase<pg8::EpiBf16S, true>(lds, g, S, E);
#else
        pg8::Gemm g{(const bf16_t*)(a.ws + WS_ACT), (const bf16_t*)(a.ws + WS_WQ_T), T_TOK, 2048, 1024}; pg8::StaticOrder S; S.init(T_TOK, 2048, G, (int)blockIdx.x);
        pg8::EpiBf16 E{(bf16_t*)(a.ws + WS_QPEER), 2048}; pg8::gemm_phase(lds, g, S, E);
#endif
        asm volatile("s_waitcnt vmcnt(0)" ::: "memory"); __syncthreads();
        phase_scores(a, lds, S); }
    SYNC(8);
    if (IN(10)) phase_peer(a, lds);
#undef IN
#undef SYNC
}

#ifndef ONE_LAUNCH
#define ONE_LAUNCH 1
#endif

extern "C" void kernel_launch(void* const* d_in, const int* in_sizes, int n_in, void* d_out, int out_size, void* d_ws, size_t ws_size, hipStream_t stream) {
    static int grid = 0;
    if (grid == 0) {
        int dev = 0, cus = 0, per_cu = 0;
        (void)hipGetDevice(&dev);
        (void)hipDeviceGetAttribute(&cus, hipDeviceAttributeMultiprocessorCount, dev);
        (void)hipFuncSetAttribute((const void*)mega, hipFuncAttributeMaxDynamicSharedMemorySize, LDS_BYTES);
        (void)hipOccupancyMaxActiveBlocksPerMultiprocessor(&per_cu, (const void*)mega, NTHR, LDS_BYTES);
        if (per_cu < 1) { fprintf(stderr, "kernel_launch: occupancy query says %d blocks/CU\n", per_cu); per_cu = 1; }
        if (per_cu > 1) per_cu = 1;
        grid = cus * per_cu;
        if (ws_size < WS_END3) fprintf(stderr, "kernel_launch: workspace too small: %zu < %zu\n", ws_size, (size_t)WS_END3);
    }
    Args a{};
    for (int i = 0; i < 19; ++i) a.in[i] = (const float*)d_in[i];
    a.out = (float*)d_out; a.ws = (unsigned char*)d_ws;
#if ONE_LAUNCH
    a.ph_lo = 0; a.ph_hi = N_PHASES;
    void* args[] = {&a};
    hipError_t e = hipLaunchCooperativeKernel((const void*)mega, dim3(grid), dim3(NTHR), args, LDS_BYTES, stream);
    if (e != hipSuccess) fprintf(stderr, "cooperative launch failed: %s (grid %d)\n", hipGetErrorString(e), grid);
#else
    for (int p = 0; p < N_PHASES; ++p) {
        a.ph_lo = p; a.ph_hi = p + 1;
        hipLaunchKernelGGL(mega, dim3(grid), dim3(NTHR), LDS_BYTES, stream, a);
    }
#endif
}
```

```cpp
#include <hip/hip_runtime.h>
#include <hip/hip_cooperative_groups.h>
#include <cstdio>
#include <utility>
#include <type_traits>
namespace cg = cooperative_groups;
#ifndef INPROJ_I8
#define INPROJ_I8 1
#endif
#ifndef QUERY_I8
#define QUERY_I8 1
#endif

#define LAS __attribute__((address_space(3)))
typedef unsigned short bf16_t;
typedef short bf16x8 __attribute__((ext_vector_type(8)));
typedef float f32x4 __attribute__((ext_vector_type(4)));
typedef float f32x2 __attribute__((ext_vector_type(2)));
typedef unsigned u32x4 __attribute__((ext_vector_type(4)));
typedef unsigned u32x2 __attribute__((ext_vector_type(2)));
using bf16x2 = __attribute__((ext_vector_type(2))) __bf16;

constexpr int T_TOK = 32768, SEQ = 4096, DM = 1024, NMODC = 6144;
constexpr int NPROJ = 3584, LDW_IN = 3592;
constexpr int NTHR = 512, NWAVE = 8;
constexpr int LDS_BYTES = 160 * 1024;
constexpr int N_PHASES = 11;
constexpr int DN_BLOCKS = 64;
constexpr float EPS = 1e-6f;

constexpr size_t WS_MOD = 0;
constexpr size_t WS_WSM = WS_MOD + 8 * 6144 * 4;
constexpr size_t WS_SMALL = WS_WSM + 8 * 1024 * 4;
constexpr size_t WS_WIN_T = WS_SMALL + (size_t)T_TOK * 8 * 4;
constexpr size_t WS_WOUT_T = WS_WIN_T + (size_t)NPROJ * 1024 * 2;
constexpr size_t WS_WQ_T = WS_WOUT_T + (size_t)1024 * 1024 * 2;
constexpr size_t WS_SUBK = WS_WQ_T + (size_t)2048 * 1024 * 2;
constexpr size_t WS_UT = WS_SUBK + (size_t)16 * 128 * 128 * 2;
constexpr size_t WS_VT = WS_UT + (size_t)16384 * 1024 * 2;
constexpr size_t WS_US = WS_UT + (size_t)16384 * 1024;
constexpr size_t WS_VS = WS_US + 65536;
constexpr size_t WS_H1S = WS_VS + 65536;
constexpr size_t WS_WINS = WS_H1S + (size_t)T_TOK * 4;
constexpr size_t WS_WQS = WS_WINS + 16384;
constexpr size_t WS_WOS = WS_WQS + 8192;
constexpr size_t WS_MS = WS_WOS + 4096;
constexpr size_t WS_ACT = WS_VT + (size_t)16384 * 1024 * 2;
constexpr size_t WS_PROJ = WS_ACT + (size_t)T_TOK * 1024 * 2;
constexpr size_t WS_QPEER = WS_PROJ;
constexpr size_t WS_SELE = WS_PROJ + (size_t)T_TOK * 2048 * 2;
constexpr size_t WS_SELG = WS_SELE + (size_t)T_TOK * 128 * 4;
constexpr size_t WS_HQ = WS_SELG + (size_t)T_TOK * 128 * 4;
constexpr size_t WS_HS = WS_HQ + (size_t)T_TOK * 1024;
constexpr size_t WS_END = WS_PROJ + (size_t)T_TOK * NPROJ * 2;
constexpr size_t DN_REC = 73728;
constexpr size_t WS_DN = WS_END;
constexpr size_t WS_X1B = WS_DN;
constexpr size_t WS_MQ = WS_DN + (size_t)T_TOK * 1024 * 2;
constexpr size_t WS_GLS = WS_DN + 2048 * DN_REC;
constexpr size_t WS_END2 = WS_GLS + 8192;
constexpr size_t WS_BAR = WS_END2;
constexpr size_t WS_XB = WS_BAR + 16 * 256;
constexpr size_t WS_END3 = WS_XB + 3456 * 4;
constexpr size_t VT_OFF = (size_t)T_TOK * 512 * 4;

struct Args { const float* in[19]; float* out; unsigned char* ws; int ph_lo, ph_hi; };

template <int CTRL> __device__ __forceinline__ float dpp_(float x) {
    return __builtin_bit_cast(float, __builtin_amdgcn_update_dpp(0, __builtin_bit_cast(int, x), CTRL, 0xF, 0xF, true));
}
__device__ __forceinline__ float wave_sum(float v) {
    v += dpp_<0xB1>(v); v += dpp_<0x4E>(v); v += dpp_<0x141>(v); v += dpp_<0x140>(v);
    v += __shfl_xor(v, 16); v += __shfl_xor(v, 32);
    return v;
}
__device__ __forceinline__ float wave_max(float v) {
    v = fmaxf(v, dpp_<0xB1>(v)); v = fmaxf(v, dpp_<0x4E>(v)); v = fmaxf(v, dpp_<0x141>(v)); v = fmaxf(v, dpp_<0x140>(v));
    v = fmaxf(v, __shfl_xor(v, 16)); v = fmaxf(v, __shfl_xor(v, 32));
    return v;
}
__device__ __forceinline__ unsigned pk2(float lo, float hi) {
    typedef __bf16 bf2v_t __attribute__((ext_vector_type(2)));
    bf2v_t v; v[0] = (__bf16)lo; v[1] = (__bf16)hi; return __builtin_bit_cast(unsigned, v);
}
__device__ __forceinline__ unsigned f2bf(float f) { return pk2(f, 0.f) & 0xffffu; }
__device__ __forceinline__ float bf_lo(unsigned w) { return __uint_as_float(w << 16); }
__device__ __forceinline__ float bf_hi(unsigned w) { return __uint_as_float(w & 0xffff0000u); }
__device__ __forceinline__ float dot2(unsigned a, unsigned b, float acc) {
    return __builtin_amdgcn_fdot2_f32_bf16(__builtin_bit_cast(bf16x2, a), __builtin_bit_cast(bf16x2, b), acc, false);
}
__device__ __forceinline__ float siluf(float x) { return x * __builtin_amdgcn_rcpf(1.0f + __expf(-x)); }
template <int CTRL> __device__ __forceinline__ float dppf(float x) {
    return __builtin_bit_cast(float, __builtin_amdgcn_update_dpp(0, __builtin_bit_cast(int, x), CTRL, 0xF, 0xF, true));
}
#define LDS_WAIT() asm volatile("s_waitcnt lgkmcnt(0)" ::: "memory")

namespace pg8 {
typedef int i32x4 __attribute__((ext_vector_type(4)));
constexpr int BM = 256, BK = 64, HALF = 128, HTB = HALF * BK * 2, STAGE_BYTES = 8 * HTB, NXCD = 8, WGM = 4;
__device__ __forceinline__ int lds_byte(int r, int c) { const int st = (r >> 4) * 2 + (c >> 5), rr = r & 15, cc = c & 31, ob = rr * 64 + cc * 2; return st * 1024 + (ob ^ (((ob >> 9) & 1) << 5)); }
__device__ __forceinline__ void stage_rc(int b, int& R, int& C) { const int st = b / 1024, sb = b % 1024, swz = sb ^ (((sb >> 9) & 1) << 5); R = (st >> 1) * 16 + swz / 64; C = (st & 1) * 32 + (swz % 64) / 2; }
__device__ __forceinline__ int perm32(int rho) { const int n = rho >> 4, i = rho & 15; return 8 * (i >> 2) + 4 * n + (i & 3); }
struct Unit { int pm, pn; };
struct Gemm { const bf16_t* A; const bf16_t* Bt; int M, N, K; };
struct StaticOrder {
    int nM, nN, nwg, G, c;
    __device__ void init(int M, int N, int G_, int c_) { nM = M / BM; nN = N / BM; nwg = nM * nN; G = G_; c = c_; }
    __device__ bool next(int i, Unit& u) const {
        const long L = (long)i * G + c; if (L >= nwg) return false;
        int wgid = (int)L; { const int q = nwg / NXCD, r = nwg % NXCD, xcd = wgid % NXCD, off = wgid / NXCD; wgid = (xcd < r ? xcd * (q + 1) : r * (q + 1) + (xcd - r) * q) + off; }
        const int nig = WGM * nN, gid = wgid / nig, fm = gid * WGM, gsz = (nM - fm) < WGM ? (nM - fm) : WGM;
        u.pm = fm + ((wgid % nig) % gsz); u.pn = (wgid % nig) / gsz; return true;
    }
};
__device__ __forceinline__ unsigned cvt_pk_bf16(float lo, float hi) { unsigned r; asm volatile("v_cvt_pk_bf16_f32 %0, %1, %2" : "=v"(r) : "v"(lo), "v"(hi)); return r; }

struct EpiBf16 {
    static constexpr bool PERM = true;
    bf16_t* O; int ldc;
    __device__ __forceinline__ void operator()(const f32x4 (&acc)[2][2][4][2], const Unit& u, int wr, int wc, int fr, int fq) const {
        const int row0 = u.pm * BM + wr * 64 + fr; const int col0 = u.pn * BM + wc * 32 + 8 * fq;
#pragma unroll
        for (int ai = 0; ai < 2; ++ai)
#pragma unroll
            for (int m = 0; m < 4; ++m) { bf16_t* rowp = O + (size_t)(row0 + ai * HALF + m * 16) * ldc + col0;
#pragma unroll
                for (int bj = 0; bj < 2; ++bj) { const f32x4 v0 = acc[ai][bj][m][0], v1 = acc[ai][bj][m][1];
                    u32x4 w; w.x = cvt_pk_bf16(v0[0], v0[1]); w.y = cvt_pk_bf16(v0[2], v0[3]); w.z = cvt_pk_bf16(v1[0], v1[1]); w.w = cvt_pk_bf16(v1[2], v1[3]);
                    *(u32x4*)(rowp + bj * HALF) = w; } }
    }
};
struct EpiBf16S {
    static constexpr bool PERM = true;
    bf16_t* O; int ldc; const float* ascale; const float* bscale;
    __device__ __forceinline__ void operator()(const i32x4 (&acc)[2][2][4][2], const Unit& u, int wr, int wc, int fr, int fq) const {
        const int row0 = u.pm * BM + wr * 64 + fr; const int col0 = u.pn * BM + wc * 32 + 8 * fq;
        f32x4 bs[2][2];
#pragma unroll
        for (int bj = 0; bj < 2; ++bj) { bs[bj][0] = *(const f32x4*)(bscale + col0 + bj * HALF); bs[bj][1] = *(const f32x4*)(bscale + col0 + bj * HALF + 4); }
#pragma unroll
        for (int ai = 0; ai < 2; ++ai)
#pragma unroll
            for (int m = 0; m < 4; ++m) { const int row = row0 + ai * HALF + m * 16; const float as = ascale[row]; bf16_t* rowp = O + (size_t)row * ldc + col0;
#pragma unroll
                for (int bj = 0; bj < 2; ++bj) { const i32x4 a0 = acc[ai][bj][m][0], a1 = acc[ai][bj][m][1];
                    const f32x4 v0 = (f32x4){(float)a0[0], (float)a0[1], (float)a0[2], (float)a0[3]} * bs[bj][0] * as;
                    const f32x4 v1 = (f32x4){(float)a1[0], (float)a1[1], (float)a1[2], (float)a1[3]} * bs[bj][1] * as;
                    u32x4 w; w.x = cvt_pk_bf16(v0[0], v0[1]); w.y = cvt_pk_bf16(v0[2], v0[3]); w.z = cvt_pk_bf16(v1[0], v1[1]); w.w = cvt_pk_bf16(v1[2], v1[3]);
                    *(u32x4*)(rowp + bj * HALF) = w; } }
    }
};
struct EpiResidS {
    static constexpr bool PERM = false;
    const float* x; const float* mod; bf16_t* out; const float* ascale; const float* bscale;
    __device__ __forceinline__ void operator()(const i32x4 (&acc)[2][2][4][2], const Unit& u, int wr, int wc, int fr, int fq) const {
        const int row0 = u.pm * BM + wr * 64 + fr, col0 = u.pn * BM + wc * 32 + 4 * fq;
        const int b = (u.pm * BM) >> 12;
        f32x4 gv[2][2];
#pragma unroll
        for (int bj = 0; bj < 2; ++bj)
#pragma unroll
            for (int n = 0; n < 2; ++n) gv[bj][n] = *(const f32x4*)(mod + (size_t)b * NMODC + 2048 + col0 + bj * HALF + n * 16) * *(const f32x4*)(bscale + col0 + bj * HALF + n * 16);
#pragma unroll
        for (int ai = 0; ai < 2; ++ai) {
            f32x4 xv[4][2][2]; float as[4];
#pragma unroll
            for (int m = 0; m < 4; ++m) { const int row = row0 + ai * HALF + m * 16; const size_t off = (size_t)row * DM + col0; as[m] = ascale[row];
#pragma unroll
                for (int bj = 0; bj < 2; ++bj)
#pragma unroll
                    for (int n = 0; n < 2; ++n) xv[m][bj][n] = *(const f32x4*)(x + off + bj * HALF + n * 16); }
            __builtin_amdgcn_sched_barrier(0);
#pragma unroll
            for (int m = 0; m < 4; ++m) { const int row = row0 + ai * HALF + m * 16; const size_t off = (size_t)row * DM + col0;
#pragma unroll
                for (int bj = 0; bj < 2; ++bj)
#pragma unroll
                    for (int n = 0; n < 2; ++n) { const i32x4 ai4 = acc[ai][bj][m][n];
                        const f32x4 r = xv[m][bj][n] + gv[bj][n] * ((f32x4){(float)ai4[0], (float)ai4[1], (float)ai4[2], (float)ai4[3]} * as[m]);
                        u32x2 w; w.x = cvt_pk_bf16(r[0], r[1]); w.y = cvt_pk_bf16(r[2], r[3]);
                        *(u32x2*)(out + off + bj * HALF + n * 16) = w; } }
        }
    }
};
struct EpiResid {
    static constexpr bool PERM = false;
    const float* x; const float* mod; bf16_t* out;
    __device__ __forceinline__ void operator()(const f32x4 (&acc)[2][2][4][2], const Unit& u, int wr, int wc, int fr, int fq) const {
        const int row0 = u.pm * BM + wr * 64 + fr, col0 = u.pn * BM + wc * 32 + 4 * fq;
        const int b = (u.pm * BM) >> 12;
        f32x4 gv[2][2];
#pragma unroll
        for (int bj = 0; bj < 2; ++bj)
#pragma unroll
            for (int n = 0; n < 2; ++n) gv[bj][n] = *(const f32x4*)(mod + (size_t)b * NMODC + 2048 + col0 + bj * HALF + n * 16);
#pragma unroll
        for (int ai = 0; ai < 2; ++ai)
#pragma unroll
            for (int m = 0; m < 4; ++m) { const size_t off = (size_t)(row0 + ai * HALF + m * 16) * DM + col0;
#pragma unroll
                for (int bj = 0; bj < 2; ++bj)
#pragma unroll
                    for (int n = 0; n < 2; ++n) { const f32x4 xv = *(const f32x4*)(x + off + bj * HALF + n * 16);
                        const f32x4 r = xv + gv[bj][n] * acc[ai][bj][m][n];
                        u32x2 w; w.x = cvt_pk_bf16(r[0], r[1]); w.y = cvt_pk_bf16(r[2], r[3]);
                        *(u32x2*)(out + off + bj * HALF + n * 16) = w; } }
    }
};

__device__ __forceinline__ f32x4 mma16(bf16x8 a, bf16x8 b, f32x4 c) { return __builtin_amdgcn_mfma_f32_16x16x32_bf16(a, b, c, 0, 0, 0); }
__device__ __forceinline__ i32x4 mma16(bf16x8 a, bf16x8 b, i32x4 c) { return __builtin_amdgcn_mfma_i32_16x16x64_i8(__builtin_bit_cast(i32x4, a), __builtin_bit_cast(i32x4, b), c, 0, 0, 0); }
template <class Epi, bool I8 = false>
__device__ __forceinline__ void gemm_phase(LAS unsigned char* lds, const Gemm g, const StaticOrder& S, const Epi& E) {
    typedef typename std::conditional<I8, i32x4, f32x4>::type acc_t;
    const int tid = threadIdx.x, wid = __builtin_amdgcn_readfirstlane(tid >> 6), lane = tid & 63, wr = wid >> 2, wc = wid & 3, fr = lane & 15, fq = lane >> 4;
    const int K = g.K, nt = K / BK;
    unsigned voffA[2], voffB[2];
#pragma unroll
    for (int i = 0; i < 2; ++i) { int R, C; stage_rc(tid * 16 + i * 8192, R, C); const int Rb = Epi::PERM ? ((R & ~31) + perm32(R & 31)) : R;
        voffA[i] = (unsigned)(R * K + C) * 2u; voffB[i] = (unsigned)(Rb * K + C) * 2u; }
    const size_t kstep = (size_t)(BK * 2);
    const size_t hstep = (size_t)HALF * K * 2;
    const size_t tstep = 2 * hstep;
    const unsigned ldsw = (unsigned)wid * 1024u;
    const int aoff = lds_byte(wr * 64 + fr, fq * 8), boff = lds_byte(wc * 32 + fr, fq * 8);
#define PG8_SA(b, h) (((b) * 2 + (h)) * HTB)
#define PG8_SB(b, h) ((4 + (b) * 2 + (h)) * HTB)
#define PG8_STAGE(bufoff, gbase, voff) do { _Pragma("unroll") for (int _i = 0; _i < 2; ++_i) \
        __builtin_amdgcn_global_load_lds((const unsigned*)((const char*)(gbase) + (voff)[_i]), (LAS unsigned*)(lds + (bufoff) + ldsw + _i * 8192), 16, 0, 0); } while (0)
#define PG8_LDA(dst, b, h) do { _Pragma("unroll") for (int m = 0; m < 4; ++m) _Pragma("unroll") for (int k = 0; k < 2; ++k) dst[m][k] = *(const LAS bf16x8*)(lds + PG8_SA(b, h) + aoff + m * 2048 + k * 1024); } while (0)
#define PG8_LDB(dst, b, h) do { _Pragma("unroll") for (int n = 0; n < 2; ++n) _Pragma("unroll") for (int k = 0; k < 2; ++k) dst[n][k] = *(const LAS bf16x8*)(lds + PG8_SB(b, h) + boff + n * 2048 + k * 1024); } while (0)
#define PG8_MMA(ai, bj, At, Bt) do { __builtin_amdgcn_s_setprio(1); _Pragma("unroll") for (int m = 0; m < 4; ++m) _Pragma("unroll") for (int n = 0; n < 2; ++n) _Pragma("unroll") for (int k = 0; k < 2; ++k) \
        acc[ai][bj][m][n] = mma16(Bt[n][k], At[m][k], acc[ai][bj][m][n]); __builtin_amdgcn_s_setprio(0); } while (0)
#define PG8_WAIT_V(n) asm volatile("s_waitcnt vmcnt(" #n ")" ::: "memory")
#define PG8_WAIT_L(n) asm volatile("s_waitcnt lgkmcnt(" #n ")" ::: "memory")
#define PG8_BAR __builtin_amdgcn_s_barrier()
#define PG8_SCHED __builtin_amdgcn_sched_barrier(0)
    Unit cur, nxt; int ui = 0;
    if (!S.next(0, cur)) return;
    acc_t acc[2][2][4][2];
#pragma unroll
    for (int a = 0; a < 2; ++a)
#pragma unroll
        for (int b = 0; b < 2; ++b)
#pragma unroll
            for (int m = 0; m < 4; ++m)
#pragma unroll
                for (int n = 0; n < 2; ++n) acc[a][b][m][n] = (acc_t){0, 0, 0, 0};
    bf16x8 At[4][2], B0[2][2], B1[2][2];
    const char* cA = (const char*)g.A + (size_t)cur.pm * tstep; const char* cB = (const char*)g.Bt + (size_t)cur.pn * tstep;
    PG8_STAGE(PG8_SB(0, 0), cB, voffB); PG8_STAGE(PG8_SA(0, 0), cA, voffA); PG8_STAGE(PG8_SB(0, 1), cB + hstep, voffB); PG8_STAGE(PG8_SA(0, 1), cA + hstep, voffA);
    if (wr == 1) PG8_BAR;
    PG8_WAIT_V(4); PG8_BAR;
    PG8_STAGE(PG8_SB(1, 0), cB + kstep, voffB); PG8_STAGE(PG8_SA(1, 0), cA + kstep, voffA); PG8_STAGE(PG8_SB(1, 1), cB + hstep + kstep, voffB);
    PG8_WAIT_V(6); PG8_BAR;
    for (;;) {
        const bool has_next = S.next(ui + 1, nxt);
        const char* nA = has_next ? (const char*)g.A + (size_t)nxt.pm * tstep : cA; const char* nB = has_next ? (const char*)g.Bt + (size_t)nxt.pn * tstep : cB;
        for (int t = 0; t < nt; t += 2) {
            const bool last = (t == nt - 2);
            const char* a1 = cA + (size_t)(t + 1) * kstep;
            const char* a2 = last ? nA : cA + (size_t)(t + 2) * kstep; const char* b2 = last ? nB : cB + (size_t)(t + 2) * kstep;
            const char* a3 = a2 + kstep; const char* b3 = b2 + kstep;
            PG8_LDB(B0, 0, 0); PG8_SCHED; PG8_LDA(At, 0, 0); PG8_STAGE(PG8_SA(1, 1), a1 + hstep, voffA);
            PG8_WAIT_L(8); PG8_BAR; PG8_WAIT_L(0); PG8_MMA(0, 0, At, B0); PG8_BAR; PG8_SCHED;
            PG8_LDB(B1, 0, 1); PG8_STAGE(PG8_SB(0, 0), b2, voffB);
            PG8_BAR; PG8_WAIT_L(0); PG8_MMA(0, 1, At, B1); PG8_BAR;
            PG8_LDA(At, 0, 1); PG8_STAGE(PG8_SA(0, 0), a2, voffA);
            PG8_BAR; PG8_WAIT_L(0); PG8_MMA(1, 0, At, B0); PG8_BAR; PG8_SCHED;
            PG8_STAGE(PG8_SB(0, 1), b2 + hstep, voffB);
            PG8_WAIT_V(6); PG8_BAR; PG8_MMA(1, 1, At, B1); PG8_BAR;
            PG8_LDB(B0, 1, 0); PG8_SCHED; PG8_LDA(At, 1, 0); PG8_STAGE(PG8_SA(0, 1), a2 + hstep, voffA);
            PG8_WAIT_L(8); PG8_BAR; PG8_WAIT_L(0); PG8_MMA(0, 0, At, B0); PG8_BAR; PG8_SCHED;
            PG8_LDB(B1, 1, 1); PG8_STAGE(PG8_SB(1, 0), b3, voffB);
            PG8_BAR; PG8_WAIT_L(0); PG8_MMA(0, 1, At, B1); PG8_BAR;
            PG8_LDA(At, 1, 1); PG8_STAGE(PG8_SA(1, 0), a3, voffA);
            PG8_BAR; PG8_WAIT_L(0); PG8_MMA(1, 0, At, B0); PG8_BAR; PG8_SCHED;
            PG8_STAGE(PG8_SB(1, 1), b3 + hstep, voffB);
            PG8_WAIT_V(6); PG8_BAR; PG8_MMA(1, 1, At, B1); PG8_BAR;
        }
        E(acc, cur, wr, wc, fr, fq);
        if (!has_next) break;
#pragma unroll
        for (int a = 0; a < 2; ++a)
#pragma unroll
            for (int b = 0; b < 2; ++b)
#pragma unroll
                for (int m = 0; m < 4; ++m)
#pragma unroll
                    for (int n = 0; n < 2; ++n) acc[a][b][m][n] = (acc_t){0, 0, 0, 0};
        cur = nxt; cA = nA; cB = nB; ++ui;
    }
    PG8_WAIT_V(0);
    if (wr == 0) PG8_BAR;
    PG8_BAR;
#undef PG8_SA
#undef PG8_SB
#undef PG8_STAGE
#undef PG8_LDA
#undef PG8_LDB
#undef PG8_MMA
#undef PG8_WAIT_V
#undef PG8_WAIT_L
#undef PG8_BAR
#undef PG8_SCHED
}
}

__device__ __forceinline__ void transpose_item(const float* W, int ldw, int K, bf16_t* WT, LAS float* scr, int kb, int src_col0, int dst_row0, int lane) {
    const int k0 = 64 * kb;
#pragma unroll 8
    for (int i = 0; i < 32; ++i) { const int kk = 2 * i + (lane >> 5); scr[kk * 33 + (lane & 31)] = W[(size_t)(k0 + kk) * ldw + src_col0 + (lane & 31)]; }
    LDS_WAIT();
    const int c = lane & 7;
#pragma unroll
    for (int j = 0; j < 4; ++j) { const int n = (lane >> 3) + 8 * j; const LAS float* s = scr + (8 * c) * 33 + n;
        u32x4 o; o.x = pk2(s[0 * 33], s[1 * 33]); o.y = pk2(s[2 * 33], s[3 * 33]); o.z = pk2(s[4 * 33], s[5 * 33]); o.w = pk2(s[6 * 33], s[7 * 33]);
        *(u32x4*)(WT + (size_t)(dst_row0 + n) * K + k0 + 8 * c) = o; }
    LDS_WAIT();
}

__device__ __forceinline__ void transpose_item_q(const float* W, int ldw, int K, signed char* WT, LAS float* scr, int kb, int src_col0, int dst_row0, int lane, const float* scale) {
    const int k0 = 64 * kb;
#pragma unroll 8
    for (int i = 0; i < 32; ++i) { const int kk = 2 * i + (lane >> 5); scr[kk * 33 + (lane & 31)] = W[(size_t)(k0 + kk) * ldw + src_col0 + (lane & 31)]; }
    LDS_WAIT();
    const int c = lane & 7;
#pragma unroll
    for (int j = 0; j < 4; ++j) { const int n = (lane >> 3) + 8 * j; const LAS float* s = scr + (8 * c) * 33 + n;
        const float sc = scale[dst_row0 + n], inv = sc > 0.f ? 1.0f / sc : 0.f;
        u32x2 o;
        o.x = ((unsigned)(int)rintf(s[0 * 33] * inv) & 255u) | (((unsigned)(int)rintf(s[1 * 33] * inv) & 255u) << 8) | (((unsigned)(int)rintf(s[2 * 33] * inv) & 255u) << 16) | (((unsigned)(int)rintf(s[3 * 33] * inv) & 255u) << 24);
        o.y = ((unsigned)(int)rintf(s[4 * 33] * inv) & 255u) | (((unsigned)(int)rintf(s[5 * 33] * inv) & 255u) << 8) | (((unsigned)(int)rintf(s[6 * 33] * inv) & 255u) << 16) | (((unsigned)(int)rintf(s[7 * 33] * inv) & 255u) << 24);
        *(u32x2*)(WT + (size_t)(dst_row0 + n) * K + k0 + 8 * c) = o; }
    LDS_WAIT();
}

__device__ __forceinline__ void phase0(const Args& a, LAS unsigned char* lds) {
    const int tid = threadIdx.x, lane = tid & 63, wave = tid >> 6, G = gridDim.x;
    unsigned char* ws = a.ws;
    if (blockIdx.x == 0 && tid < 64) ((unsigned*)(ws + WS_BAR))[16 * tid] = 0u;
    if (blockIdx.x == 1) for (int i = tid; i < 3456; i += NTHR) ((unsigned*)(ws + WS_XB))[i] = 0u;
    {
        const float* c = a.in[1]; const float* w_ada = a.in[2]; const float* b_ada = a.in[3]; float* mod = (float*)(ws + WS_MOD);
        LAS float* sc = (LAS float*)lds;
        LAS float* red = (LAS float*)(lds + 32768);
        if ((int)blockIdx.x < 96) {
            for (int i = tid; i < 8192; i += NTHR) sc[i] = siluf(c[i]);
            __syncthreads();
            for (int item = blockIdx.x; item < 96; item += G) {
                const int n = item * 64 + lane; float acc[8];
#pragma unroll
                for (int b = 0; b < 8; ++b) acc[b] = 0.f;
                for (int k4 = 0; k4 < 32; ++k4) {
                    const int k = wave * 128 + k4 * 4;
                    float wv[4];
#pragma unroll
                    for (int j = 0; j < 4; ++j) wv[j] = w_ada[(size_t)(k + j) * NMODC + n];
#pragma unroll
                    for (int b = 0; b < 8; ++b) { const f32x4 s = *(const LAS f32x4*)(sc + b * 1024 + k);
                        acc[b] += s[0] * wv[0] + s[1] * wv[1] + s[2] * wv[2] + s[3] * wv[3]; }
                }
#pragma unroll
                for (int b = 0; b < 8; ++b) red[(wave * 8 + b) * 64 + lane] = acc[b];
                __syncthreads();
                { const int b = tid >> 6; float s = 0.f;
#pragma unroll
                  for (int w = 0; w < 8; ++w) s += red[(w * 8 + b) * 64 + lane];
                  mod[b * NMODC + n] = s + b_ada[n]; }
                __syncthreads();
            }
        }
        __syncthreads();
    }
    if ((int)blockIdx.x >= 96) {
        LAS float* red = (LAS float*)lds;
        for (int cb = (int)blockIdx.x - 96; cb < 104; cb += G - 96) {
            const bool isq = cb >= 56 && cb < 88, iso = cb >= 88; const int n = (iso ? cb - 88 : (isq ? cb - 56 : cb)) * 64 + lane;
            const float* W = iso ? a.in[13] : (isq ? a.in[15] : a.in[5]); const int ldw = iso ? 1024 : (isq ? 2048 : LDW_IN); const int col = (isq || iso) ? n : n + (n >= 2048 ? 8 : 0);
            float m = 0.f;
            for (int k = wave * 128; k < wave * 128 + 128; ++k) m = fmaxf(m, fabsf(W[(size_t)k * ldw + col]));
            red[wave * 64 + lane] = m;
            __syncthreads();
            if (wave == 0) {
#pragma unroll
                for (int w = 1; w < 8; ++w) m = fmaxf(m, red[w * 64 + lane]);
                ((float*)(ws + (iso ? WS_WOS : (isq ? WS_WQS : WS_WINS))))[n] = m * (1.0f / 127.0f);
            }
            __syncthreads();
        }
    }
    {
        const size_t gt = (size_t)blockIdx.x * NTHR + tid, NGT = (size_t)G * NTHR;
        float* wsm = (float*)(ws + WS_WSM);
        for (size_t i = gt; i < 8 * 1024; i += NGT) { const int j = (int)(i >> 10), k = (int)(i & 1023); wsm[i] = a.in[5][(size_t)k * LDW_IN + 2048 + j]; }
    }
}
__device__ __forceinline__ void phase0b(const Args& a, LAS unsigned char* lds) {
    const int tid = threadIdx.x, lane = tid & 63, wave = tid >> 6, G = gridDim.x;
    unsigned char* ws = a.ws;
    {
        const int gw = blockIdx.x * NWAVE + wave, NGW = G * NWAVE;
        LAS float* scr = (LAS float*)(lds + wave * 8704);
        bf16_t* win_t = (bf16_t*)(ws + WS_WIN_T);
        constexpr int I_IN = 16 * (NPROJ / 32);
        for (int it = gw; it < I_IN; it += NGW) {
            const int kb = it / (NPROJ / 32), nb = it % (NPROJ / 32), n0 = nb * 32; if (INPROJ_I8) transpose_item_q(a.in[5], LDW_IN, 1024, (signed char*)win_t, scr, kb, n0 + (n0 >= 2048 ? 8 : 0), n0, lane, (const float*)(ws + WS_WINS));
            else transpose_item(a.in[5], LDW_IN, 1024, win_t, scr, kb, n0 + (n0 >= 2048 ? 8 : 0), n0, lane);
        }
    }
    {
        const size_t gt = (size_t)blockIdx.x * NTHR + tid, NGT = (size_t)G * NTHR;
        const float* sk = a.in[16]; unsigned* o = (unsigned*)(ws + WS_SUBK);
        for (size_t i = gt; i < 16 * 128 * 128 / 2; i += NGT) o[i] = pk2(sk[2 * i], sk[2 * i + 1]);
    }
}

__device__ __forceinline__ void late_prep(const Args& a, LAS unsigned char* lds, int widx, int nw) {
    const int lane = threadIdx.x & 63, wave = threadIdx.x >> 6;
    unsigned char* ws = a.ws;
    {
        LAS float* scr = (LAS float*)(lds + wave * 8704);
        bf16_t* wout_t = (bf16_t*)(ws + WS_WOUT_T); bf16_t* wq_t = (bf16_t*)(ws + WS_WQ_T);
        constexpr int I_OUT = 16 * 32, I_Q = 16 * 64;
        for (int it = widx; it < I_OUT + I_Q; it += nw) {
            if (it < I_OUT) { const int kb = it / 32, nb = it % 32; transpose_item_q(a.in[13], 1024, 1024, (signed char*)wout_t, scr, kb, nb * 32, nb * 32, lane, (const float*)(ws + WS_WOS)); }
            else { const int r = it - I_OUT, kb = r / 64, nb = r % 64;
                if (QUERY_I8) transpose_item_q(a.in[15], 2048, 1024, (signed char*)wq_t, scr, kb, nb * 32, nb * 32, lane, (const float*)(ws + WS_WQS));
                else transpose_item(a.in[15], 2048, 1024, wq_t, scr, kb, nb * 32, nb * 32, lane); }
        }
    }
    {
        const int G = 0; (void)G;
        { const int gw = widx, NGW = nw;
          for (int row = gw; row < 2 * 16384; row += NGW) {
              const bool isv = row >= 16384; const int e = row & 16383;
              const f32x4* src = (const f32x4*)((isv ? a.in[18] : a.in[17]) + (size_t)e * 1024) + lane;
              f32x4 v[4]; float am = 0.f;
#pragma unroll
              for (int j = 0; j < 4; ++j) { v[j] = src[64 * j]; am = fmaxf(am, fmaxf(fmaxf(fabsf(v[j][0]), fabsf(v[j][1])), fmaxf(fabsf(v[j][2]), fabsf(v[j][3])))); }
              am = wave_max(am);
              const float inv = am > 0.f ? 127.0f / am : 0.f;
              unsigned char* dst = ws + (isv ? WS_VT : WS_UT);
#pragma unroll
              for (int j = 0; j < 4; ++j) {
                  const unsigned pk = ((unsigned)(int)rintf(v[j][0] * inv) & 255u) | (((unsigned)(int)rintf(v[j][1] * inv) & 255u) << 8) |
                                      (((unsigned)(int)rintf(v[j][2] * inv) & 255u) << 16) | (((unsigned)(int)rintf(v[j][3] * inv) & 255u) << 24);
                  const int sl = 2 * j + (lane >> 5);
                  *(unsigned*)(dst + ((size_t)sl * 16384 + e) * 128 + ((4 * lane) & 127)) = pk;
              }
              if (lane == 0) ((float*)(ws + (isv ? WS_VS : WS_US)))[e] = am * (1.0f / 127.0f);
          } }
    }
}

__device__ __forceinline__ unsigned q8x4(float v0, float v1, float v2, float v3, float inv) {
    const float M = 12582912.0f;
    const unsigned t0 = __float_as_uint(fmaf(v0, inv, M)), t1 = __float_as_uint(fmaf(v1, inv, M)), t2 = __float_as_uint(fmaf(v2, inv, M)), t3 = __float_as_uint(fmaf(v3, inv, M));
    return __builtin_amdgcn_perm(t1, t0, 0x0c0c0400u) | __builtin_amdgcn_perm(t3, t2, 0x04000c0cu);
}
#ifndef NORM_PF_FIRST
#define NORM_PF_FIRST 1
#endif
template <bool FIRST>
__device__ __forceinline__ void phase_norm(const Args& a, const float* src, const float* gain, int shift_off, int scale_off) {
    const bf16_t* srcb = (const bf16_t*)(a.ws + WS_X1B);
    constexpr int R = FIRST ? 2 : 4;
    const int wave = threadIdx.x >> 6;
    const int gw = blockIdx.x * NWAVE + wave, NGW = gridDim.x * NWAVE;
    const float* mod = (const float*)(a.ws + WS_MOD); const float* wsm = (const float*)(a.ws + WS_WSM);
    bf16_t* dst = (bf16_t*)(a.ws + WS_ACT); float* small = (float*)(a.ws + WS_SMALL);
    typedef typename std::conditional<FIRST, f32x4, u32x2>::type raw_t;
    constexpr bool PF = NORM_PF_FIRST || !FIRST;
    const int rpw = (((T_TOK + NGW - 1) / NGW) + 3) & ~3, row_lo = gw * rpw, row_hi = (row_lo + rpw < T_TOK) ? row_lo + rpw : T_TOK;
    raw_t nx[R][4];
    if constexpr (PF) {
        const int lane0 = threadIdx.x & 63, tk = row_lo < T_TOK ? row_lo : 0;
#pragma unroll
        for (int q = 0; q < R; ++q)
#pragma unroll
            for (int j = 0; j < 4; ++j) nx[q][j] = ((const raw_t*)((FIRST ? (const char*)src : (const char*)srcb) + (size_t)(tk + q) * DM * (FIRST ? 4 : 2)) + lane0)[64 * j];
    }
    f32x4 gs[4], sh[4]; int pb = -1;
    for (int tok0 = row_lo; tok0 < row_hi; tok0 += R) {
        int lane = threadIdx.x & 63; asm volatile("" : "+v"(lane));
        if ((tok0 >> 12) != pb) { pb = tok0 >> 12; const float* mrow = mod + (size_t)pb * NMODC;
#pragma unroll
            for (int j = 0; j < 4; ++j) { const int d = 4 * lane + 256 * j;
                const f32x4 g = *(const f32x4*)(gain + d), sc = *(const f32x4*)(mrow + scale_off + d); gs[j] = g * (1.0f + sc); sh[j] = *(const f32x4*)(mrow + shift_off + d); } }
        f32x4 v[R][4]; float rstd[R];
#pragma unroll
        for (int q = 0; q < R; ++q)
#pragma unroll
            for (int j = 0; j < 4; ++j) {
                if constexpr (!PF) nx[q][j] = ((const raw_t*)((FIRST ? (const char*)src : (const char*)srcb) + (size_t)(tok0 + q) * DM * (FIRST ? 4 : 2)) + lane)[64 * j];
                if constexpr (FIRST) v[q][j] = nx[q][j];
                else { const u32x2 w = nx[q][j]; v[q][j] = (f32x4){bf_lo(w.x), bf_hi(w.x), bf_lo(w.y), bf_hi(w.y)}; }
            }
        if constexpr (PF) {
            const int tn = tok0 + R < row_hi ? tok0 + R : tok0;
#pragma unroll
            for (int q = 0; q < R; ++q)
#pragma unroll
                for (int j = 0; j < 4; ++j) nx[q][j] = ((const raw_t*)((FIRST ? (const char*)src : (const char*)srcb) + (size_t)(tn + q) * DM * (FIRST ? 4 : 2)) + lane)[64 * j];
        }
#pragma unroll
        for (int q = 0; q < R; ++q) { float ss = 0.f;
#pragma unroll
            for (int j = 0; j < 4; ++j) ss += (v[q][j][0] * v[q][j][0] + v[q][j][1] * v[q][j][1]) + (v[q][j][2] * v[q][j][2] + v[q][j][3] * v[q][j][3]);
            rstd[q] = ss; }
#pragma unroll
        for (int q = 0; q < R; ++q) rstd[q] = rsqrtf(wave_sum(rstd[q]) * (1.0f / DM) + EPS);
        float sa[R][8];
#pragma unroll
        for (int q = 0; q < R; ++q)
#pragma unroll
            for (int c = 0; c < 8; ++c) sa[q][c] = 0.f;
#pragma unroll
        for (int j = 0; j < 4; ++j) {
            const int d = 4 * lane + 256 * j;
#pragma unroll
            for (int q = 0; q < R; ++q) {
                v[q][j] = v[q][j] * rstd[q] * gs[j] + sh[j];
                if ((FIRST && !INPROJ_I8) || (!FIRST && !QUERY_I8)) { u32x2 o; o.x = pk2(v[q][j][0], v[q][j][1]); o.y = pk2(v[q][j][2], v[q][j][3]); *(u32x2*)(dst + (size_t)(tok0 + q) * DM + d) = o; }
            }
            if (FIRST) {
#pragma unroll
                for (int c = 0; c < 8; ++c) { const f32x4 w = *(const f32x4*)(wsm + c * 1024 + d);
#pragma unroll
                    for (int q = 0; q < R; ++q) sa[q][c] += (v[q][j][0] * w[0] + v[q][j][1] * w[1]) + (v[q][j][2] * w[2] + v[q][j][3] * w[3]); }
            }
            __builtin_amdgcn_sched_barrier(0);
        }
        if (!FIRST || INPROJ_I8) {
#pragma unroll
            for (int q = 0; q < R; ++q) {
                float am = 0.f;
#pragma unroll
                for (int j = 0; j < 4; ++j) am = fmaxf(am, fmaxf(fmaxf(fabsf(v[q][j][0]), fabsf(v[q][j][1])), fmaxf(fabsf(v[q][j][2]), fabsf(v[q][j][3]))));
                am = wave_max(am);
                const float inv = am > 0.f ? 127.0f / am : 0.f;
                unsigned* hq = (unsigned*)(a.ws + (FIRST ? WS_ACT : WS_HQ)) + (size_t)(tok0 + q) * 256;
#pragma unroll
                for (int j = 0; j < 4; ++j) hq[lane + 64 * j] = q8x4(v[q][j][0], v[q][j][1], v[q][j][2], v[q][j][3], inv);
                if (lane == 0) ((float*)(a.ws + (FIRST ? WS_H1S : WS_HS)))[tok0 + q] = am * (1.0f / 127.0f);
            }
        }
        if (FIRST) {
#pragma unroll
            for (int q = 0; q < R; ++q) {
                float ov = 0.f;
#pragma unroll
                for (int c = 0; c < 8; ++c) { const float s = wave_sum(sa[q][c]); if (lane == c) ov = s; }
                if (lane < 8) small[(size_t)(tok0 + q) * 8 + lane] = ov;
            }
        }
    }
}

typedef float f32x16 __attribute__((ext_vector_type(16)));
__device__ __forceinline__ unsigned cvt2(float lo, float hi) {
    typedef __bf16 bf2_t __attribute__((ext_vector_type(2)));
    bf2_t v; v[0] = (__bf16)lo; v[1] = (__bf16)hi; return __builtin_bit_cast(unsigned, v);
}
__device__ __forceinline__ int crow(int reg, int h) { return (reg & 3) + 8 * (reg >> 2) + 4 * h; }
constexpr int R_W = 0, R_QD = 16384, R_KDT = 32768, R_ATT = 49152, R_U = 57344;

template <int I> __device__ __forceinline__ void tsolve_load(f32x4 (&l)[8], const LAS float* Lb) {
#pragma unroll
    for (int j4 = 0; j4 < (I + 3) / 4; ++j4) l[j4] = *(const LAS f32x4*)(Lb + I * 68 + 4 * j4);
}
template <int I> __device__ __forceinline__ void tsolve_row(float (&x)[32], const LAS float* Lb, int c, f32x4 (&cur)[8], f32x4 (&nxt)[8]) {
    if constexpr (I + 1 < 32) { tsolve_load<I + 1>(nxt, Lb); __builtin_amdgcn_sched_barrier(0); }
    float a0 = 0.f, a1 = 0.f, a2 = 0.f, a3 = 0.f;
#pragma unroll
    for (int j4 = 0; j4 < (I + 3) / 4; ++j4) {
        const f32x4 l = cur[j4];
        if (4 * j4 + 0 < I) a0 += l[0] * x[4 * j4 + 0];
        if (4 * j4 + 1 < I) a1 += l[1] * x[4 * j4 + 1];
        if (4 * j4 + 2 < I) a2 += l[2] * x[4 * j4 + 2];
        if (4 * j4 + 3 < I) a3 += l[3] * x[4 * j4 + 3];
    }
    x[I] = (I == c ? 1.0f : 0.0f) - ((a0 + a1) + (a2 + a3));
}
template <int... Is> __device__ __forceinline__ void tsolve_all(float (&x)[32], const LAS float* Lb, int c, std::integer_sequence<int, Is...>) {
    f32x4 la[8], lb[8];
    tsolve_load<0>(la, Lb);
    ((Is % 2 == 0 ? tsolve_row<Is>(x, Lb, c, la, lb) : tsolve_row<Is>(x, Lb, c, lb, la)), ...);
}
__device__ __forceinline__ bf16x8 lda_split(const LAS unsigned char* p) {
    const u32x2 lo = *(const LAS u32x2*)p, hi = *(const LAS u32x2*)(p + 16);
    u32x4 v; v.x = lo.x; v.y = lo.y; v.z = hi.x; v.w = hi.y; return __builtin_bit_cast(bf16x8, v);
}
__device__ __forceinline__ bf16x8 pack8(const f32x16& x, int s) {
    u32x4 v; v.x = cvt2(x[8 * s], x[8 * s + 1]); v.y = cvt2(x[8 * s + 2], x[8 * s + 3]); v.z = cvt2(x[8 * s + 4], x[8 * s + 5]); v.w = cvt2(x[8 * s + 6], x[8 * s + 7]);
    return __builtin_bit_cast(bf16x8, v);
}

#ifndef DNP_DUP
#define DNP_DUP 0
#endif
#define DNP_REP(k) _Pragma("nounroll") for (int drep_ = 0; drep_ < 1 + ((DNP_DUP >> (k)) & 1); ++drep_)
constexpr int DNL_KBT = 98304, DNL_VBT = 116736, DNL_T = 135168, DNL_T11T = 144384;
__device__ __forceinline__ void dn_prep(const Args& a, LAS unsigned char* lds) {
    const bf16_t* proj = (const bf16_t*)(a.ws + WS_PROJ); const float* small = (const float*)(a.ws + WS_SMALL);
    const float* convw = a.in[6];
    LAS float* qs = (LAS float*)lds;
    LAS float* ks = (LAS float*)(lds + 32768);
    LAS float* vs = (LAS float*)(lds + 65536);
    LAS unsigned char* q16 = lds + 98304;
    LAS unsigned char* k16 = lds + 115712;
    LAS unsigned char* kb16 = lds + 133120;
    LAS float* sbeta = (LAS float*)(lds + 150528);
    LAS float* sG = sbeta + 64;
    LAS float* seG = sG + 64;
    LAS float* sbg = seG + 64;
    LAS float* Lm = (LAS float*)lds;
    float* gls = (float*)(a.ws + WS_GLS);
    u32x2 rawn[19];
    float bln = 0.f, dln = 0.f;
    f32x4 w[4]; int whd = -1;
    {
        const int tid0 = threadIdx.x, ci0 = blockIdx.x;
        if (tid0 < 384 && ci0 < 2048) {
            const int cgp = tid0 % 96, seg = tid0 / 96, which = cgp >> 5, c4 = (cgp & 31) * 4, col = which * 512 + ((ci0 >> 6) & 3) * 128 + c4;
#pragma unroll
            for (int r = 0; r < 19; ++r) { const int sp = (ci0 & 63) * 64 + 16 * seg - 3 + r;
                rawn[r] = *(const u32x2*)(proj + ((size_t)(ci0 >> 8) * SEQ + (sp < 0 ? 0 : sp)) * NPROJ + col); }
        }
        if (tid0 >= 448 && ci0 < 2048) { const size_t tk = (size_t)(ci0 >> 8) * SEQ + (ci0 & 63) * 64 + (tid0 - 448); bln = small[tk * 8 + ((ci0 >> 6) & 3)]; dln = small[tk * 8 + 4 + ((ci0 >> 6) & 3)]; }
#pragma unroll
        for (int j = 0; j < 4; ++j) w[j] = (f32x4){0.f, 0.f, 0.f, 0.f};
    }
    for (int ci = blockIdx.x; ci < 2048; ci += gridDim.x) {
        int tid = threadIdx.x; asm volatile("" : "+v"(tid));
        const int lane = tid & 63, wave = tid >> 6;
        const int b = ci >> 8, hd = (ci >> 6) & 3, n = ci & 63, s0 = n * 64; const size_t tok0 = (size_t)b * SEQ + s0;
        unsigned char* rec = a.ws + WS_DN + (size_t)ci * DN_REC;
        if (hd != whd) { whd = hd;
            if (tid < 384) { const int cgp = tid % 96, which = cgp >> 5, c4 = (cgp & 31) * 4, col = which * 512 + hd * 128 + c4;
#pragma unroll
                for (int j = 0; j < 4; ++j) w[j] = *(const f32x4*)(convw + j * 1536 + col); } }
        const float bl = bln, dl = dln;
        DNP_REP(0) if (tid < 384) {
            const int cgp = tid % 96, seg = tid / 96, which = cgp >> 5, c4 = (cgp & 31) * 4;
            u32x2 raw[19];
#pragma unroll
            for (int r = 0; r < 19; ++r) {
                const int sp = s0 + 16 * seg - 3 + r;
                raw[r] = (sp >= 0) ? rawn[r] : (u32x2){0u, 0u};
            }
            LAS float* dstp = (which == 0 ? qs : (which == 1 ? ks : vs)) + (16 * seg) * 128 + c4;
#pragma unroll
            for (int i = 0; i < 16; ++i) {
                f32x4 y = (f32x4){0.f, 0.f, 0.f, 0.f};
#pragma unroll
                for (int j = 0; j < 4; ++j) { const u32x2 u = raw[i + j];
                    y[0] += w[j][0] * bf_lo(u.x); y[1] += w[j][1] * bf_hi(u.x); y[2] += w[j][2] * bf_lo(u.y); y[3] += w[j][3] * bf_hi(u.y); }
                f32x4 r; r[0] = siluf(y[0]); r[1] = siluf(y[1]); r[2] = siluf(y[2]); r[3] = siluf(y[3]);
                *(LAS f32x4*)(dstp + i * 128) = r;
            }
        }
        if (wave == 7) {
            const float Aexp = __expf(a.in[7][hd]), dtb = a.in[8][hd];
            const float dlb = dl + dtb;
            const float sp = fmaxf(dlb, 0.f) + log1pf(expf(-fabsf(dlb)));
            float Gc = -Aexp * sp;
#pragma unroll
            for (int o = 1; o < 64; o <<= 1) { const float t = __shfl_up(Gc, o); if (lane >= o) Gc += t; }
            const float bt = 1.0f / (1.0f + expf(-bl)), eg = expf(Gc);
            sbeta[lane] = bt; sG[lane] = Gc; seG[lane] = eg; sbg[lane] = bt * eg;
        }
        __syncthreads();
        {
            const int cn = ci + (int)gridDim.x;
            if (tid < 384 && cn < 2048) {
                const int cgp = tid % 96, seg = tid / 96, which = cgp >> 5, c4 = (cgp & 31) * 4, col = which * 512 + ((cn >> 6) & 3) * 128 + c4;
#pragma unroll
                for (int r = 0; r < 19; ++r) { const int sp = (cn & 63) * 64 + 16 * seg - 3 + r;
                    rawn[r] = *(const u32x2*)(proj + ((size_t)(cn >> 8) * SEQ + (sp < 0 ? 0 : sp)) * NPROJ + col); }
            }
            if (tid >= 448 && cn < 2048) { const size_t tk = (size_t)(cn >> 8) * SEQ + (cn & 63) * 64 + (tid - 448); bln = small[tk * 8 + ((cn >> 6) & 3)]; dln = small[tk * 8 + 4 + ((cn >> 6) & 3)]; }
        }
        {
            const bool isk = wave >= 4;
            LAS float* pb = (isk ? ks : qs) + ((wave & 3) * 16) * 128 + 2 * lane;
#pragma unroll
            for (int r4 = 0; r4 < 4; ++r4) {
                f32x2 v[4]; float ss[4];
#pragma unroll
                for (int q = 0; q < 4; ++q) { v[q] = *(LAS f32x2*)(pb + (r4 * 4 + q) * 128); ss[q] = v[q][0] * v[q][0] + v[q][1] * v[q][1]; }
#pragma unroll
                for (int q = 0; q < 4; ++q) ss[q] = wave_sum(ss[q]);
#pragma unroll
                for (int q = 0; q < 4; ++q) { const float sc = rsqrtf(ss[q] + EPS) * (isk ? 1.0f : 0.08838834764831845f);
                    v[q][0] *= sc; v[q][1] *= sc; *(LAS f32x2*)(pb + (r4 * 4 + q) * 128) = v[q]; }
            }
        }
        __syncthreads();
        DNP_REP(1) for (int idx = tid; idx < 1024; idx += NTHR) {
            const int i = idx >> 4, d0 = (idx & 15) * 8; const float bt = sbeta[i], eg = seG[i];
            const f32x4 q0 = *(const LAS f32x4*)(qs + i * 128 + d0), q1 = *(const LAS f32x4*)(qs + i * 128 + d0 + 4);
            const f32x4 k0 = *(const LAS f32x4*)(ks + i * 128 + d0), k1 = *(const LAS f32x4*)(ks + i * 128 + d0 + 4);
            u32x4 o;
            o.x = cvt2(q0[0], q0[1]); o.y = cvt2(q0[2], q0[3]); o.z = cvt2(q1[0], q1[1]); o.w = cvt2(q1[2], q1[3]); *(LAS u32x4*)(q16 + i * 272 + d0 * 2) = o;
            o.x = cvt2(k0[0], k0[1]); o.y = cvt2(k0[2], k0[3]); o.z = cvt2(k1[0], k1[1]); o.w = cvt2(k1[2], k1[3]); *(LAS u32x4*)(k16 + i * 272 + d0 * 2) = o;
            o.x = cvt2(k0[0] * bt, k0[1] * bt); o.y = cvt2(k0[2] * bt, k0[3] * bt); o.z = cvt2(k1[0] * bt, k1[1] * bt); o.w = cvt2(k1[2] * bt, k1[3] * bt); *(LAS u32x4*)(kb16 + i * 272 + d0 * 2) = o;
            o.x = cvt2(q0[0] * eg, q0[1] * eg); o.y = cvt2(q0[2] * eg, q0[3] * eg); o.z = cvt2(q1[0] * eg, q1[1] * eg); o.w = cvt2(q1[2] * eg, q1[3] * eg);
            *(u32x4*)(rec + R_QD + (i * 128 + d0) * 2) = o;
        }
        DNP_REP(1) for (int idx = tid; idx < 1024; idx += NTHR) {
            const int d = idx & 127, i0 = (idx >> 7) * 8; const float G63 = sG[63];
            float v[8];
#pragma unroll
            for (int jj = 0; jj < 8; ++jj) v[jj] = ks[(i0 + jj) * 128 + d] * __expf(G63 - sG[i0 + jj]);
            u32x4 o; o.x = cvt2(v[0], v[1]); o.y = cvt2(v[2], v[3]); o.z = cvt2(v[4], v[5]); o.w = cvt2(v[6], v[7]);
            *(u32x4*)(rec + R_KDT + (d * 64 + i0) * 2) = o;
        }
        if (tid == 0) gls[ci] = seG[63];
        __syncthreads();
        DNP_REP(2) {
            const int which = wave >> 2, mt = (wave >> 1) & 1, nt = wave & 1, r32 = lane & 31, h = lane >> 5;
            const LAS unsigned char* Ab = (which ? q16 : kb16) + (32 * mt + r32) * 272 + h * 16;
            const LAS unsigned char* Bb = k16 + (32 * nt + r32) * 272 + h * 16;
            f32x16 acc;
#pragma unroll
            for (int r = 0; r < 16; ++r) acc[r] = 0.f;
#pragma unroll
            for (int kk = 0; kk < 8; ++kk) {
                const bf16x8 av = *(const LAS bf16x8*)(Ab + kk * 32), bv = *(const LAS bf16x8*)(Bb + kk * 32);
                acc = __builtin_amdgcn_mfma_f32_32x32x16_bf16(av, bv, acc, 0, 0, 0);
            }
            const int j = 32 * nt + r32; const float Gj = sG[j];
#pragma unroll
            for (int r = 0; r < 16; ++r) {
                const int i = 32 * mt + crow(r, h);
                const float val = acc[r] * __expf(sG[i] - Gj);
                if (which == 0) Lm[i * 68 + j] = (i > j) ? val : 0.f;
                else *(bf16_t*)(rec + R_ATT + (i * 64 + j) * 2) = (bf16_t)((i >= j) ? f2bf(val) : 0u);
            }
        }
        __syncthreads();
        const int n32 = lane & 31, h32 = lane >> 5;
        DNP_REP(3) {
        if (wave == 0) {
            int ln = lane; asm volatile("" : "+v"(ln));
            const int r = ln >> 5, c = ln & 31;
            float x[32];
            tsolve_all(x, Lm + (32 * r) * 68 + 32 * r, c, std::make_integer_sequence<int, 32>{});
            if (r == 0) {
#pragma unroll
                for (int q = 0; q < 4; ++q) { u32x4 o; o.x = cvt2(x[8 * q], x[8 * q + 1]); o.y = cvt2(x[8 * q + 2], x[8 * q + 3]); o.z = cvt2(x[8 * q + 4], x[8 * q + 5]); o.w = cvt2(x[8 * q + 6], x[8 * q + 7]);
                    *(LAS u32x4*)(lds + DNL_T11T + c * 80 + q * 16) = o; }
            }
            LAS bf16_t* Tp = (LAS bf16_t*)(lds + DNL_T) + (32 * r) * 72 + 32 * r + c;
#pragma unroll
            for (int i = 0; i < 32; ++i) Tp[i * 72] = (bf16_t)f2bf(x[i]);
            asm volatile("s_waitcnt lgkmcnt(0)" ::: "memory"); __builtin_amdgcn_wave_barrier();
            const int m = ln & 31, h = ln >> 5;
            f32x16 ax, a2;
#pragma unroll
            for (int q = 0; q < 16; ++q) { ax[q] = 0.f; a2[q] = 0.f; }
#pragma unroll
            for (int s = 0; s < 2; ++s) {
                const f32x4 l0 = *(const LAS f32x4*)(Lm + (32 + m) * 68 + 16 * s + 8 * h), l1 = *(const LAS f32x4*)(Lm + (32 + m) * 68 + 16 * s + 8 * h + 4);
                u32x4 av; av.x = cvt2(l0[0], l0[1]); av.y = cvt2(l0[2], l0[3]); av.z = cvt2(l1[0], l1[1]); av.w = cvt2(l1[2], l1[3]);
                const bf16x8 bv = *(const LAS bf16x8*)(lds + DNL_T11T + m * 80 + (16 * s + 8 * h) * 2);
                ax = __builtin_amdgcn_mfma_f32_32x32x16_bf16(__builtin_bit_cast(bf16x8, av), bv, ax, 0, 0, 0);
            }
#pragma unroll
            for (int s = 0; s < 2; ++s)
                a2 = __builtin_amdgcn_mfma_f32_32x32x16_bf16(lda_split(lds + DNL_T + (32 + m) * 144 + (32 + 16 * s + 4 * h) * 2), pack8(ax, s), a2, 0, 0, 0);
            LAS bf16_t* T21 = (LAS bf16_t*)(lds + DNL_T) + 32 * 72 + m;
#pragma unroll
            for (int q = 0; q < 16; ++q) T21[crow(q, h) * 72] = (bf16_t)f2bf(-a2[q]);
        } else {
            for (int idx = tid - 64; idx < 2048; idx += NTHR - 64) {
                const int c = idx & 127, jr = (idx >> 7) & 7, wh = idx >> 10;
                const LAS float* sp_ = (wh ? vs : ks) + c; const LAS float* sc = (wh ? sbeta : sbg) + 8 * jr;
                float v[8];
#pragma unroll
                for (int jj = 0; jj < 8; ++jj) v[jj] = sp_[(8 * jr + jj) * 128] * sc[jj];
                u32x4 o; o.x = cvt2(v[0], v[1]); o.y = cvt2(v[2], v[3]); o.z = cvt2(v[4], v[5]); o.w = cvt2(v[6], v[7]);
                *(LAS u32x4*)(lds + (wh ? DNL_VBT : DNL_KBT) + c * 144 + jr * 16) = o;
            }
        }
        }
        __syncthreads();
        {
            const bool isw = wave < 4;
            const LAS unsigned char* Bt = lds + (isw ? DNL_KBT : DNL_VBT) + (32 * (wave & 3) + n32) * 144 + h32 * 16;
            const LAS unsigned char* Ta = lds + DNL_T + n32 * 144 + h32 * 16;
            bf16x8 bv[4], t0[2], t1[4];
#pragma unroll
            for (int s = 0; s < 4; ++s) { bv[s] = *(const LAS bf16x8*)(Bt + s * 32); t1[s] = *(const LAS bf16x8*)(Ta + 32 * 144 + s * 32); }
#pragma unroll
            for (int s = 0; s < 2; ++s) t0[s] = *(const LAS bf16x8*)(Ta + s * 32);
            f32x16 c0, c1;
#pragma unroll
            for (int q = 0; q < 16; ++q) { c0[q] = 0.f; c1[q] = 0.f; }
            if (isw) {
#pragma unroll
                for (int s = 0; s < 2; ++s) c0 = __builtin_amdgcn_mfma_f32_32x32x16_bf16(bv[s], t0[s], c0, 0, 0, 0);
#pragma unroll
                for (int s = 0; s < 4; ++s) c1 = __builtin_amdgcn_mfma_f32_32x32x16_bf16(bv[s], t1[s], c1, 0, 0, 0);
                unsigned char* dst = rec + R_W + (size_t)(wave * 4096 + lane * 16);
                *(u32x4*)dst = __builtin_bit_cast(u32x4, pack8(c0, 0)); *(u32x4*)(dst + 1024) = __builtin_bit_cast(u32x4, pack8(c0, 1));
                *(u32x4*)(dst + 2048) = __builtin_bit_cast(u32x4, pack8(c1, 0)); *(u32x4*)(dst + 3072) = __builtin_bit_cast(u32x4, pack8(c1, 1));
            } else {
#pragma unroll
                for (int s = 0; s < 2; ++s) c0 = __builtin_amdgcn_mfma_f32_32x32x16_bf16(t0[s], bv[s], c0, 0, 0, 0);
#pragma unroll
                for (int s = 0; s < 4; ++s) c1 = __builtin_amdgcn_mfma_f32_32x32x16_bf16(t1[s], bv[s], c1, 0, 0, 0);
                unsigned char* dst = rec + R_U + (size_t)(((wave - 4) * 64 + lane) * 64);
                *(u32x4*)dst = __builtin_bit_cast(u32x4, pack8(c0, 0)); *(u32x4*)(dst + 16) = __builtin_bit_cast(u32x4, pack8(c0, 1));
                *(u32x4*)(dst + 32) = __builtin_bit_cast(u32x4, pack8(c1, 0)); *(u32x4*)(dst + 48) = __builtin_bit_cast(u32x4, pack8(c1, 1));
            }
        }
    }
    __syncthreads();
}

constexpr int DNB_W = 0, DNB_QD = 16896, DNB_KDT = 33792, DNB_ATT = 51200, DNB_U = 59904  , DNB_GL = 80384, DNB_SZ = 80400;
__device__ __forceinline__ void dn_issue_chunk(const unsigned char* rec, const float* glp, u32x4 (&v)[18], float& gl, int tl) {
    asm volatile("" : "+v"(tl));
#pragma unroll
    for (int i = 0; i < 18; ++i) v[i] = *(const u32x4*)(rec + (size_t)(tl + 256 * i) * 16);
    gl = *glp;
}
__device__ __forceinline__ void dn_write_chunk(const u32x4 (&v)[18], float gl, LAS unsigned char* buf, int tl) {
    asm volatile("" : "+v"(tl));
#pragma unroll
    for (int i = 0; i < 18; ++i) {
        const int q = tl + 256 * i;
        LAS unsigned char* d;
        if (i < 4) d = buf + DNB_W + q * 16;
        else if (i < 8) d = buf + DNB_QD + ((q - 1024) >> 4) * 264 + (q & 15) * 16;
        else if (i < 12) d = buf + DNB_KDT + ((q - 2048) >> 3) * 136 + (q & 7) * 16;
        else if (i < 14) d = buf + DNB_ATT + ((q - 3072) >> 3) * 136 + (q & 7) * 16;
        else d = buf + DNB_U + ((q - 3584) >> 2) * 80 + (q & 3) * 16;
        u32x2 lo, hi; lo.x = v[i].x; lo.y = v[i].y; hi.x = v[i].z; hi.y = v[i].w;
        *(LAS u32x2*)d = lo; *(LAS u32x2*)(d + 8) = hi;
    }
    if (tl == 0) *(LAS float*)(buf + DNB_GL) = gl;
}
__device__ __forceinline__ void dn_gate_norm(const Args& a) {
    const int lane = threadIdx.x & 63, wave = threadIdx.x >> 6;
    const int gw = blockIdx.x * NWAVE + wave, NGW = gridDim.x * NWAVE;
    const bf16_t* oraw = (const bf16_t*)a.out; const bf16_t* proj = (const bf16_t*)(a.ws + WS_PROJ); const bf16_t* mixed = (const bf16_t*)(a.ws + WS_ACT); const float* ogain = a.in[9];
    unsigned char* mq = a.ws + WS_MQ; float* ms = (float*)(a.ws + WS_MS);
    const f32x4 g0 = *(const f32x4*)(ogain + (lane & 15) * 8), g1 = *(const f32x4*)(ogain + (lane & 15) * 8 + 4);
    u32x4 on[2], zn[2], sn[2];
#pragma unroll
    for (int q = 0; q < 2; ++q) { const size_t tok = (size_t)((gw * 2 < T_TOK ? gw * 2 : 0) + q);
        on[q] = *(const u32x4*)(oraw + tok * 512 + lane * 8); zn[q] = *(const u32x4*)(proj + tok * NPROJ + 1536 + lane * 8); sn[q] = *(const u32x4*)(mixed + tok * DM + 512 + lane * 8); }
    for (int tok0 = gw * 2; tok0 < T_TOK; tok0 += NGW * 2) {
        u32x4 ov[2], zv[2], sv[2];
#pragma unroll
        for (int q = 0; q < 2; ++q) { ov[q] = on[q]; zv[q] = zn[q]; sv[q] = sn[q]; }
        {
            const int tn = tok0 + NGW * 2 < T_TOK ? tok0 + NGW * 2 : tok0;
#pragma unroll
            for (int q = 0; q < 2; ++q) { const size_t tok = (size_t)(tn + q);
                on[q] = *(const u32x4*)(oraw + tok * 512 + lane * 8); zn[q] = *(const u32x4*)(proj + tok * NPROJ + 1536 + lane * 8); sn[q] = *(const u32x4*)(mixed + tok * DM + 512 + lane * 8); }
        }
#pragma unroll
        for (int q = 0; q < 2; ++q) {
            float o[8], z[8], s[8];
#pragma unroll
            for (int c = 0; c < 4; ++c) { o[2 * c] = bf_lo(ov[q][c]); o[2 * c + 1] = bf_hi(ov[q][c]); z[2 * c] = bf_lo(zv[q][c]); z[2 * c + 1] = bf_hi(zv[q][c]); s[2 * c] = bf_lo(sv[q][c]); s[2 * c + 1] = bf_hi(sv[q][c]); }
            float ss = 0.f;
#pragma unroll
            for (int c = 0; c < 8; ++c) ss += o[c] * o[c];
            ss += dpp_<0xB1>(ss); ss += dpp_<0x4E>(ss); ss += dpp_<0x141>(ss); ss += dpp_<0x140>(ss);
            const float r = rsqrtf(ss * (1.0f / 128.0f) + EPS);
            float am = 0.f;
#pragma unroll
            for (int c = 0; c < 8; ++c) { o[c] = o[c] * r * (c < 4 ? g0[c] : g1[c - 4]) * siluf(z[c]); am = fmaxf(am, fmaxf(fabsf(o[c]), fabsf(s[c]))); }
            am = wave_max(am);
            const float inv = am > 0.f ? 127.0f / am : 0.f;
            u32x2 od, os;
            od.x = q8x4(o[0], o[1], o[2], o[3], inv); od.y = q8x4(o[4], o[5], o[6], o[7], inv);
            os.x = q8x4(s[0], s[1], s[2], s[3], inv); os.y = q8x4(s[4], s[5], s[6], s[7], inv);
            const size_t tok = (size_t)(tok0 + q);
            *(u32x2*)(mq + tok * 1024 + lane * 8) = od; *(u32x2*)(mq + tok * 1024 + 512 + lane * 8) = os;
            if (lane == 0) ms[tok] = am * (1.0f / 127.0f);
        }
    }
}
__device__ __forceinline__ void dn_scan2(const Args& a, LAS unsigned char* lds) {
    const int tid = threadIdx.x, lane = tid & 63, wave = __builtin_amdgcn_readfirstlane(tid >> 6);
    const int bh = blockIdx.x >> 1, dvh = blockIdx.x & 1, b = bh >> 2, hd = bh & 3;
    const unsigned char* recs = a.ws + WS_DN + (size_t)bh * 64 * DN_REC;
    const float* gls = (const float*)(a.ws + WS_GLS) + bh * 64;
    bf16_t* oraw = (bf16_t*)a.out;
    if (wave >= 4) {
        u32x4 pv[18]; float pgl;
        dn_issue_chunk(recs, gls, pv, pgl, tid - 256); dn_write_chunk(pv, pgl, lds, tid - 256); dn_issue_chunk(recs + DN_REC, gls + 1, pv, pgl, tid - 256);
        __syncthreads();
        for (int n = 0; n < 64; ++n) {
            if (n + 1 < 64) dn_write_chunk(pv, pgl, lds + ((n + 1) & 1) * DNB_SZ, tid - 256);
            if (n + 2 < 64) dn_issue_chunk(recs + (size_t)(n + 2) * DN_REC, gls + n + 2, pv, pgl, tid - 256);
            __syncthreads();
        }
        return;
    }
    if (wave >= 2) {
        __syncthreads();
        for (int n = 0; n < 64; ++n) __syncthreads();
        return;
    }
    const int cw = dvh * 2 + wave;
    f32x16 S[4]; bf16x8 BS[8];
#pragma unroll
    for (int kt = 0; kt < 4; ++kt)
#pragma unroll
        for (int r = 0; r < 16; ++r) S[kt][r] = 0.f;
#pragma unroll
    for (int ks = 0; ks < 8; ++ks) BS[ks] = (bf16x8){0, 0, 0, 0, 0, 0, 0, 0};
    __syncthreads();
    for (int n = 0; n < 64; ++n) {
        {
            int lane_o = lane; asm volatile("" : "+v"(lane_o));
            const int r32 = lane_o & 31, h = lane_o >> 5;
            const LAS unsigned char* B0 = lds + (n & 1) * DNB_SZ;
            const float gl = *(const LAS float*)(B0 + DNB_GL);
            const int koff = 8 * h;
            bf16x8 BV[4];
            {
                bf16x8 fa[16];
#pragma unroll
                for (int ks = 0; ks < 8; ++ks) { fa[2 * ks] = *(const LAS bf16x8*)(B0 + DNB_W + ((ks >> 1) * 4 + (ks & 1)) * 1024 + lane_o * 16); fa[2 * ks + 1] = *(const LAS bf16x8*)(B0 + DNB_W + ((ks >> 1) * 4 + 2 + (ks & 1)) * 1024 + lane_o * 16); }
                const LAS unsigned char* up = B0 + DNB_U + (cw * 64 + lane_o) * 80;
                u32x4 uq[4];
#pragma unroll
                for (int c = 0; c < 4; ++c) uq[c] = *(const LAS u32x4*)(up + c * 16);
                __builtin_amdgcn_sched_barrier(0);
                f32x16 X0, X1;
#pragma unroll
                for (int r = 0; r < 16; ++r) { X0[r] = 0.f; X1[r] = 0.f; }
#pragma unroll
                for (int ks = 0; ks < 8; ++ks) {
                    X0 = __builtin_amdgcn_mfma_f32_32x32x16_bf16(fa[2 * ks], BS[ks], X0, 0, 0, 0);
                    X1 = __builtin_amdgcn_mfma_f32_32x32x16_bf16(fa[2 * ks + 1], BS[ks], X1, 0, 0, 0);
                }
#pragma unroll
                for (int r = 0; r < 16; ++r) { const unsigned w0 = uq[r >> 3][(r >> 1) & 3], w1 = uq[2 + (r >> 3)][(r >> 1) & 3];
                    X0[r] = ((r & 1) ? bf_hi(w0) : bf_lo(w0)) - X0[r]; X1[r] = ((r & 1) ? bf_hi(w1) : bf_lo(w1)) - X1[r]; }
                BV[0] = pack8(X0, 0); BV[1] = pack8(X0, 1); BV[2] = pack8(X1, 0); BV[3] = pack8(X1, 1);
            }
            __builtin_amdgcn_sched_barrier(0);
            {
                bf16x8 fq[16], ft[8];
#pragma unroll
                for (int ks = 0; ks < 8; ++ks) { fq[2 * ks] = lda_split(B0 + DNB_QD + r32 * 264 + ks * 32 + koff); fq[2 * ks + 1] = lda_split(B0 + DNB_QD + (32 + r32) * 264 + ks * 32 + koff); }
                __builtin_amdgcn_sched_barrier(0);
                f32x16 O0, O1;
#pragma unroll
                for (int r = 0; r < 16; ++r) { O0[r] = 0.f; O1[r] = 0.f; }
#pragma unroll
                for (int ks = 0; ks < 4; ++ks) {
                    O0 = __builtin_amdgcn_mfma_f32_32x32x16_bf16(fq[2 * ks], BS[ks], O0, 0, 0, 0);
                    O1 = __builtin_amdgcn_mfma_f32_32x32x16_bf16(fq[2 * ks + 1], BS[ks], O1, 0, 0, 0);
                }
                __builtin_amdgcn_sched_barrier(0);
#pragma unroll
                for (int cs = 0; cs < 4; ++cs) { ft[2 * cs] = lda_split(B0 + DNB_ATT + r32 * 136 + cs * 32 + koff); ft[2 * cs + 1] = lda_split(B0 + DNB_ATT + (32 + r32) * 136 + cs * 32 + koff); }
                __builtin_amdgcn_sched_barrier(0);
#pragma unroll
                for (int ks = 4; ks < 8; ++ks) {
                    O0 = __builtin_amdgcn_mfma_f32_32x32x16_bf16(fq[2 * ks], BS[ks], O0, 0, 0, 0);
                    O1 = __builtin_amdgcn_mfma_f32_32x32x16_bf16(fq[2 * ks + 1], BS[ks], O1, 0, 0, 0);
                }
#pragma unroll
                for (int cs = 0; cs < 4; ++cs) {
                    O0 = __builtin_amdgcn_mfma_f32_32x32x16_bf16(ft[2 * cs], BV[cs], O0, 0, 0, 0);
                    O1 = __builtin_amdgcn_mfma_f32_32x32x16_bf16(ft[2 * cs + 1], BV[cs], O1, 0, 0, 0);
                }
                bf16_t* obu = oraw + ((size_t)b * SEQ + n * 64) * 512 + hd * 128 + 32 * cw;
                const unsigned lo = (unsigned)((4 * h) * 512 + r32);
#pragma unroll
                for (int r = 0; r < 16; ++r) { obu[lo + (unsigned)(((r & 3) + 8 * (r >> 2)) * 512)] = (bf16_t)f2bf(O0[r]); obu[lo + (unsigned)((32 + (r & 3) + 8 * (r >> 2)) * 512)] = (bf16_t)f2bf(O1[r]); }
            }
            __builtin_amdgcn_sched_barrier(0);
            {
                bf16x8 fk[16];
#pragma unroll
                for (int kt = 0; kt < 4; ++kt)
#pragma unroll
                    for (int cs = 0; cs < 4; ++cs) fk[kt * 4 + cs] = lda_split(B0 + DNB_KDT + (32 * kt + r32) * 136 + cs * 32 + koff);
#pragma unroll
                for (int kt = 0; kt < 4; ++kt)
#pragma unroll
                    for (int r = 0; r < 16; ++r) S[kt][r] *= gl;
                __builtin_amdgcn_sched_barrier(0);
#pragma unroll
                for (int cs = 0; cs < 4; ++cs)
#pragma unroll
                    for (int kt = 0; kt < 4; ++kt) S[kt] = __builtin_amdgcn_mfma_f32_32x32x16_bf16(fk[kt * 4 + cs], BV[cs], S[kt], 0, 0, 0);
            }
#pragma unroll
            for (int kt = 0; kt < 4; ++kt) { BS[2 * kt] = pack8(S[kt], 0); BS[2 * kt + 1] = pack8(S[kt], 1); }
        }
        __syncthreads();
    }
}

__device__ __forceinline__ void sb_prep(const Args& a) {
    const int lane = threadIdx.x & 63, wave = threadIdx.x >> 6;
    const int gw = blockIdx.x * NWAVE + wave, NGW = gridDim.x * NWAVE;
    bf16_t* proj = (bf16_t*)(a.ws + WS_PROJ);
    const float* gq = a.in[10]; const float* gk = a.in[11];
    {
        const int sub = lane & 7;
        float gsc[8];
#pragma unroll
        for (int j = 0; j < 8; ++j) gsc[j] = gq[sub * 8 + j] * gk[sub * 8 + j] * 0.125f;
        for (int r0 = gw * 8; r0 < T_TOK * 16; r0 += NGW * 8) {
            const int row = r0 + (lane >> 3); const int isk = row & 1, hd = (row >> 1) & 7; const size_t tok = (size_t)(row >> 4);
            u32x4* p = (u32x4*)(proj + tok * NPROJ + 2048 + isk * 512 + hd * 64 + sub * 8);
            const u32x4 w = *p;
            float ss = dot2(w.x, w.x, 0.f); ss = dot2(w.y, w.y, ss); ss = dot2(w.z, w.z, ss); ss = dot2(w.w, w.w, ss);
            ss += dppf<0xB1>(ss); ss += dppf<0x4E>(ss); ss += dppf<0x141>(ss);
            const float rs = rsqrtf(ss * (1.0f / 64.0f) + EPS);
            u32x4 o;
            if (isk) { o.x = pk2(bf_lo(w.x) * rs, bf_hi(w.x) * rs); o.y = pk2(bf_lo(w.y) * rs, bf_hi(w.y) * rs); o.z = pk2(bf_lo(w.z) * rs, bf_hi(w.z) * rs); o.w = pk2(bf_lo(w.w) * rs, bf_hi(w.w) * rs); }
            else { o.x = pk2(bf_lo(w.x) * rs * gsc[0], bf_hi(w.x) * rs * gsc[1]); o.y = pk2(bf_lo(w.y) * rs * gsc[2], bf_hi(w.y) * rs * gsc[3]);
                   o.z = pk2(bf_lo(w.z) * rs * gsc[4], bf_hi(w.z) * rs * gsc[5]); o.w = pk2(bf_lo(w.w) * rs * gsc[6], bf_hi(w.w) * rs * gsc[7]); }
            *p = o;
        }
    }
    {
        bf16_t* VT = (bf16_t*)((unsigned char*)a.out + VT_OFF);
        for (int item = gw; item < 64 * 64; item += NGW) {
            const int bh = item >> 6, kt = item & 63, b = bh >> 3, h = bh & 7;
            const u32x4* src = (const u32x4*)(proj + ((size_t)b * SEQ + kt * 64 + lane) * NPROJ + 3072 + h * 64);
            u32x4 v[8];
#pragma unroll
            for (int j = 0; j < 8; ++j) v[j] = src[j];
            bf16_t* dst = VT + ((size_t)bh * 64) * SEQ + kt * 64 + lane;
#pragma unroll
            for (int j = 0; j < 8; ++j)
#pragma unroll
                for (int c = 0; c < 4; ++c) { dst[(size_t)(j * 8 + 2 * c) * SEQ] = (bf16_t)(v[j][c] & 0xffffu); dst[(size_t)(j * 8 + 2 * c + 1) * SEQ] = (bf16_t)(v[j][c] >> 16); }
        }
    }
}

__device__ __forceinline__ void sb_attn(const Args& a, int wave_id, int n_waves) {
    const int lane = threadIdx.x & 63, r32 = lane & 31, hh = lane >> 5;
    const bf16_t* proj = (const bf16_t*)(a.ws + WS_PROJ); bf16_t* mixed = (bf16_t*)(a.ws + WS_ACT);
    const bf16_t* VT = (const bf16_t*)((const unsigned char*)a.out + VT_OFF);
    const float* go = a.in[12];
    const int krow_l = (r32 & 19) | ((r32 & 4) << 1) | ((r32 & 8) >> 1);
    for (int item = wave_id; item < 64 * 128; item += n_waves) {
        const int tile = 127 - (item >> 6), bh = item & 63, b = bh >> 3, h = bh & 7;
        const int t0 = tile * 32, t = t0 + r32; const size_t tokb = (size_t)b * SEQ;
        bf16x8 qf[4];
#pragma unroll
        for (int ks = 0; ks < 4; ++ks) qf[ks] = *(const bf16x8*)(proj + (tokb + t) * NPROJ + 2048 + h * 64 + 16 * ks + 8 * hh);
        f32x16 O0, O1;
#pragma unroll
        for (int r = 0; r < 16; ++r) { O0[r] = 0.f; O1[r] = 0.f; }
        float R = 0.f;
        const bf16_t* kbase = proj + (tokb + krow_l) * NPROJ + 2560 + h * 64 + 8 * hh;
        const bf16_t* vbase = VT + ((size_t)bh * 64 + r32) * SEQ + 8 * hh;
        for (int kb = tile; kb >= 0; --kb) {
            const int k0 = kb * 32;
            bf16x8 kf[4], vf[4];
#pragma unroll
            for (int ks = 0; ks < 4; ++ks) kf[ks] = *(const bf16x8*)(kbase + (size_t)k0 * NPROJ + 16 * ks);
#pragma unroll
            for (int mt = 0; mt < 2; ++mt)
#pragma unroll
                for (int s = 0; s < 2; ++s) vf[mt * 2 + s] = *(const bf16x8*)(vbase + (size_t)(32 * mt) * SEQ + k0 + 16 * s);
            f32x16 Z;
#pragma unroll
            for (int r = 0; r < 16; ++r) Z[r] = 0.f;
#pragma unroll
            for (int ks = 0; ks < 4; ++ks) Z = __builtin_amdgcn_mfma_f32_32x32x16_bf16(kf[ks], qf[ks], Z, 0, 0, 0);
            float l1[16], lb[16];
#pragma unroll
            for (int r = 0; r < 16; ++r) {
                const float z = Z[r];
                const float lp = __logf(1.0f + __expf(-fabsf(z)));
                const bool valid = (k0 + 16 * (r >> 3) + 8 * hh + (r & 7)) < t;
                l1[r] = valid ? -(fmaxf(z, 0.f) + lp) : 0.f;
                lb[r] = valid ? (fminf(z, 0.f) - lp) : -1.0e30f;
            }
            float sufA[8], sufB[8];
            sufA[7] = 0.f; sufB[7] = 0.f;
#pragma unroll
            for (int p = 6; p >= 0; --p) { sufA[p] = sufA[p + 1] + l1[p + 1]; sufB[p] = sufB[p + 1] + l1[8 + p + 1]; }
            const float sA = sufA[0] + l1[0], sB = sufB[0] + l1[8];
            const float pA = __shfl_xor(sA, 32), pB = __shfl_xor(sB, 32);
            const float aboveB = hh ? 0.f : pB;
            const float aboveA = hh ? (sB + pB) : (pB + sB + pA);
            const float RA = R + aboveA, RB = R + aboveB;
#pragma unroll
            for (int p = 0; p < 8; ++p) { Z[p] = __expf(lb[p] + RA + sufA[p]); Z[8 + p] = __expf(lb[8 + p] + RB + sufB[p]); }
            R += (sA + sB) + (pA + pB);
            const bf16x8 p0 = pack8(Z, 0), p1 = pack8(Z, 1);
            O0 = __builtin_amdgcn_mfma_f32_32x32x16_bf16(vf[0], p0, O0, 0, 0, 0);
            O0 = __builtin_amdgcn_mfma_f32_32x32x16_bf16(vf[1], p1, O0, 0, 0, 0);
            O1 = __builtin_amdgcn_mfma_f32_32x32x16_bf16(vf[2], p0, O1, 0, 0, 0);
            O1 = __builtin_amdgcn_mfma_f32_32x32x16_bf16(vf[3], p1, O1, 0, 0, 0);
            if (__all(R < -110.0f)) break;
        }
        float ss = 0.f;
#pragma unroll
        for (int r = 0; r < 16; ++r) ss += O0[r] * O0[r] + O1[r] * O1[r];
        ss += __shfl_xor(ss, 32);
        const float rn = rsqrtf(ss * (1.0f / 64.0f) + EPS);
        bf16_t* dst = mixed + (tokb + t) * DM + 512 + h * 64;
#pragma unroll
        for (int g = 0; g < 4; ++g) {
            const int d = 8 * g + 4 * hh;
            const f32x4 gv0 = *(const f32x4*)(go + d), gv1 = *(const f32x4*)(go + 32 + d);
            u32x2 w0, w1;
            w0.x = pk2(O0[4 * g] * rn * gv0[0], O0[4 * g + 1] * rn * gv0[1]); w0.y = pk2(O0[4 * g + 2] * rn * gv0[2], O0[4 * g + 3] * rn * gv0[3]);
            w1.x = pk2(O1[4 * g] * rn * gv1[0], O1[4 * g + 1] * rn * gv1[1]); w1.y = pk2(O1[4 * g + 2] * rn * gv1[2], O1[4 * g + 3] * rn * gv1[3]);
            *(u32x2*)(dst + d) = w0; *(u32x2*)(dst + 32 + d) = w1;
        }
    }
}

__device__ __forceinline__ void topk_insert(float (&L)[16], float x) {
#pragma unroll
    for (int i = 15; i >= 1; --i) L[i] = __builtin_amdgcn_fmed3f(L[i - 1], L[i], x);
    L[0] = fmaxf(L[0], x);
}
template <int I, int J> __device__ __forceinline__ void cand_ins(float (&M)[16], const float (&L0)[16], const float (&L1)[16]) {
    const float s = __uint_as_float(__float_as_uint(L0[I]) & ~127u) + __uint_as_float(__float_as_uint(L1[J]) & ~127u);
    topk_insert(M, __uint_as_float((__float_as_uint(s) & ~255u) | (unsigned)(I * 16 + J)));
}
template <int I, int... Js> __device__ __forceinline__ void cand_row(float (&M)[16], const float (&L0)[16], const float (&L1)[16], std::integer_sequence<int, Js...>) {
    (cand_ins<I, Js>(M, L0, L1), ...);
}
template <int... Is> __device__ __forceinline__ void cand_all(float (&M)[16], const float (&L0)[16], const float (&L1)[16], std::integer_sequence<int, Is...>) {
    (cand_row<Is>(M, L0, L1, std::make_integer_sequence<int, 16 / (Is + 1)>{}), ...);
}
__device__ __forceinline__ unsigned sel16(const float (&L)[16], int i) {
    unsigned r = __float_as_uint(L[0]);
#pragma unroll
    for (int k = 1; k < 16; ++k) { r = (i == k) ? __float_as_uint(L[k]) : r; asm volatile("" : "+v"(r)); }
    return r;
}
__device__ __forceinline__ void phase_scores(const Args& a, LAS unsigned char* lds, const pg8::StaticOrder& S) {
    const bf16_t* qp = (const bf16_t*)(a.ws + WS_QPEER); const bf16_t* kb = (const bf16_t*)(a.ws + WS_SUBK);
    unsigned* sel_e = (unsigned*)(a.ws + WS_SELE); float* sel_g = (float*)(a.ws + WS_SELG);
    pg8::Unit un;
    for (int ui = 0; S.next(ui, un); ++ui) {
        int tid = threadIdx.x; asm volatile("" : "+v"(tid));
        const int lane = tid & 63, wave = tid >> 6, r32 = lane & 31, hh = lane >> 5;
        const int h = un.pn, tile = un.pm;
        __syncthreads();
        for (int c = tid; c < 4096; c += NTHR) { const int r = c >> 4, cc = c & 15;
            *(LAS u32x4*)(lds + r * 272 + cc * 16) = *(const u32x4*)(kb + ((size_t)h * 256 + r) * 128 + cc * 8); }
        __syncthreads();
        const size_t tok = (size_t)tile * 256 + wave * 32 + r32;
        float L0[16], L1[16];
#pragma unroll
        for (int p = 0; p < 2; ++p) {
            bf16x8 bq[8];
#pragma unroll
            for (int ks = 0; ks < 8; ++ks) bq[ks] = *(const bf16x8*)(qp + tok * 2048 + (h * 2 + p) * 128 + 16 * ks + 8 * hh);
            float L[16];
#pragma unroll
            for (int i = 0; i < 16; ++i) L[i] = -3.0e38f;
#pragma unroll
            for (int kt = 0; kt < 4; ++kt) {
                f32x16 acc;
#pragma unroll
                for (int r = 0; r < 16; ++r) acc[r] = 0.f;
                const LAS unsigned char* Ab = lds + (p * 128 + 32 * kt + r32) * 272 + hh * 16;
#pragma unroll
                for (int ks = 0; ks < 8; ++ks) acc = __builtin_amdgcn_mfma_f32_32x32x16_bf16(*(const LAS bf16x8*)(Ab + ks * 32), bq[ks], acc, 0, 0, 0);
#pragma unroll
                for (int r = 0; r < 16; ++r) {
                    const unsigned key = (unsigned)(32 * kt + (r & 3) + 8 * (r >> 2)) + 4u * (unsigned)hh;
                    topk_insert(L, __uint_as_float((__float_as_uint(acc[r]) & ~127u) | key));
                }
            }
            float P[16];
#pragma unroll
            for (int i = 0; i < 16; ++i) P[i] = __shfl_xor(L[i], 32);
#pragma unroll
            for (int i = 0; i < 16; ++i) topk_insert(L, P[i]);
#pragma unroll
            for (int i = 0; i < 16; ++i) { if (p == 0) L0[i] = L[i]; else L1[i] = L[i]; }
        }
        float M[16];
#pragma unroll
        for (int i = 0; i < 16; ++i) M[i] = -3.0e38f;
        cand_all(M, L0, L1, std::make_integer_sequence<int, 16>{});
        const float m0 = __uint_as_float(__float_as_uint(M[0]) & ~255u);
        float den = 0.f;
#pragma unroll
        for (int i = 0; i < 16; ++i) den += __expf(__uint_as_float(__float_as_uint(M[i]) & ~255u) - m0);
        const float rden = 1.0f / den;
        unsigned eo[8]; float go[8];
#pragma unroll
        for (int q = 0; q < 8; ++q) {
            unsigned mlo = __float_as_uint(M[q]), mhi = __float_as_uint(M[8 + q]); asm volatile("" : "+v"(mlo), "+v"(mhi));
            const unsigned mb = hh ? mhi : mlo;
            const int ci = (mb >> 4) & 15, cj = mb & 15;
            eo[q] = (sel16(L0, ci) & 127u) * 128u + (sel16(L1, cj) & 127u);
            go[q] = __expf(__uint_as_float(mb & ~255u) - m0) * rden;
        }
        const size_t ob = (tok * 8 + h) * 16 + 8 * hh;
        *(u32x4*)(sel_e + ob) = (u32x4){eo[0], eo[1], eo[2], eo[3]}; *(u32x4*)(sel_e + ob + 4) = (u32x4){eo[4], eo[5], eo[6], eo[7]};
        *(f32x4*)(sel_g + ob) = (f32x4){go[0], go[1], go[2], go[3]}; *(f32x4*)(sel_g + ob + 4) = (f32x4){go[4], go[5], go[6], go[7]};
    }
}


template <int CTRL> __device__ __forceinline__ int dppi(int x) { return __builtin_amdgcn_update_dpp(0, x, CTRL, 0xF, 0xF, true); }
__device__ __forceinline__ void peer_gather(u32x4 (&w)[16], const LAS unsigned* idp, const unsigned char* tab) {
    u32x4 id[4];
#pragma unroll
    for (int c = 0; c < 4; ++c) id[c] = *(const LAS u32x4*)(idp + 4 * c);
#pragma unroll
    for (int i = 0; i < 16; ++i) w[i] = *(const u32x4*)(tab + (size_t)id[i >> 2][i & 3] * 128);
}
__device__ __forceinline__ void peer_u_reduce(const u32x4 (&w)[16], const u32x4 hq, LAS int* pp, bool first, bool b2, bool b1, bool b0) {
    int p[16];
#pragma unroll
    for (int i = 0; i < 16; ++i) {
        int acc = __builtin_amdgcn_sdot4((int)w[i].x, (int)hq.x, 0, false);
        acc = __builtin_amdgcn_sdot4((int)w[i].y, (int)hq.y, acc, false);
        acc = __builtin_amdgcn_sdot4((int)w[i].z, (int)hq.z, acc, false);
        p[i] = __builtin_amdgcn_sdot4((int)w[i].w, (int)hq.w, acc, false);
    }
    int q8[8], q4[4], q2[2];
#pragma unroll
    for (int k = 0; k < 8; ++k) { const int keep = b2 ? p[8 + k] : p[k], send = b2 ? p[k] : p[8 + k]; q8[k] = keep + dppi<0x141>(send); }
#pragma unroll
    for (int k = 0; k < 4; ++k) { const int keep = b1 ? q8[4 + k] : q8[k], send = b1 ? q8[k] : q8[4 + k]; q4[k] = keep + dppi<0x4E>(send); }
#pragma unroll
    for (int k = 0; k < 2; ++k) { const int keep = b0 ? q4[2 + k] : q4[k], send = b0 ? q4[k] : q4[2 + k]; q2[k] = keep + dppi<0xB1>(send); }
    if (first) { pp[0] = q2[0]; pp[8] = q2[1]; } else { pp[0] += q2[0]; pp[8] += q2[1]; }
}
__device__ __forceinline__ void peer_v_reduce(const u32x4 (&w)[16], const LAS unsigned* ap, float asc, float* op, const unsigned* xp, f32x2 gv, bool e0, bool e1, bool e2) {
    const u32x4 aq = *(const LAS u32x4*)ap;
    int y[16];
#pragma unroll
    for (int k = 0; k < 16; ++k) y[k] = 0;
#pragma unroll
    for (int g = 0; g < 4; ++g)
#pragma unroll
        for (int c = 0; c < 4; ++c) {
            const unsigned W0 = w[4 * g][c], W1 = w[4 * g + 1][c], W2 = w[4 * g + 2][c], W3 = w[4 * g + 3][c];
            const unsigned p01l = __builtin_amdgcn_perm(W1, W0, 0x05010400u), p01h = __builtin_amdgcn_perm(W1, W0, 0x07030602u);
            const unsigned p23l = __builtin_amdgcn_perm(W3, W2, 0x05010400u), p23h = __builtin_amdgcn_perm(W3, W2, 0x07030602u);
            const unsigned T0 = __builtin_amdgcn_perm(p23l, p01l, 0x05040100u), T1 = __builtin_amdgcn_perm(p23l, p01l, 0x07060302u);
            const unsigned T2 = __builtin_amdgcn_perm(p23h, p01h, 0x05040100u), T3 = __builtin_amdgcn_perm(p23h, p01h, 0x07060302u);
            y[4 * c + 0] = __builtin_amdgcn_sdot4((int)T0, (int)aq[g], y[4 * c + 0], false);
            y[4 * c + 1] = __builtin_amdgcn_sdot4((int)T1, (int)aq[g], y[4 * c + 1], false);
            y[4 * c + 2] = __builtin_amdgcn_sdot4((int)T2, (int)aq[g], y[4 * c + 2], false);
            y[4 * c + 3] = __builtin_amdgcn_sdot4((int)T3, (int)aq[g], y[4 * c + 3], false);
        }
    int z8[8], z4[4], z2[2];
#pragma unroll
    for (int k = 0; k < 8; ++k) { const int keep = e0 ? y[8 + k] : y[k], send = e0 ? y[k] : y[8 + k]; z8[k] = keep + dppi<0x128>(send); }
#pragma unroll
    for (int k = 0; k < 4; ++k) { const int keep = e1 ? z8[4 + k] : z8[k], send = e1 ? z8[k] : z8[4 + k]; z4[k] = keep + __shfl_xor(send, 16); }
#pragma unroll
    for (int k = 0; k < 2; ++k) { const int keep = e2 ? z4[2 + k] : z4[k], send = e2 ? z4[k] : z4[2 + k]; z2[k] = keep + __shfl_xor(send, 32); }
    const unsigned xw = *xp; const f32x2 xv = (f32x2){bf_lo(xw), bf_hi(xw)};
    *(f32x2*)op = xv + gv * (f32x2){(float)z2[0] * asc, (float)z2[1] * asc};
}
__device__ __forceinline__ void phase_peer(const Args& a, LAS unsigned char* lds) {
    const int wave = threadIdx.x >> 6;
    const int gw = blockIdx.x * NWAVE + wave, NGW = gridDim.x * NWAVE;
    const unsigned* gsel_e = (const unsigned*)(a.ws + WS_SELE); const float* gsel_g = (const float*)(a.ws + WS_SELG);
    const unsigned char* hq = a.ws + WS_HQ; const float* hsc = (const float*)(a.ws + WS_HS);
    const unsigned char* Uq = a.ws + WS_UT; const unsigned char* Vq = a.ws + WS_VT;
    const float* uscale = (const float*)(a.ws + WS_US); const float* vscale = (const float*)(a.ws + WS_VS);
    const float* mod = (const float*)(a.ws + WS_MOD); float* out = a.out; const bf16_t* x1b = (const bf16_t*)(a.ws + WS_X1B);
    LAS unsigned* ids = (LAS unsigned*)(lds + wave * 16384);
    LAS int* pre = (LAS int*)(lds + wave * 16384 + 8192);
    for (int grp = gw; grp * 16 < T_TOK; grp += NGW) {
        int lane = threadIdx.x & 63; asm volatile("" : "+v"(lane));
        const int sub = lane & 7, eg = lane >> 3;
        const bool b2 = (sub & 4) != 0, b1 = (sub & 2) != 0, b0 = (sub & 1) != 0;
        const bool e0 = (eg & 1) != 0, e1 = (eg & 2) != 0, e2 = (eg & 4) != 0;
        const size_t tok0 = (size_t)grp * 16;
#pragma unroll
        for (int j = 0; j < 8; ++j) {
            const int q = lane + 64 * j;
            const u32x4 v = *(const u32x4*)(gsel_e + tok0 * 128 + (size_t)q * 4);
            const int t = q >> 5, k = (q & 31) * 4;
#pragma unroll
            for (int c = 0; c < 4; ++c) ids[t * 128 + ((k + c) & 7) * 16 + ((k + c) >> 3)] = v[c];
        }
        LDS_WAIT();
        for (int s = 0; s < 8; ++s) {
            const unsigned char* Us = Uq + (size_t)s * 16384 * 128 + 16 * sub;
            const unsigned char* hs = hq + tok0 * DM + 128 * s + 16 * sub;
            u32x4 wA[16], wB[16], hA, hB;
            peer_gather(wA, ids + eg * 16, Us); hA = *(const u32x4*)(hs);
            for (int t = 0; t < 16; t += 2) {
                peer_gather(wB, ids + (t + 1) * 128 + eg * 16, Us); hB = *(const u32x4*)(hs + (t + 1) * DM);
                peer_u_reduce(wA, hA, pre + t * 128 + 16 * sub + eg, s == 0, b2, b1, b0);
                if (t + 2 < 16) { peer_gather(wA, ids + (t + 2) * 128 + eg * 16, Us); hA = *(const u32x4*)(hs + (t + 2) * DM); }
                peer_u_reduce(wB, hB, pre + (t + 1) * 128 + 16 * sub + eg, s == 0, b2, b1, b0);
            }
        }
        LDS_WAIT();
        for (int t = 0; t < 16; ++t) {
            float r[2]; const float hs_t = hsc[tok0 + t];
#pragma unroll
            for (int c = 0; c < 2; ++c) {
                const int k = lane + 64 * c;
                const unsigned e = ids[t * 128 + (k & 7) * 16 + (k >> 3)];
                const float pv = (float)pre[t * 128 + k] * (uscale[e] * hs_t);
                r[c] = 0.5f * pv * (1.0f + erff(pv * 0.70710678118654752f)) * gsel_g[(tok0 + t) * 128 + k] * vscale[e];
            }
            const float am = wave_max(fmaxf(fabsf(r[0]), fabsf(r[1])));
            const float inv = am > 0.f ? 127.0f / am : 0.f;
            LDS_WAIT();
            LAS unsigned char* ab = (LAS unsigned char*)(pre + t * 128);
#pragma unroll
            for (int c = 0; c < 2; ++c) { const int k = lane + 64 * c; ab[(k & 7) * 16 + (k >> 3)] = (unsigned char)((int)rintf(r[c] * inv) & 255); }
            if (lane == 0) *(LAS float*)(ab + 128) = am * (1.0f / 127.0f);
        }
        LDS_WAIT();
        for (int s = 0; s < 8; ++s) {
            const unsigned char* Vs = Vq + (size_t)s * 16384 * 128 + 16 * sub;
            const int d = 128 * s + 16 * sub + (e0 ? 8 : 0) + (e1 ? 4 : 0) + (e2 ? 2 : 0);
            const f32x2 gv = *(const f32x2*)(mod + (tok0 >> 12) * NMODC + 5120 + d);
            u32x4 wA[16], wB[16];
            peer_gather(wA, ids + eg * 16, Vs);
            for (int t = 0; t < 16; t += 2) {
                peer_gather(wB, ids + (t + 1) * 128 + eg * 16, Vs);
                peer_v_reduce(wA, (const LAS unsigned*)(pre + t * 128) + eg * 4, *(const LAS float*)((const LAS unsigned char*)(pre + t * 128) + 128), out + (tok0 + t) * DM + d, (const unsigned*)(x1b + (tok0 + t) * DM + d), gv, e0, e1, e2);
                if (t + 2 < 16) peer_gather(wA, ids + (t + 2) * 128 + eg * 16, Vs);
                peer_v_reduce(wB, (const LAS unsigned*)(pre + (t + 1) * 128) + eg * 4, *(const LAS float*)((const LAS unsigned char*)(pre + (t + 1) * 128) + 128), out + (tok0 + t + 1) * DM + d, (const unsigned*)(x1b + (tok0 + t + 1) * DM + d), gv, e0, e1, e2);
            }
        }
        LDS_WAIT();
    }
}

__device__ __forceinline__ void grid_barrier(unsigned* cnt, unsigned nblocks) {
    __syncthreads();
    if (threadIdx.x == 0) {
        __builtin_amdgcn_fence(__ATOMIC_RELEASE, "agent");
        asm volatile("s_waitcnt vmcnt(0)" ::: "memory");
        __hip_atomic_fetch_add(cnt, 1u, __ATOMIC_RELAXED, __HIP_MEMORY_SCOPE_AGENT);
        while (__hip_atomic_load(cnt, __ATOMIC_RELAXED, __HIP_MEMORY_SCOPE_AGENT) < nblocks) __builtin_amdgcn_s_sleep(2);
        __builtin_amdgcn_fence(__ATOMIC_ACQUIRE, "agent");
        asm volatile("s_waitcnt vmcnt(0)" ::: "memory");
    }
    __syncthreads();
}

#define XB_TMO      128
#define XB_XCNT(j)  (256  + 64 * (j))
#define XB_XSUB(j)  (1280 + 64 * (j))
#define XB_XGEN(j)  (2304 + 64 * (j))
#define XB_TOP      3328
#define XB_TOPGEN   3392
#define XB_SPIN_CAP (1u << 22)
__device__ __forceinline__ unsigned xb_ld(unsigned* p)              { return __hip_atomic_load(p, __ATOMIC_RELAXED, __HIP_MEMORY_SCOPE_AGENT); }
__device__ __forceinline__ unsigned xb_add(unsigned* p, unsigned v) { return __hip_atomic_fetch_add(p, v, __ATOMIC_RELAXED, __HIP_MEMORY_SCOPE_AGENT); }
__device__ __forceinline__ unsigned xb_xcc_id() { return (unsigned)__builtin_amdgcn_s_getreg((3 << 11) | 20) & 0xFu; }
#define XB_SPIN(cond, bar) do { unsigned _sp = 0; while (cond) { __builtin_amdgcn_s_sleep(1); \
    if ((++_sp & 255u) == 0u) { if (xb_ld(&(bar)[XB_TMO])) break; if (_sp > XB_SPIN_CAP) { atomicAdd(&(bar)[XB_TMO], 1u); break; } } } } while (0)
struct XcdBarrier { unsigned* bar; unsigned x; volatile LAS unsigned* st; };
__device__ __forceinline__ XcdBarrier xcd_barrier_post(unsigned* bar, volatile LAS unsigned* st) {
    XcdBarrier b; b.bar = bar; b.x = xb_xcc_id(); b.st = st;
    if (threadIdx.x == 0) (void)xb_add(&bar[XB_XCNT(b.x)], 1u);
    return b;
}
__device__ __forceinline__ void xcd_barrier_complete(unsigned* bar, unsigned x, unsigned& nloc, unsigned& nx) {
    const unsigned G = gridDim.x * gridDim.y * gridDim.z;
    unsigned sum, cnt, mine, sp = 0u;
    for (;;) {
        sum = 0u; cnt = 0u; mine = 0u;
#pragma unroll
        for (unsigned j = 0; j < 16; ++j) { const unsigned c = xb_ld(&bar[XB_XCNT(j)]); sum += c; cnt += (c > 0u) ? 1u : 0u; mine = (j == x) ? c : mine; }
        if (sum == G) break;
        __builtin_amdgcn_s_sleep(1);
        if ((++sp & 255u) == 0u) { if (xb_ld(&bar[XB_TMO])) break; if (sp > XB_SPIN_CAP) { atomicAdd(&bar[XB_TMO], 1u); break; } }
    }
    nloc = mine > 0u ? mine : 1u; nx = cnt > 0u ? cnt : 1u;
}
__device__ __forceinline__ void xcd_barrier(const XcdBarrier& b) {
    asm volatile("s_waitcnt vmcnt(0)" ::: "memory");
    __syncthreads();
    if (threadIdx.x == 0) {
        unsigned* bar = b.bar;
        __builtin_amdgcn_s_waitcnt(0);
        unsigned nloc = b.st[0], nx = b.st[1];
        if (nloc == 0u) { xcd_barrier_complete(bar, b.x, nloc, nx); b.st[0] = nloc; b.st[1] = nx; }
        const unsigned old = xb_add(&bar[XB_XSUB(b.x)], 1u);
        const unsigned gen = old / nloc;
        if (old + 1u == (gen + 1u) * nloc) {
            __builtin_amdgcn_fence(__ATOMIC_RELEASE, "agent");
            asm volatile("s_waitcnt vmcnt(0)" ::: "memory");
            const unsigned og = xb_add(&bar[XB_TOP], 1u);
            const unsigned tg = og / nx;
            if (og + 1u == (tg + 1u) * nx) xb_add(&bar[XB_TOPGEN], 1u);
            else XB_SPIN(xb_ld(&bar[XB_TOPGEN]) == tg, bar);
            __builtin_amdgcn_fence(__ATOMIC_ACQUIRE, "agent");
            xb_add(&bar[XB_XGEN(b.x)], 1u);
            asm volatile("s_waitcnt vmcnt(0)" ::: "memory");
        } else {
            XB_SPIN(xb_ld(&bar[XB_XGEN(b.x)]) == gen, bar);
            __builtin_amdgcn_fence(__ATOMIC_ACQUIRE, "agent");
            asm volatile("s_waitcnt vmcnt(0)" ::: "memory");
        }
    }
    __syncthreads();
}

__global__ void __launch_bounds__(NTHR, 2) mega(Args a) {
    extern __shared__ __attribute__((aligned(16))) unsigned char smem[];
    LAS unsigned char* lds = (LAS unsigned char*)smem;
    const int lo = a.ph_lo, hi = a.ph_hi;
    const int G = gridDim.x;
    if (threadIdx.x < 4) ((LAS unsigned*)(lds + LDS_BYTES - 16))[threadIdx.x] = 0u;
    XcdBarrier xb; xb.bar = (unsigned*)(a.ws + WS_XB); xb.x = 0; xb.st = (volatile LAS unsigned*)(lds + LDS_BYTES - 16);
#define IN(k) (lo <= (k) && (k) < hi)
#ifndef DUP_MASK
#define DUP_MASK 0
#endif
#define REP(k) for (int rep_ = 0; rep_ < 1 + ((DUP_MASK >> (k)) & 1); ++rep_, (((DUP_MASK >> 23) & 1) && ((DUP_MASK >> (k)) & 1) && (k) < 16 && rep_ == 1 ? grid_barrier((unsigned*)(a.ws + WS_BAR) + 64 * ((k) > 15 ? 15 : (k)) + 16, (unsigned)G) : (void)0))
#define SYNC(k) do { if (IN(k) && IN((k) + 1)) { if ((k) == 0) { cg::this_grid().sync(); xb = xcd_barrier_post((unsigned*)(a.ws + WS_XB), (volatile LAS unsigned*)(lds + LDS_BYTES - 16)); } else { xcd_barrier(xb); if ((DUP_MASK >> 22) & 1) xcd_barrier(xb); } } } while (0)
    if (IN(0)) REP(0) phase0(a, lds);
    SYNC(0);
    if (IN(1)) REP(1) { phase_norm<true>(a, a.in[0], a.in[4], 0, 1024); phase0b(a, lds); }
    SYNC(1);
#if INPROJ_I8
    if (IN(2)) REP(2) { pg8::Gemm g{(const bf16_t*)(a.ws + WS_ACT), (const bf16_t*)(a.ws + WS_WIN_T), T_TOK, NPROJ, 512}; pg8::StaticOrder S; S.init(T_TOK, NPROJ, G, (int)blockIdx.x);
        pg8::EpiBf16S E{(bf16_t*)(a.ws + WS_PROJ), NPROJ, (const float*)(a.ws + WS_H1S), (const float*)(a.ws + WS_WINS)}; pg8::gemm_phase<pg8::EpiBf16S, true>(lds, g, S, E); }
#else
    if (IN(2)) REP(2) { pg8::Gemm g{(const bf16_t*)(a.ws + WS_ACT), (const bf16_t*)(a.ws + WS_WIN_T), T_TOK, NPROJ, 1024}; pg8::StaticOrder S; S.init(T_TOK, NPROJ, G, (int)blockIdx.x);
        pg8::EpiBf16 E{(bf16_t*)(a.ws + WS_PROJ), NPROJ}; pg8::gemm_phase(lds, g, S, E); }
#endif
    SYNC(2);
    if (IN(3)) { REP(3) dn_prep(a, lds); REP(18) sb_prep(a); }
    SYNC(3);
    if (IN(4)) {
        if ((int)blockIdx.x < DN_BLOCKS) { REP(16) dn_scan2(a, lds); }
        else { REP(17) sb_attn(a, ((int)blockIdx.x - DN_BLOCKS) * NWAVE + (int)(threadIdx.x >> 6), (G - DN_BLOCKS) * NWAVE);
               late_prep(a, lds, ((int)blockIdx.x - DN_BLOCKS) * NWAVE + (int)(threadIdx.x >> 6), (G - DN_BLOCKS) * NWAVE); }
    }
    SYNC(4);
    if (IN(5)) REP(5) dn_gate_norm(a);
    SYNC(5);
    if (IN(6)) REP(6) { pg8::Gemm g{(const bf16_t*)(a.ws + WS_MQ), (const bf16_t*)(a.ws + WS_WOUT_T), T_TOK, 1024, 512}; pg8::StaticOrder S; S.init(T_TOK, 1024, G, (int)blockIdx.x);
        pg8::EpiResidS E{a.in[0], (const float*)(a.ws + WS_MOD), (bf16_t*)(a.ws + WS_X1B), (const float*)(a.ws + WS_MS), (const float*)(a.ws + WS_WOS)}; pg8::gemm_phase<pg8::EpiResidS, true>(lds, g, S, E); }
    SYNC(6);
    if (IN(7)) REP(7) phase_norm<false>(a, a.out, a.in[14], 3072, 4096);
    SYNC(7);
    if (IN(8)) REP(8) {
#if QUERY_I8
        pg8::Gemm g{(const bf16_t*)(a.ws + WS_HQ), (const bf16_t*)(a.ws + WS_WQ_T), T_TOK, 2048, 512}; pg8::StaticOrder S; S.init(T_TOK, 2048, G, (int)blockIdx.x);
        pg8::EpiBf16S E{(bf16_t*)(a.ws + WS_QPEER), 2048, (const float*)(a.ws + WS_HS), (const float*)(a.ws + WS_WQS)}; pg8::gemm_phase<pg8::EpiBf16S, true>(lds, g, S, E);
#else
        pg8::Gemm g{(const bf16_t*)(a.ws + WS_ACT), (const bf16_t*)(a.ws + WS_WQ_T), T_TOK, 2048, 1024}; pg8::StaticOrder S; S.init(T_TOK, 2048, G, (int)blockIdx.x);
        pg8::EpiBf16 E{(bf16_t*)(a.ws + WS_QPEER), 2048}; pg8::gemm_phase(lds, g, S, E);
#endif
        asm volatile("s_waitcnt vmcnt(0)" ::: "memory"); __syncthreads();
        phase_scores(a, lds, S); }
    SYNC(8);
    if (IN(10)) phase_peer(a, lds);
#undef IN
#undef SYNC
}

#ifndef ONE_LAUNCH
#define ONE_LAUNCH 1
#endif

extern "C" void kernel_launch(void* const* d_in, const int* in_sizes, int n_in, void* d_out, int out_size, void* d_ws, size_t ws_size, hipStream_t stream) {
    static int grid = 0;
    if (grid == 0) {
        int dev = 0, cus = 0, per_cu = 0;
        (void)hipGetDevice(&dev);
        (void)hipDeviceGetAttribute(&cus, hipDeviceAttributeMultiprocessorCount, dev);
        (void)hipFuncSetAttribute((const void*)mega, hipFuncAttributeMaxDynamicSharedMemorySize, LDS_BYTES);
        (void)hipOccupancyMaxActiveBlocksPerMultiprocessor(&per_cu, (const void*)mega, NTHR, LDS_BYTES);
        if (per_cu < 1) { fprintf(stderr, "kernel_launch: occupancy query says %d blocks/CU\n", per_cu); per_cu = 1; }
        if (per_cu > 1) per_cu = 1;
        grid = cus * per_cu;
        if (ws_size < WS_END3) fprintf(stderr, "kernel_launch: workspace too small: %zu < %zu\n", ws_size, (size_t)WS_END3);
    }
    Args a{};
    for (int i = 0; i < 19; ++i) a.in[i] = (const float*)d_in[i];
    a.out = (float*)d_out; a.ws = (unsigned char*)d_ws;
#if ONE_LAUNCH
    a.ph_lo = 0; a.ph_hi = N_PHASES;
    void* args[] = {&a};
    hipError_t e = hipLaunchCooperativeKernel((const void*)mega, dim3(grid), dim3(NTHR), args, LDS_BYTES, stream);
    if (e != hipSuccess) fprintf(stderr, "cooperative launch failed: %s (grid %d)\n", hipGetErrorString(e), grid);
#else
    for (int p = 0; p < N_PHASES; ++p) {
        a.ph_lo = p; a.ph_hi = p + 1;
        hipLaunchKernelGGL(mega, dim3(grid), dim3(NTHR), LDS_BYTES, stream, a);
    }
#endif
}
```

```cpp
#include <hip/hip_runtime.h>
#include <hip/hip_cooperative_groups.h>
#include <cstdio>
#include <utility>
#include <type_traits>
namespace cg = cooperative_groups;
#ifndef INPROJ_I8
#define INPROJ_I8 1
#endif
#ifndef QUERY_I8
#define QUERY_I8 1
#ifndef PAIR_CHAIN
#define PAIR_CHAIN 1
#endif
#endif

#define LAS __attribute__((address_space(3)))
typedef unsigned short bf16_t;
typedef short bf16x8 __attribute__((ext_vector_type(8)));
typedef float f32x4 __attribute__((ext_vector_type(4)));
typedef float f32x2 __attribute__((ext_vector_type(2)));
typedef unsigned u32x4 __attribute__((ext_vector_type(4)));
typedef unsigned u32x2 __attribute__((ext_vector_type(2)));
using bf16x2 = __attribute__((ext_vector_type(2))) __bf16;

constexpr int T_TOK = 32768, SEQ = 4096, DM = 1024, NMODC = 6144;
constexpr int NPROJ = 3584, LDW_IN = 3592;
constexpr int NTHR = 512, NWAVE = 8;
constexpr int LDS_BYTES = 160 * 1024;
constexpr int N_PHASES = 11;
constexpr int DN_BLOCKS = 64;
constexpr float EPS = 1e-6f;

constexpr size_t WS_MOD = 0;
constexpr size_t WS_WSM = WS_MOD + 8 * 6144 * 4;
constexpr size_t WS_SMALL = WS_WSM + 8 * 1024 * 4;
constexpr size_t WS_WIN_T = WS_SMALL + (size_t)T_TOK * 8 * 4;
constexpr size_t WS_WOUT_T = WS_WIN_T + (size_t)NPROJ * 1024 * 2;
constexpr size_t WS_WQ_T = WS_WOUT_T + (size_t)1024 * 1024 * 2;
constexpr size_t WS_SUBK = WS_WQ_T + (size_t)2048 * 1024 * 2;
constexpr size_t WS_UT = WS_SUBK + (size_t)16 * 128 * 128 * 2;
constexpr size_t WS_VT = WS_UT + (size_t)16384 * 1024 * 2;
constexpr size_t WS_US = WS_UT + (size_t)16384 * 1024;
constexpr size_t WS_VS = WS_US + 65536;
constexpr size_t WS_H1S = WS_VS + 65536;
constexpr size_t WS_WINS = WS_H1S + (size_t)T_TOK * 4;
constexpr size_t WS_WQS = WS_WINS + 16384;
constexpr size_t WS_WOS = WS_WQS + 8192;
constexpr size_t WS_MS = WS_WOS + 4096;
constexpr size_t WS_ACT = WS_VT + (size_t)16384 * 1024 * 2;
constexpr size_t WS_PROJ = WS_ACT + (size_t)T_TOK * 1024 * 2;
constexpr size_t WS_QPEER = WS_PROJ;
constexpr size_t WS_SELE = WS_PROJ + (size_t)T_TOK * 2048 * 2;
constexpr size_t WS_SELG = WS_SELE + (size_t)T_TOK * 128 * 4;
constexpr size_t WS_HQ = WS_SELG + (size_t)T_TOK * 128 * 4;
constexpr size_t WS_HS = WS_HQ + (size_t)T_TOK * 1024;
constexpr size_t WS_END = WS_PROJ + (size_t)T_TOK * NPROJ * 2;
constexpr size_t DN_REC = 73728;
constexpr size_t WS_DN = WS_END;
constexpr size_t WS_X1B = WS_DN;
constexpr size_t WS_MQ = WS_DN + (size_t)T_TOK * 1024 * 2;
constexpr size_t WS_GLS = WS_DN + 2048 * DN_REC;
constexpr size_t WS_END2 = WS_GLS + 8192;
constexpr size_t WS_BAR = WS_END2;
constexpr size_t WS_XB = WS_BAR + 16 * 256;
constexpr size_t WS_END3 = WS_XB + 3456 * 4;
constexpr size_t WS_PC = WS_END3;
constexpr size_t WS_END4 = WS_PC + 128 * 4 * 64 + 4096;
constexpr size_t VT_OFF = (size_t)T_TOK * 512 * 4;

struct Args { const float* in[19]; float* out; unsigned char* ws; int ph_lo, ph_hi; };

template <int CTRL> __device__ __forceinline__ float dpp_(float x) {
    return __builtin_bit_cast(float, __builtin_amdgcn_update_dpp(0, __builtin_bit_cast(int, x), CTRL, 0xF, 0xF, true));
}
__device__ __forceinline__ float wave_sum(float v) {
    v += dpp_<0xB1>(v); v += dpp_<0x4E>(v); v += dpp_<0x141>(v); v += dpp_<0x140>(v);
    v += __shfl_xor(v, 16); v += __shfl_xor(v, 32);
    return v;
}
__device__ __forceinline__ float wave_max(float v) {
    v = fmaxf(v, dpp_<0xB1>(v)); v = fmaxf(v, dpp_<0x4E>(v)); v = fmaxf(v, dpp_<0x141>(v)); v = fmaxf(v, dpp_<0x140>(v));
    v = fmaxf(v, __shfl_xor(v, 16)); v = fmaxf(v, __shfl_xor(v, 32));
    return v;
}
__device__ __forceinline__ unsigned pk2(float lo, float hi) {
    typedef __bf16 bf2v_t __attribute__((ext_vector_type(2)));
    bf2v_t v; v[0] = (__bf16)lo; v[1] = (__bf16)hi; return __builtin_bit_cast(unsigned, v);
}
__device__ __forceinline__ unsigned f2bf(float f) { return pk2(f, 0.f) & 0xffffu; }
__device__ __forceinline__ float bf_lo(unsigned w) { return __uint_as_float(w << 16); }
__device__ __forceinline__ float bf_hi(unsigned w) { return __uint_as_float(w & 0xffff0000u); }
__device__ __forceinline__ float dot2(unsigned a, unsigned b, float acc) {
    return __builtin_amdgcn_fdot2_f32_bf16(__builtin_bit_cast(bf16x2, a), __builtin_bit_cast(bf16x2, b), acc, false);
}
__device__ __forceinline__ float siluf(float x) { return x * __builtin_amdgcn_rcpf(1.0f + __expf(-x)); }
template <int CTRL> __device__ __forceinline__ float dppf(float x) {
    return __builtin_bit_cast(float, __builtin_amdgcn_update_dpp(0, __builtin_bit_cast(int, x), CTRL, 0xF, 0xF, true));
}
#define LDS_WAIT() asm volatile("s_waitcnt lgkmcnt(0)" ::: "memory")

namespace pg8 {
typedef int i32x4 __attribute__((ext_vector_type(4)));
constexpr int BM = 256, BK = 64, HALF = 128, HTB = HALF * BK * 2, STAGE_BYTES = 8 * HTB, NXCD = 8, WGM = 4;
__device__ __forceinline__ int lds_byte(int r, int c) { const int st = (r >> 4) * 2 + (c >> 5), rr = r & 15, cc = c & 31, ob = rr * 64 + cc * 2; return st * 1024 + (ob ^ (((ob >> 9) & 1) << 5)); }
__device__ __forceinline__ void stage_rc(int b, int& R, int& C) { const int st = b / 1024, sb = b % 1024, swz = sb ^ (((sb >> 9) & 1) << 5); R = (st >> 1) * 16 + swz / 64; C = (st & 1) * 32 + (swz % 64) / 2; }
__device__ __forceinline__ int perm32(int rho) { const int n = rho >> 4, i = rho & 15; return 8 * (i >> 2) + 4 * n + (i & 3); }
struct Unit { int pm, pn; };
struct Gemm { const bf16_t* A; const bf16_t* Bt; int M, N, K; };
struct StaticOrder {
    int nM, nN, nwg, G, c; bool pair;
    __device__ void init(int M, int N, int G_, int c_, bool pair_ = false) { nM = M / BM; nN = N / BM; nwg = nM * nN; G = G_; c = c_; pair = pair_; }
    __device__ bool next(int i, Unit& u) const {
        if (pair) {
            if (i >= nN / 2) return false;
            u.pm = c >> 1; u.pn = (c & 1) * (nN / 2) + i; return true;
        }
        const long L = (long)i * G + c; if (L >= nwg) return false;
        int wgid = (int)L; { const int q = nwg / NXCD, r = nwg % NXCD, xcd = wgid % NXCD, off = wgid / NXCD; wgid = (xcd < r ? xcd * (q + 1) : r * (q + 1) + (xcd - r) * q) + off; }
        const int nig = WGM * nN, gid = wgid / nig, fm = gid * WGM, gsz = (nM - fm) < WGM ? (nM - fm) : WGM;
        u.pm = fm + ((wgid % nig) % gsz); u.pn = (wgid % nig) / gsz; return true;
    }
};
__device__ __forceinline__ unsigned cvt_pk_bf16(float lo, float hi) { unsigned r; asm volatile("v_cvt_pk_bf16_f32 %0, %1, %2" : "=v"(r) : "v"(lo), "v"(hi)); return r; }

struct EpiBf16 {
    static constexpr bool PERM = true;
    bf16_t* O; int ldc;
    __device__ __forceinline__ void operator()(const f32x4 (&acc)[2][2][4][2], const Unit& u, int wr, int wc, int fr, int fq) const {
        const int row0 = u.pm * BM + wr * 64 + fr; const int col0 = u.pn * BM + wc * 32 + 8 * fq;
#pragma unroll
        for (int ai = 0; ai < 2; ++ai)
#pragma unroll
            for (int m = 0; m < 4; ++m) { bf16_t* rowp = O + (size_t)(row0 + ai * HALF + m * 16) * ldc + col0;
#pragma unroll
                for (int bj = 0; bj < 2; ++bj) { const f32x4 v0 = acc[ai][bj][m][0], v1 = acc[ai][bj][m][1];
                    u32x4 w; w.x = cvt_pk_bf16(v0[0], v0[1]); w.y = cvt_pk_bf16(v0[2], v0[3]); w.z = cvt_pk_bf16(v1[0], v1[1]); w.w = cvt_pk_bf16(v1[2], v1[3]);
                    *(u32x4*)(rowp + bj * HALF) = w; } }
    }
};
struct EpiBf16S {
    static constexpr bool PERM = true;
    bf16_t* O; int ldc; const float* ascale; const float* bscale;
    __device__ __forceinline__ void operator()(const i32x4 (&acc)[2][2][4][2], const Unit& u, int wr, int wc, int fr, int fq) const {
        const int row0 = u.pm * BM + wr * 64 + fr; const int col0 = u.pn * BM + wc * 32 + 8 * fq;
        f32x4 bs[2][2];
#pragma unroll
        for (int bj = 0; bj < 2; ++bj) { bs[bj][0] = *(const f32x4*)(bscale + col0 + bj * HALF); bs[bj][1] = *(const f32x4*)(bscale + col0 + bj * HALF + 4); }
#pragma unroll
        for (int ai = 0; ai < 2; ++ai)
#pragma unroll
            for (int m = 0; m < 4; ++m) { const int row = row0 + ai * HALF + m * 16; const float as = ascale[row]; bf16_t* rowp = O + (size_t)row * ldc + col0;
#pragma unroll
                for (int bj = 0; bj < 2; ++bj) { const i32x4 a0 = acc[ai][bj][m][0], a1 = acc[ai][bj][m][1];
                    const f32x4 v0 = (f32x4){(float)a0[0], (float)a0[1], (float)a0[2], (float)a0[3]} * bs[bj][0] * as;
                    const f32x4 v1 = (f32x4){(float)a1[0], (float)a1[1], (float)a1[2], (float)a1[3]} * bs[bj][1] * as;
                    u32x4 w; w.x = cvt_pk_bf16(v0[0], v0[1]); w.y = cvt_pk_bf16(v0[2], v0[3]); w.z = cvt_pk_bf16(v1[0], v1[1]); w.w = cvt_pk_bf16(v1[2], v1[3]);
                    *(u32x4*)(rowp + bj * HALF) = w; } }
    }
};
struct EpiResidS {
    static constexpr bool PERM = false;
    const float* x; const float* mod; bf16_t* out; const float* ascale; const float* bscale;
    __device__ __forceinline__ void operator()(const i32x4 (&acc)[2][2][4][2], const Unit& u, int wr, int wc, int fr, int fq) const {
        const int row0 = u.pm * BM + wr * 64 + fr, col0 = u.pn * BM + wc * 32 + 4 * fq;
        const int b = (u.pm * BM) >> 12;
        f32x4 gv[2][2];
#pragma unroll
        for (int bj = 0; bj < 2; ++bj)
#pragma unroll
            for (int n = 0; n < 2; ++n) gv[bj][n] = *(const f32x4*)(mod + (size_t)b * NMODC + 2048 + col0 + bj * HALF + n * 16) * *(const f32x4*)(bscale + col0 + bj * HALF + n * 16);
#pragma unroll
        for (int ai = 0; ai < 2; ++ai) {
            f32x4 xv[4][2][2]; float as[4];
#pragma unroll
            for (int m = 0; m < 4; ++m) { const int row = row0 + ai * HALF + m * 16; const size_t off = (size_t)row * DM + col0; as[m] = ascale[row];
#pragma unroll
                for (int bj = 0; bj < 2; ++bj)
#pragma unroll
                    for (int n = 0; n < 2; ++n) xv[m][bj][n] = *(const f32x4*)(x + off + bj * HALF + n * 16); }
            __builtin_amdgcn_sched_barrier(0);
#pragma unroll
            for (int m = 0; m < 4; ++m) { const int row = row0 + ai * HALF + m * 16; const size_t off = (size_t)row * DM + col0;
#pragma unroll
                for (int bj = 0; bj < 2; ++bj)
#pragma unroll
                    for (int n = 0; n < 2; ++n) { const i32x4 ai4 = acc[ai][bj][m][n];
                        const f32x4 r = xv[m][bj][n] + gv[bj][n] * ((f32x4){(float)ai4[0], (float)ai4[1], (float)ai4[2], (float)ai4[3]} * as[m]);
                        u32x2 w; w.x = cvt_pk_bf16(r[0], r[1]); w.y = cvt_pk_bf16(r[2], r[3]);
                        *(u32x2*)(out + off + bj * HALF + n * 16) = w; } }
        }
    }
};
struct EpiResid {
    static constexpr bool PERM = false;
    const float* x; const float* mod; bf16_t* out;
    __device__ __forceinline__ void operator()(const f32x4 (&acc)[2][2][4][2], const Unit& u, int wr, int wc, int fr, int fq) const {
        const int row0 = u.pm * BM + wr * 64 + fr, col0 = u.pn * BM + wc * 32 + 4 * fq;
        const int b = (u.pm * BM) >> 12;
        f32x4 gv[2][2];
#pragma unroll
        for (int bj = 0; bj < 2; ++bj)
#pragma unroll
            for (int n = 0; n < 2; ++n) gv[bj][n] = *(const f32x4*)(mod + (size_t)b * NMODC + 2048 + col0 + bj * HALF + n * 16);
#pragma unroll
        for (int ai = 0; ai < 2; ++ai)
#pragma unroll
            for (int m = 0; m < 4; ++m) { const size_t off = (size_t)(row0 + ai * HALF + m * 16) * DM + col0;
#pragma unroll
                for (int bj = 0; bj < 2; ++bj)
#pragma unroll
                    for (int n = 0; n < 2; ++n) { const f32x4 xv = *(const f32x4*)(x + off + bj * HALF + n * 16);
                        const f32x4 r = xv + gv[bj][n] * acc[ai][bj][m][n];
                        u32x2 w; w.x = cvt_pk_bf16(r[0], r[1]); w.y = cvt_pk_bf16(r[2], r[3]);
                        *(u32x2*)(out + off + bj * HALF + n * 16) = w; } }
    }
};

__device__ __forceinline__ f32x4 mma16(bf16x8 a, bf16x8 b, f32x4 c) { return __builtin_amdgcn_mfma_f32_16x16x32_bf16(a, b, c, 0, 0, 0); }
__device__ __forceinline__ i32x4 mma16(bf16x8 a, bf16x8 b, i32x4 c) { return __builtin_amdgcn_mfma_i32_16x16x64_i8(__builtin_bit_cast(i32x4, a), __builtin_bit_cast(i32x4, b), c, 0, 0, 0); }
template <class Epi, bool I8 = false>
__device__ __forceinline__ void gemm_phase(LAS unsigned char* lds, const Gemm g, const StaticOrder& S, const Epi& E) {
    typedef typename std::conditional<I8, i32x4, f32x4>::type acc_t;
    const int tid = threadIdx.x, wid = __builtin_amdgcn_readfirstlane(tid >> 6), lane = tid & 63, wr = wid >> 2, wc = wid & 3, fr = lane & 15, fq = lane >> 4;
    const int K = g.K, nt = K / BK;
    unsigned voffA[2], voffB[2];
#pragma unroll
    for (int i = 0; i < 2; ++i) { int R, C; stage_rc(tid * 16 + i * 8192, R, C); const int Rb = Epi::PERM ? ((R & ~31) + perm32(R & 31)) : R;
        voffA[i] = (unsigned)(R * K + C) * 2u; voffB[i] = (unsigned)(Rb * K + C) * 2u; }
    const size_t kstep = (size_t)(BK * 2);
    const size_t hstep = (size_t)HALF * K * 2;
    const size_t tstep = 2 * hstep;
    const unsigned ldsw = (unsigned)wid * 1024u;
    const int aoff = lds_byte(wr * 64 + fr, fq * 8), boff = lds_byte(wc * 32 + fr, fq * 8);
#define PG8_SA(b, h) (((b) * 2 + (h)) * HTB)
#define PG8_SB(b, h) ((4 + (b) * 2 + (h)) * HTB)
#define PG8_STAGE(bufoff, gbase, voff) do { _Pragma("unroll") for (int _i = 0; _i < 2; ++_i) \
        __builtin_amdgcn_global_load_lds((const unsigned*)((const char*)(gbase) + (voff)[_i]), (LAS unsigned*)(lds + (bufoff) + ldsw + _i * 8192), 16, 0, 0); } while (0)
#define PG8_LDA(dst, b, h) do { _Pragma("unroll") for (int m = 0; m < 4; ++m) _Pragma("unroll") for (int k = 0; k < 2; ++k) dst[m][k] = *(const LAS bf16x8*)(lds + PG8_SA(b, h) + aoff + m * 2048 + k * 1024); } while (0)
#define PG8_LDB(dst, b, h) do { _Pragma("unroll") for (int n = 0; n < 2; ++n) _Pragma("unroll") for (int k = 0; k < 2; ++k) dst[n][k] = *(const LAS bf16x8*)(lds + PG8_SB(b, h) + boff + n * 2048 + k * 1024); } while (0)
#define PG8_MMA(ai, bj, At, Bt) do { __builtin_amdgcn_s_setprio(1); _Pragma("unroll") for (int m = 0; m < 4; ++m) _Pragma("unroll") for (int n = 0; n < 2; ++n) _Pragma("unroll") for (int k = 0; k < 2; ++k) \
        acc[ai][bj][m][n] = mma16(Bt[n][k], At[m][k], acc[ai][bj][m][n]); __builtin_amdgcn_s_setprio(0); } while (0)
#define PG8_WAIT_V(n) asm volatile("s_waitcnt vmcnt(" #n ")" ::: "memory")
#define PG8_WAIT_L(n) asm volatile("s_waitcnt lgkmcnt(" #n ")" ::: "memory")
#define PG8_BAR __builtin_amdgcn_s_barrier()
#define PG8_SCHED __builtin_amdgcn_sched_barrier(0)
    Unit cur, nxt; int ui = 0;
    if (!S.next(0, cur)) return;
    acc_t acc[2][2][4][2];
#pragma unroll
    for (int a = 0; a < 2; ++a)
#pragma unroll
        for (int b = 0; b < 2; ++b)
#pragma unroll
            for (int m = 0; m < 4; ++m)
#pragma unroll
                for (int n = 0; n < 2; ++n) acc[a][b][m][n] = (acc_t){0, 0, 0, 0};
    bf16x8 At[4][2], B0[2][2], B1[2][2];
    const char* cA = (const char*)g.A + (size_t)cur.pm * tstep; const char* cB = (const char*)g.Bt + (size_t)cur.pn * tstep;
    PG8_STAGE(PG8_SB(0, 0), cB, voffB); PG8_STAGE(PG8_SA(0, 0), cA, voffA); PG8_STAGE(PG8_SB(0, 1), cB + hstep, voffB); PG8_STAGE(PG8_SA(0, 1), cA + hstep, voffA);
    if (wr == 1) PG8_BAR;
    PG8_WAIT_V(4); PG8_BAR;
    PG8_STAGE(PG8_SB(1, 0), cB + kstep, voffB); PG8_STAGE(PG8_SA(1, 0), cA + kstep, voffA); PG8_STAGE(PG8_SB(1, 1), cB + hstep + kstep, voffB);
    PG8_WAIT_V(6); PG8_BAR;
    for (;;) {
        const bool has_next = S.next(ui + 1, nxt);
        const char* nA = has_next ? (const char*)g.A + (size_t)nxt.pm * tstep : cA; const char* nB = has_next ? (const char*)g.Bt + (size_t)nxt.pn * tstep : cB;
        for (int t = 0; t < nt; t += 2) {
            const bool last = (t == nt - 2);
            const char* a1 = cA + (size_t)(t + 1) * kstep;
            const char* a2 = last ? nA : cA + (size_t)(t + 2) * kstep; const char* b2 = last ? nB : cB + (size_t)(t + 2) * kstep;
            const char* a3 = a2 + kstep; const char* b3 = b2 + kstep;
            PG8_LDB(B0, 0, 0); PG8_SCHED; PG8_LDA(At, 0, 0); PG8_STAGE(PG8_SA(1, 1), a1 + hstep, voffA);
            PG8_WAIT_L(8); PG8_BAR; PG8_WAIT_L(0); PG8_MMA(0, 0, At, B0); PG8_BAR; PG8_SCHED;
            PG8_LDB(B1, 0, 1); PG8_STAGE(PG8_SB(0, 0), b2, voffB);
            PG8_BAR; PG8_WAIT_L(0); PG8_MMA(0, 1, At, B1); PG8_BAR;
            PG8_LDA(At, 0, 1); PG8_STAGE(PG8_SA(0, 0), a2, voffA);
            PG8_BAR; PG8_WAIT_L(0); PG8_MMA(1, 0, At, B0); PG8_BAR; PG8_SCHED;
            PG8_STAGE(PG8_SB(0, 1), b2 + hstep, voffB);
            PG8_WAIT_V(6); PG8_BAR; PG8_MMA(1, 1, At, B1); PG8_BAR;
            PG8_LDB(B0, 1, 0); PG8_SCHED; PG8_LDA(At, 1, 0); PG8_STAGE(PG8_SA(0, 1), a2 + hstep, voffA);
            PG8_WAIT_L(8); PG8_BAR; PG8_WAIT_L(0); PG8_MMA(0, 0, At, B0); PG8_BAR; PG8_SCHED;
            PG8_LDB(B1, 1, 1); PG8_STAGE(PG8_SB(1, 0), b3, voffB);
            PG8_BAR; PG8_WAIT_L(0); PG8_MMA(0, 1, At, B1); PG8_BAR;
            PG8_LDA(At, 1, 1); PG8_STAGE(PG8_SA(1, 0), a3, voffA);
            PG8_BAR; PG8_WAIT_L(0); PG8_MMA(1, 0, At, B0); PG8_BAR; PG8_SCHED;
            PG8_STAGE(PG8_SB(1, 1), b3 + hstep, voffB);
            PG8_WAIT_V(6); PG8_BAR; PG8_MMA(1, 1, At, B1); PG8_BAR;
        }
        E(acc, cur, wr, wc, fr, fq);
        if (!has_next) break;
#pragma unroll
        for (int a = 0; a < 2; ++a)
#pragma unroll
            for (int b = 0; b < 2; ++b)
#pragma unroll
                for (int m = 0; m < 4; ++m)
#pragma unroll
                    for (int n = 0; n < 2; ++n) acc[a][b][m][n] = (acc_t){0, 0, 0, 0};
        cur = nxt; cA = nA; cB = nB; ++ui;
    }
    PG8_WAIT_V(0);
    if (wr == 0) PG8_BAR;
    PG8_BAR;
#undef PG8_SA
#undef PG8_SB
#undef PG8_STAGE
#undef PG8_LDA
#undef PG8_LDB
#undef PG8_MMA
#undef PG8_WAIT_V
#undef PG8_WAIT_L
#undef PG8_BAR
#undef PG8_SCHED
}
}

__device__ __forceinline__ void transpose_item(const float* W, int ldw, int K, bf16_t* WT, LAS float* scr, int kb, int src_col0, int dst_row0, int lane) {
    const int k0 = 64 * kb;
#pragma unroll 8
    for (int i = 0; i < 32; ++i) { const int kk = 2 * i + (lane >> 5); scr[kk * 33 + (lane & 31)] = W[(size_t)(k0 + kk) * ldw + src_col0 + (lane & 31)]; }
    LDS_WAIT();
    const int c = lane & 7;
#pragma unroll
    for (int j = 0; j < 4; ++j) { const int n = (lane >> 3) + 8 * j; const LAS float* s = scr + (8 * c) * 33 + n;
        u32x4 o; o.x = pk2(s[0 * 33], s[1 * 33]); o.y = pk2(s[2 * 33], s[3 * 33]); o.z = pk2(s[4 * 33], s[5 * 33]); o.w = pk2(s[6 * 33], s[7 * 33]);
        *(u32x4*)(WT + (size_t)(dst_row0 + n) * K + k0 + 8 * c) = o; }
    LDS_WAIT();
}

__device__ __forceinline__ void transpose_item_q(const float* W, int ldw, int K, signed char* WT, LAS float* scr, int kb, int src_col0, int dst_row0, int lane, const float* scale) {
    const int k0 = 64 * kb;
#pragma unroll 8
    for (int i = 0; i < 32; ++i) { const int kk = 2 * i + (lane >> 5); scr[kk * 33 + (lane & 31)] = W[(size_t)(k0 + kk) * ldw + src_col0 + (lane & 31)]; }
    LDS_WAIT();
    const int c = lane & 7;
#pragma unroll
    for (int j = 0; j < 4; ++j) { const int n = (lane >> 3) + 8 * j; const LAS float* s = scr + (8 * c) * 33 + n;
        const float sc = scale[dst_row0 + n], inv = sc > 0.f ? 1.0f / sc : 0.f;
        u32x2 o;
        o.x = ((unsigned)(int)rintf(s[0 * 33] * inv) & 255u) | (((unsigned)(int)rintf(s[1 * 33] * inv) & 255u) << 8) | (((unsigned)(int)rintf(s[2 * 33] * inv) & 255u) << 16) | (((unsigned)(int)rintf(s[3 * 33] * inv) & 255u) << 24);
        o.y = ((unsigned)(int)rintf(s[4 * 33] * inv) & 255u) | (((unsigned)(int)rintf(s[5 * 33] * inv) & 255u) << 8) | (((unsigned)(int)rintf(s[6 * 33] * inv) & 255u) << 16) | (((unsigned)(int)rintf(s[7 * 33] * inv) & 255u) << 24);
        *(u32x2*)(WT + (size_t)(dst_row0 + n) * K + k0 + 8 * c) = o; }
    LDS_WAIT();
}

__device__ __forceinline__ void phase0(const Args& a, LAS unsigned char* lds) {
    const int tid = threadIdx.x, lane = tid & 63, wave = tid >> 6, G = gridDim.x;
    unsigned char* ws = a.ws;
    if (blockIdx.x == 0 && tid < 64) ((unsigned*)(ws + WS_BAR))[16 * tid] = 0u;
    if (blockIdx.x == 2 % gridDim.x) for (int i = tid; i < 128 * 4 * 16; i += NTHR) ((unsigned*)(ws + WS_PC))[i] = 0u;
    if (blockIdx.x == 1) for (int i = tid; i < 3456; i += NTHR) ((unsigned*)(ws + WS_XB))[i] = 0u;
    {
        const float* c = a.in[1]; const float* w_ada = a.in[2]; const float* b_ada = a.in[3]; float* mod = (float*)(ws + WS_MOD);
        LAS float* sc = (LAS float*)lds;
        LAS float* red = (LAS float*)(lds + 32768);
        if ((int)blockIdx.x < 96) {
            for (int i = tid; i < 8192; i += NTHR) sc[i] = siluf(c[i]);
            __syncthreads();
            for (int item = blockIdx.x; item < 96; item += G) {
                const int n = item * 64 + lane; float acc[8];
#pragma unroll
                for (int b = 0; b < 8; ++b) acc[b] = 0.f;
                for (int k4 = 0; k4 < 32; ++k4) {
                    const int k = wave * 128 + k4 * 4;
                    float wv[4];
#pragma unroll
                    for (int j = 0; j < 4; ++j) wv[j] = w_ada[(size_t)(k + j) * NMODC + n];
#pragma unroll
                    for (int b = 0; b < 8; ++b) { const f32x4 s = *(const LAS f32x4*)(sc + b * 1024 + k);
                        acc[b] += s[0] * wv[0] + s[1] * wv[1] + s[2] * wv[2] + s[3] * wv[3]; }
                }
#pragma unroll
                for (int b = 0; b < 8; ++b) red[(wave * 8 + b) * 64 + lane] = acc[b];
                __syncthreads();
                { const int b = tid >> 6; float s = 0.f;
#pragma unroll
                  for (int w = 0; w < 8; ++w) s += red[(w * 8 + b) * 64 + lane];
                  mod[b * NMODC + n] = s + b_ada[n]; }
                __syncthreads();
            }
        }
        __syncthreads();
    }
    if ((int)blockIdx.x >= 96) {
        LAS float* red = (LAS float*)lds;
        for (int cb = (int)blockIdx.x - 96; cb < 104; cb += G - 96) {
            const bool isq = cb >= 56 && cb < 88, iso = cb >= 88; const int n = (iso ? cb - 88 : (isq ? cb - 56 : cb)) * 64 + lane;
            const float* W = iso ? a.in[13] : (isq ? a.in[15] : a.in[5]); const int ldw = iso ? 1024 : (isq ? 2048 : LDW_IN); const int col = (isq || iso) ? n : n + (n >= 2048 ? 8 : 0);
            float m = 0.f;
            for (int k = wave * 128; k < wave * 128 + 128; ++k) m = fmaxf(m, fabsf(W[(size_t)k * ldw + col]));
            red[wave * 64 + lane] = m;
            __syncthreads();
            if (wave == 0) {
#pragma unroll
                for (int w = 1; w < 8; ++w) m = fmaxf(m, red[w * 64 + lane]);
                ((float*)(ws + (iso ? WS_WOS : (isq ? WS_WQS : WS_WINS))))[n] = m * (1.0f / 127.0f);
            }
            __syncthreads();
        }
    }
    {
        const size_t gt = (size_t)blockIdx.x * NTHR + tid, NGT = (size_t)G * NTHR;
        float* wsm = (float*)(ws + WS_WSM);
        for (size_t i = gt; i < 8 * 1024; i += NGT) { const int j = (int)(i >> 10), k = (int)(i & 1023); wsm[i] = a.in[5][(size_t)k * LDW_IN + 2048 + j]; }
    }
}
__device__ __forceinline__ void phase0b(const Args& a, LAS unsigned char* lds) {
    const int tid = threadIdx.x, lane = tid & 63, wave = tid >> 6, G = gridDim.x;
    unsigned char* ws = a.ws;
    {
        const int gw = blockIdx.x * NWAVE + wave, NGW = G * NWAVE;
        LAS float* scr = (LAS float*)(lds + wave * 8704);
        bf16_t* win_t = (bf16_t*)(ws + WS_WIN_T);
        constexpr int I_IN = 16 * (NPROJ / 32);
        for (int it = gw; it < I_IN; it += NGW) {
            const int kb = it / (NPROJ / 32), nb = it % (NPROJ / 32), n0 = nb * 32; if (INPROJ_I8) transpose_item_q(a.in[5], LDW_IN, 1024, (signed char*)win_t, scr, kb, n0 + (n0 >= 2048 ? 8 : 0), n0, lane, (const float*)(ws + WS_WINS));
            else transpose_item(a.in[5], LDW_IN, 1024, win_t, scr, kb, n0 + (n0 >= 2048 ? 8 : 0), n0, lane);
        }
    }
    {
        const size_t gt = (size_t)blockIdx.x * NTHR + tid, NGT = (size_t)G * NTHR;
        const float* sk = a.in[16]; unsigned* o = (unsigned*)(ws + WS_SUBK);
        for (size_t i = gt; i < 16 * 128 * 128 / 2; i += NGT) o[i] = pk2(sk[2 * i], sk[2 * i + 1]);
    }
}

__device__ __forceinline__ void late_prep(const Args& a, LAS unsigned char* lds, int widx, int nw) {
    const int lane = threadIdx.x & 63, wave = threadIdx.x >> 6;
    unsigned char* ws = a.ws;
    {
        LAS float* scr = (LAS float*)(lds + wave * 8704);
        bf16_t* wout_t = (bf16_t*)(ws + WS_WOUT_T); bf16_t* wq_t = (bf16_t*)(ws + WS_WQ_T);
        constexpr int I_OUT = 16 * 32, I_Q = 16 * 64;
        for (int it = widx; it < I_OUT + I_Q; it += nw) {
            if (it < I_OUT) { const int kb = it / 32, nb = it % 32; transpose_item_q(a.in[13], 1024, 1024, (signed char*)wout_t, scr, kb, nb * 32, nb * 32, lane, (const float*)(ws + WS_WOS)); }
            else { const int r = it - I_OUT, kb = r / 64, nb = r % 64;
                if (QUERY_I8) transpose_item_q(a.in[15], 2048, 1024, (signed char*)wq_t, scr, kb, nb * 32, nb * 32, lane, (const float*)(ws + WS_WQS));
                else transpose_item(a.in[15], 2048, 1024, wq_t, scr, kb, nb * 32, nb * 32, lane); }
        }
    }
    {
        const int G = 0; (void)G;
        { const int gw = widx, NGW = nw;
          for (int row = gw; row < 2 * 16384; row += NGW) {
              const bool isv = row >= 16384; const int e = row & 16383;
              const f32x4* src = (const f32x4*)((isv ? a.in[18] : a.in[17]) + (size_t)e * 1024) + lane;
              f32x4 v[4]; float am = 0.f;
#pragma unroll
              for (int j = 0; j < 4; ++j) { v[j] = src[64 * j]; am = fmaxf(am, fmaxf(fmaxf(fabsf(v[j][0]), fabsf(v[j][1])), fmaxf(fabsf(v[j][2]), fabsf(v[j][3])))); }
              am = wave_max(am);
              const float inv = am > 0.f ? 127.0f / am : 0.f;
              unsigned char* dst = ws + (isv ? WS_VT : WS_UT);
#pragma unroll
              for (int j = 0; j < 4; ++j) {
                  const unsigned pk = ((unsigned)(int)rintf(v[j][0] * inv) & 255u) | (((unsigned)(int)rintf(v[j][1] * inv) & 255u) << 8) |
                                      (((unsigned)(int)rintf(v[j][2] * inv) & 255u) << 16) | (((unsigned)(int)rintf(v[j][3] * inv) & 255u) << 24);
                  const int sl = 2 * j + (lane >> 5);
                  *(unsigned*)(dst + ((size_t)sl * 16384 + e) * 128 + ((4 * lane) & 127)) = pk;
              }
              if (lane == 0) ((float*)(ws + (isv ? WS_VS : WS_US)))[e] = am * (1.0f / 127.0f);
          } }
    }
}

__device__ __forceinline__ unsigned q8x4(float v0, float v1, float v2, float v3, float inv) {
    const float M = 12582912.0f;
    const unsigned t0 = __float_as_uint(fmaf(v0, inv, M)), t1 = __float_as_uint(fmaf(v1, inv, M)), t2 = __float_as_uint(fmaf(v2, inv, M)), t3 = __float_as_uint(fmaf(v3, inv, M));
    return __builtin_amdgcn_perm(t1, t0, 0x0c0c0400u) | __builtin_amdgcn_perm(t3, t2, 0x04000c0cu);
}
#ifndef NORM_PF_FIRST
#define NORM_PF_FIRST 1
#endif
template <bool FIRST>
__device__ __forceinline__ void phase_norm(const Args& a, const float* src, const float* gain, int shift_off, int scale_off, int vblock) {
    const bf16_t* srcb = (const bf16_t*)(a.ws + WS_X1B);
    constexpr int R = FIRST ? 2 : 4;
    const int wave = threadIdx.x >> 6;
    const int gw = vblock * NWAVE + wave, NGW = gridDim.x * NWAVE;
    const float* mod = (const float*)(a.ws + WS_MOD); const float* wsm = (const float*)(a.ws + WS_WSM);
    bf16_t* dst = (bf16_t*)(a.ws + WS_ACT); float* small = (float*)(a.ws + WS_SMALL);
    typedef typename std::conditional<FIRST, f32x4, u32x2>::type raw_t;
    constexpr bool PF = NORM_PF_FIRST || !FIRST;
    const int rpw = (((T_TOK + NGW - 1) / NGW) + 3) & ~3, row_lo = gw * rpw, row_hi = (row_lo + rpw < T_TOK) ? row_lo + rpw : T_TOK;
    raw_t nx[R][4];
    if constexpr (PF) {
        const int lane0 = threadIdx.x & 63, tk = row_lo < T_TOK ? row_lo : 0;
#pragma unroll
        for (int q = 0; q < R; ++q)
#pragma unroll
            for (int j = 0; j < 4; ++j) nx[q][j] = ((const raw_t*)((FIRST ? (const char*)src : (const char*)srcb) + (size_t)(tk + q) * DM * (FIRST ? 4 : 2)) + lane0)[64 * j];
    }
    f32x4 gs[4], sh[4]; int pb = -1;
    for (int tok0 = row_lo; tok0 < row_hi; tok0 += R) {
        int lane = threadIdx.x & 63; asm volatile("" : "+v"(lane));
        if ((tok0 >> 12) != pb) { pb = tok0 >> 12; const float* mrow = mod + (size_t)pb * NMODC;
#pragma unroll
            for (int j = 0; j < 4; ++j) { const int d = 4 * lane + 256 * j;
                const f32x4 g = *(const f32x4*)(gain + d), sc = *(const f32x4*)(mrow + scale_off + d); gs[j] = g * (1.0f + sc); sh[j] = *(const f32x4*)(mrow + shift_off + d); } }
        f32x4 v[R][4]; float rstd[R];
#pragma unroll
        for (int q = 0; q < R; ++q)
#pragma unroll
            for (int j = 0; j < 4; ++j) {
                if constexpr (!PF) nx[q][j] = ((const raw_t*)((FIRST ? (const char*)src : (const char*)srcb) + (size_t)(tok0 + q) * DM * (FIRST ? 4 : 2)) + lane)[64 * j];
                if constexpr (FIRST) v[q][j] = nx[q][j];
                else { const u32x2 w = nx[q][j]; v[q][j] = (f32x4){bf_lo(w.x), bf_hi(w.x), bf_lo(w.y), bf_hi(w.y)}; }
            }
        if constexpr (PF) {
            const int tn = tok0 + R < row_hi ? tok0 + R : tok0;
#pragma unroll
            for (int q = 0; q < R; ++q)
#pragma unroll
                for (int j = 0; j < 4; ++j) nx[q][j] = ((const raw_t*)((FIRST ? (const char*)src : (const char*)srcb) + (size_t)(tn + q) * DM * (FIRST ? 4 : 2)) + lane)[64 * j];
        }
#pragma unroll
        for (int q = 0; q < R; ++q) { float ss = 0.f;
#pragma unroll
            for (int j = 0; j < 4; ++j) ss += (v[q][j][0] * v[q][j][0] + v[q][j][1] * v[q][j][1]) + (v[q][j][2] * v[q][j][2] + v[q][j][3] * v[q][j][3]);
            rstd[q] = ss; }
#pragma unroll
        for (int q = 0; q < R; ++q) rstd[q] = rsqrtf(wave_sum(rstd[q]) * (1.0f / DM) + EPS);
        float sa[R][8];
#pragma unroll
        for (int q = 0; q < R; ++q)
#pragma unroll
            for (int c = 0; c < 8; ++c) sa[q][c] = 0.f;
#pragma unroll
        for (int j = 0; j < 4; ++j) {
            const int d = 4 * lane + 256 * j;
#pragma unroll
            for (int q = 0; q < R; ++q) {
                v[q][j] = v[q][j] * rstd[q] * gs[j] + sh[j];
                if ((FIRST && !INPROJ_I8) || (!FIRST && !QUERY_I8)) { u32x2 o; o.x = pk2(v[q][j][0], v[q][j][1]); o.y = pk2(v[q][j][2], v[q][j][3]); *(u32x2*)(dst + (size_t)(tok0 + q) * DM + d) = o; }
            }
            if (FIRST) {
#pragma unroll
                for (int c = 0; c < 8; ++c) { const f32x4 w = *(const f32x4*)(wsm + c * 1024 + d);
#pragma unroll
                    for (int q = 0; q < R; ++q) sa[q][c] += (v[q][j][0] * w[0] + v[q][j][1] * w[1]) + (v[q][j][2] * w[2] + v[q][j][3] * w[3]); }
            }
            __builtin_amdgcn_sched_barrier(0);
        }
        if (!FIRST || INPROJ_I8) {
#pragma unroll
            for (int q = 0; q < R; ++q) {
                float am = 0.f;
#pragma unroll
                for (int j = 0; j < 4; ++j) am = fmaxf(am, fmaxf(fmaxf(fabsf(v[q][j][0]), fabsf(v[q][j][1])), fmaxf(fabsf(v[q][j][2]), fabsf(v[q][j][3]))));
                am = wave_max(am);
                const float inv = am > 0.f ? 127.0f / am : 0.f;
                unsigned* hq = (unsigned*)(a.ws + (FIRST ? WS_ACT : WS_HQ)) + (size_t)(tok0 + q) * 256;
#pragma unroll
                for (int j = 0; j < 4; ++j) hq[lane + 64 * j] = q8x4(v[q][j][0], v[q][j][1], v[q][j][2], v[q][j][3], inv);
                if (lane == 0) ((float*)(a.ws + (FIRST ? WS_H1S : WS_HS)))[tok0 + q] = am * (1.0f / 127.0f);
            }
        }
        if (FIRST) {
#pragma unroll
            for (int q = 0; q < R; ++q) {
                float ov = 0.f;
#pragma unroll
                for (int c = 0; c < 8; ++c) { const float s = wave_sum(sa[q][c]); if (lane == c) ov = s; }
                if (lane < 8) small[(size_t)(tok0 + q) * 8 + lane] = ov;
            }
        }
    }
}

typedef float f32x16 __attribute__((ext_vector_type(16)));
__device__ __forceinline__ unsigned cvt2(float lo, float hi) {
    typedef __bf16 bf2_t __attribute__((ext_vector_type(2)));
    bf2_t v; v[0] = (__bf16)lo; v[1] = (__bf16)hi; return __builtin_bit_cast(unsigned, v);
}
__device__ __forceinline__ int crow(int reg, int h) { return (reg & 3) + 8 * (reg >> 2) + 4 * h; }
constexpr int R_W = 0, R_QD = 16384, R_KDT = 32768, R_ATT = 49152, R_U = 57344;

template <int I> __device__ __forceinline__ void tsolve_load(f32x4 (&l)[8], const LAS float* Lb) {
#pragma unroll
    for (int j4 = 0; j4 < (I + 3) / 4; ++j4) l[j4] = *(const LAS f32x4*)(Lb + I * 68 + 4 * j4);
}
template <int I> __device__ __forceinline__ void tsolve_row(float (&x)[32], const LAS float* Lb, int c, f32x4 (&cur)[8], f32x4 (&nxt)[8]) {
    if constexpr (I + 1 < 32) { tsolve_load<I + 1>(nxt, Lb); __builtin_amdgcn_sched_barrier(0); }
    float a0 = 0.f, a1 = 0.f, a2 = 0.f, a3 = 0.f;
#pragma unroll
    for (int j4 = 0; j4 < (I + 3) / 4; ++j4) {
        const f32x4 l = cur[j4];
        if (4 * j4 + 0 < I) a0 += l[0] * x[4 * j4 + 0];
        if (4 * j4 + 1 < I) a1 += l[1] * x[4 * j4 + 1];
        if (4 * j4 + 2 < I) a2 += l[2] * x[4 * j4 + 2];
        if (4 * j4 + 3 < I) a3 += l[3] * x[4 * j4 + 3];
    }
    x[I] = (I == c ? 1.0f : 0.0f) - ((a0 + a1) + (a2 + a3));
}
template <int... Is> __device__ __forceinline__ void tsolve_all(float (&x)[32], const LAS float* Lb, int c, std::integer_sequence<int, Is...>) {
    f32x4 la[8], lb[8];
    tsolve_load<0>(la, Lb);
    ((Is % 2 == 0 ? tsolve_row<Is>(x, Lb, c, la, lb) : tsolve_row<Is>(x, Lb, c, lb, la)), ...);
}
__device__ __forceinline__ bf16x8 lda_split(const LAS unsigned char* p) {
    const u32x2 lo = *(const LAS u32x2*)p, hi = *(const LAS u32x2*)(p + 16);
    u32x4 v; v.x = lo.x; v.y = lo.y; v.z = hi.x; v.w = hi.y; return __builtin_bit_cast(bf16x8, v);
}
__device__ __forceinline__ bf16x8 pack8(const f32x16& x, int s) {
    u32x4 v; v.x = cvt2(x[8 * s], x[8 * s + 1]); v.y = cvt2(x[8 * s + 2], x[8 * s + 3]); v.z = cvt2(x[8 * s + 4], x[8 * s + 5]); v.w = cvt2(x[8 * s + 6], x[8 * s + 7]);
    return __builtin_bit_cast(bf16x8, v);
}

#ifndef DNP_DUP
#define DNP_DUP 0
#endif
#define DNP_REP(k) _Pragma("nounroll") for (int drep_ = 0; drep_ < 1 + ((DNP_DUP >> (k)) & 1); ++drep_)
constexpr int DNL_KBT = 98304, DNL_VBT = 116736, DNL_T = 135168, DNL_T11T = 144384;
__device__ __forceinline__ void dn_prep(const Args& a, LAS unsigned char* lds) {
    const bf16_t* proj = (const bf16_t*)(a.ws + WS_PROJ); const float* small = (const float*)(a.ws + WS_SMALL);
    const float* convw = a.in[6];
    LAS float* qs = (LAS float*)lds;
    LAS float* ks = (LAS float*)(lds + 32768);
    LAS float* vs = (LAS float*)(lds + 65536);
    LAS unsigned char* q16 = lds + 98304;
    LAS unsigned char* k16 = lds + 115712;
    LAS unsigned char* kb16 = lds + 133120;
    LAS float* sbeta = (LAS float*)(lds + 150528);
    LAS float* sG = sbeta + 64;
    LAS float* seG = sG + 64;
    LAS float* sbg = seG + 64;
    LAS float* Lm = (LAS float*)lds;
    float* gls = (float*)(a.ws + WS_GLS);
    u32x2 rawn[19];
    float bln = 0.f, dln = 0.f;
    f32x4 w[4]; int whd = -1;
    {
        const int tid0 = threadIdx.x, ci0 = blockIdx.x;
        if (tid0 < 384 && ci0 < 2048) {
            const int cgp = tid0 % 96, seg = tid0 / 96, which = cgp >> 5, c4 = (cgp & 31) * 4, col = which * 512 + ((ci0 >> 6) & 3) * 128 + c4;
#pragma unroll
            for (int r = 0; r < 19; ++r) { const int sp = (ci0 & 63) * 64 + 16 * seg - 3 + r;
                rawn[r] = *(const u32x2*)(proj + ((size_t)(ci0 >> 8) * SEQ + (sp < 0 ? 0 : sp)) * NPROJ + col); }
        }
        if (tid0 >= 448 && ci0 < 2048) { const size_t tk = (size_t)(ci0 >> 8) * SEQ + (ci0 & 63) * 64 + (tid0 - 448); bln = small[tk * 8 + ((ci0 >> 6) & 3)]; dln = small[tk * 8 + 4 + ((ci0 >> 6) & 3)]; }
#pragma unroll
        for (int j = 0; j < 4; ++j) w[j] = (f32x4){0.f, 0.f, 0.f, 0.f};
    }
    for (int ci = blockIdx.x; ci < 2048; ci += gridDim.x) {
        int tid = threadIdx.x; asm volatile("" : "+v"(tid));
        const int lane = tid & 63, wave = tid >> 6;
        const int b = ci >> 8, hd = (ci >> 6) & 3, n = ci & 63, s0 = n * 64; const size_t tok0 = (size_t)b * SEQ + s0;
        unsigned char* rec = a.ws + WS_DN + (size_t)ci * DN_REC;
        if (hd != whd) { whd = hd;
            if (tid < 384) { const int cgp = tid % 96, which = cgp >> 5, c4 = (cgp & 31) * 4, col = which * 512 + hd * 128 + c4;
#pragma unroll
                for (int j = 0; j < 4; ++j) w[j] = *(const f32x4*)(convw + j * 1536 + col); } }
        const float bl = bln, dl = dln;
        DNP_REP(0) if (tid < 384) {
            const int cgp = tid % 96, seg = tid / 96, which = cgp >> 5, c4 = (cgp & 31) * 4;
            u32x2 raw[19];
#pragma unroll
            for (int r = 0; r < 19; ++r) {
                const int sp = s0 + 16 * seg - 3 + r;
                raw[r] = (sp >= 0) ? rawn[r] : (u32x2){0u, 0u};
            }
            LAS float* dstp = (which == 0 ? qs : (which == 1 ? ks : vs)) + (16 * seg) * 128 + c4;
#pragma unroll
            for (int i = 0; i < 16; ++i) {
                f32x4 y = (f32x4){0.f, 0.f, 0.f, 0.f};
#pragma unroll
                for (int j = 0; j < 4; ++j) { const u32x2 u = raw[i + j];
                    y[0] += w[j][0] * bf_lo(u.x); y[1] += w[j][1] * bf_hi(u.x); y[2] += w[j][2] * bf_lo(u.y); y[3] += w[j][3] * bf_hi(u.y); }
                f32x4 r; r[0] = siluf(y[0]); r[1] = siluf(y[1]); r[2] = siluf(y[2]); r[3] = siluf(y[3]);
                *(LAS f32x4*)(dstp + i * 128) = r;
            }
        }
        if (wave == 7) {
            const float Aexp = __expf(a.in[7][hd]), dtb = a.in[8][hd];
            const float dlb = dl + dtb;
            const float sp = fmaxf(dlb, 0.f) + log1pf(expf(-fabsf(dlb)));
            float Gc = -Aexp * sp;
#pragma unroll
            for (int o = 1; o < 64; o <<= 1) { const float t = __shfl_up(Gc, o); if (lane >= o) Gc += t; }
            const float bt = 1.0f / (1.0f + expf(-bl)), eg = expf(Gc);
            sbeta[lane] = bt; sG[lane] = Gc; seG[lane] = eg; sbg[lane] = bt * eg;
        }
        __syncthreads();
        {
            const int cn = ci + (int)gridDim.x;
            if (tid < 384 && cn < 2048) {
                const int cgp = tid % 96, seg = tid / 96, which = cgp >> 5, c4 = (cgp & 31) * 4, col = which * 512 + ((cn >> 6) & 3) * 128 + c4;
#pragma unroll
                for (int r = 0; r < 19; ++r) { const int sp = (cn & 63) * 64 + 16 * seg - 3 + r;
                    rawn[r] = *(const u32x2*)(proj + ((size_t)(cn >> 8) * SEQ + (sp < 0 ? 0 : sp)) * NPROJ + col); }
            }
            if (tid >= 448 && cn < 2048) { const size_t tk = (size_t)(cn >> 8) * SEQ + (cn & 63) * 64 + (tid - 448); bln = small[tk * 8 + ((cn >> 6) & 3)]; dln = small[tk * 8 + 4 + ((cn >> 6) & 3)]; }
        }
        {
            const bool isk = wave >= 4;
            LAS float* pb = (isk ? ks : qs) + ((wave & 3) * 16) * 128 + 2 * lane;
#pragma unroll
            for (int r4 = 0; r4 < 4; ++r4) {
                f32x2 v[4]; float ss[4];
#pragma unroll
                for (int q = 0; q < 4; ++q) { v[q] = *(LAS f32x2*)(pb + (r4 * 4 + q) * 128); ss[q] = v[q][0] * v[q][0] + v[q][1] * v[q][1]; }
#pragma unroll
                for (int q = 0; q < 4; ++q) ss[q] = wave_sum(ss[q]);
#pragma unroll
                for (int q = 0; q < 4; ++q) { const float sc = rsqrtf(ss[q] + EPS) * (isk ? 1.0f : 0.08838834764831845f);
                    v[q][0] *= sc; v[q][1] *= sc; *(LAS f32x2*)(pb + (r4 * 4 + q) * 128) = v[q]; }
            }
        }
        __syncthreads();
        DNP_REP(1) for (int idx = tid; idx < 1024; idx += NTHR) {
            const int i = idx >> 4, d0 = (idx & 15) * 8; const float bt = sbeta[i], eg = seG[i];
            const f32x4 q0 = *(const LAS f32x4*)(qs + i * 128 + d0), q1 = *(const LAS f32x4*)(qs + i * 128 + d0 + 4);
            const f32x4 k0 = *(const LAS f32x4*)(ks + i * 128 + d0), k1 = *(const LAS f32x4*)(ks + i * 128 + d0 + 4);
            u32x4 o;
            o.x = cvt2(q0[0], q0[1]); o.y = cvt2(q0[2], q0[3]); o.z = cvt2(q1[0], q1[1]); o.w = cvt2(q1[2], q1[3]); *(LAS u32x4*)(q16 + i * 272 + d0 * 2) = o;
            o.x = cvt2(k0[0], k0[1]); o.y = cvt2(k0[2], k0[3]); o.z = cvt2(k1[0], k1[1]); o.w = cvt2(k1[2], k1[3]); *(LAS u32x4*)(k16 + i * 272 + d0 * 2) = o;
            o.x = cvt2(k0[0] * bt, k0[1] * bt); o.y = cvt2(k0[2] * bt, k0[3] * bt); o.z = cvt2(k1[0] * bt, k1[1] * bt); o.w = cvt2(k1[2] * bt, k1[3] * bt); *(LAS u32x4*)(kb16 + i * 272 + d0 * 2) = o;
            o.x = cvt2(q0[0] * eg, q0[1] * eg); o.y = cvt2(q0[2] * eg, q0[3] * eg); o.z = cvt2(q1[0] * eg, q1[1] * eg); o.w = cvt2(q1[2] * eg, q1[3] * eg);
            *(u32x4*)(rec + R_QD + (i * 128 + d0) * 2) = o;
        }
        DNP_REP(1) for (int idx = tid; idx < 1024; idx += NTHR) {
            const int d = idx & 127, i0 = (idx >> 7) * 8; const float G63 = sG[63];
            float v[8];
#pragma unroll
            for (int jj = 0; jj < 8; ++jj) v[jj] = ks[(i0 + jj) * 128 + d] * __expf(G63 - sG[i0 + jj]);
            u32x4 o; o.x = cvt2(v[0], v[1]); o.y = cvt2(v[2], v[3]); o.z = cvt2(v[4], v[5]); o.w = cvt2(v[6], v[7]);
            *(u32x4*)(rec + R_KDT + (d * 64 + i0) * 2) = o;
        }
        if (tid == 0) gls[ci] = seG[63];
        __syncthreads();
        DNP_REP(2) {
            const int which = wave >> 2, mt = (wave >> 1) & 1, nt = wave & 1, r32 = lane & 31, h = lane >> 5;
            const LAS unsigned char* Ab = (which ? q16 : kb16) + (32 * mt + r32) * 272 + h * 16;
            const LAS unsigned char* Bb = k16 + (32 * nt + r32) * 272 + h * 16;
            f32x16 acc;
#pragma unroll
            for (int r = 0; r < 16; ++r) acc[r] = 0.f;
#pragma unroll
            for (int kk = 0; kk < 8; ++kk) {
                const bf16x8 av = *(const LAS bf16x8*)(Ab + kk * 32), bv = *(const LAS bf16x8*)(Bb + kk * 32);
                acc = __builtin_amdgcn_mfma_f32_32x32x16_bf16(av, bv, acc, 0, 0, 0);
            }
            const int j = 32 * nt + r32; const float Gj = sG[j];
#pragma unroll
            for (int r = 0; r < 16; ++r) {
                const int i = 32 * mt + crow(r, h);
                const float val = acc[r] * __expf(sG[i] - Gj);
                if (which == 0) Lm[i * 68 + j] = (i > j) ? val : 0.f;
                else *(bf16_t*)(rec + R_ATT + (i * 64 + j) * 2) = (bf16_t)((i >= j) ? f2bf(val) : 0u);
            }
        }
        __syncthreads();
        const int n32 = lane & 31, h32 = lane >> 5;
        DNP_REP(3) {
        if (wave == 0) {
            int ln = lane; asm volatile("" : "+v"(ln));
            const int r = ln >> 5, c = ln & 31;
            float x[32];
            tsolve_all(x, Lm + (32 * r) * 68 + 32 * r, c, std::make_integer_sequence<int, 32>{});
            if (r == 0) {
#pragma unroll
                for (int q = 0; q < 4; ++q) { u32x4 o; o.x = cvt2(x[8 * q], x[8 * q + 1]); o.y = cvt2(x[8 * q + 2], x[8 * q + 3]); o.z = cvt2(x[8 * q + 4], x[8 * q + 5]); o.w = cvt2(x[8 * q + 6], x[8 * q + 7]);
                    *(LAS u32x4*)(lds + DNL_T11T + c * 80 + q * 16) = o; }
            }
            LAS bf16_t* Tp = (LAS bf16_t*)(lds + DNL_T) + (32 * r) * 72 + 32 * r + c;
#pragma unroll
            for (int i = 0; i < 32; ++i) Tp[i * 72] = (bf16_t)f2bf(x[i]);
            asm volatile("s_waitcnt lgkmcnt(0)" ::: "memory"); __builtin_amdgcn_wave_barrier();
            const int m = ln & 31, h = ln >> 5;
            f32x16 ax, a2;
#pragma unroll
            for (int q = 0; q < 16; ++q) { ax[q] = 0.f; a2[q] = 0.f; }
#pragma unroll
            for (int s = 0; s < 2; ++s) {
                const f32x4 l0 = *(const LAS f32x4*)(Lm + (32 + m) * 68 + 16 * s + 8 * h), l1 = *(const LAS f32x4*)(Lm + (32 + m) * 68 + 16 * s + 8 * h + 4);
                u32x4 av; av.x = cvt2(l0[0], l0[1]); av.y = cvt2(l0[2], l0[3]); av.z = cvt2(l1[0], l1[1]); av.w = cvt2(l1[2], l1[3]);
                const bf16x8 bv = *(const LAS bf16x8*)(lds + DNL_T11T + m * 80 + (16 * s + 8 * h) * 2);
                ax = __builtin_amdgcn_mfma_f32_32x32x16_bf16(__builtin_bit_cast(bf16x8, av), bv, ax, 0, 0, 0);
            }
#pragma unroll
            for (int s = 0; s < 2; ++s)
                a2 = __builtin_amdgcn_mfma_f32_32x32x16_bf16(lda_split(lds + DNL_T + (32 + m) * 144 + (32 + 16 * s + 4 * h) * 2), pack8(ax, s), a2, 0, 0, 0);
            LAS bf16_t* T21 = (LAS bf16_t*)(lds + DNL_T) + 32 * 72 + m;
#pragma unroll
            for (int q = 0; q < 16; ++q) T21[crow(q, h) * 72] = (bf16_t)f2bf(-a2[q]);
        } else {
            for (int idx = tid - 64; idx < 2048; idx += NTHR - 64) {
                const int c = idx & 127, jr = (idx >> 7) & 7, wh = idx >> 10;
                const LAS float* sp_ = (wh ? vs : ks) + c; const LAS float* sc = (wh ? sbeta : sbg) + 8 * jr;
                float v[8];
#pragma unroll
                for (int jj = 0; jj < 8; ++jj) v[jj] = sp_[(8 * jr + jj) * 128] * sc[jj];
                u32x4 o; o.x = cvt2(v[0], v[1]); o.y = cvt2(v[2], v[3]); o.z = cvt2(v[4], v[5]); o.w = cvt2(v[6], v[7]);
                *(LAS u32x4*)(lds + (wh ? DNL_VBT : DNL_KBT) + c * 144 + jr * 16) = o;
            }
        }
        }
        __syncthreads();
        {
            const bool isw = wave < 4;
            const LAS unsigned char* Bt = lds + (isw ? DNL_KBT : DNL_VBT) + (32 * (wave & 3) + n32) * 144 + h32 * 16;
            const LAS unsigned char* Ta = lds + DNL_T + n32 * 144 + h32 * 16;
            bf16x8 bv[4], t0[2], t1[4];
#pragma unroll
            for (int s = 0; s < 4; ++s) { bv[s] = *(const LAS bf16x8*)(Bt + s * 32); t1[s] = *(const LAS bf16x8*)(Ta + 32 * 144 + s * 32); }
#pragma unroll
            for (int s = 0; s < 2; ++s) t0[s] = *(const LAS bf16x8*)(Ta + s * 32);
            f32x16 c0, c1;
#pragma unroll
            for (int q = 0; q < 16; ++q) { c0[q] = 0.f; c1[q] = 0.f; }
            if (isw) {
#pragma unroll
                for (int s = 0; s < 2; ++s) c0 = __builtin_amdgcn_mfma_f32_32x32x16_bf16(bv[s], t0[s], c0, 0, 0, 0);
#pragma unroll
                for (int s = 0; s < 4; ++s) c1 = __builtin_amdgcn_mfma_f32_32x32x16_bf16(bv[s], t1[s], c1, 0, 0, 0);
                unsigned char* dst = rec + R_W + (size_t)(wave * 4096 + lane * 16);
                *(u32x4*)dst = __builtin_bit_cast(u32x4, pack8(c0, 0)); *(u32x4*)(dst + 1024) = __builtin_bit_cast(u32x4, pack8(c0, 1));
                *(u32x4*)(dst + 2048) = __builtin_bit_cast(u32x4, pack8(c1, 0)); *(u32x4*)(dst + 3072) = __builtin_bit_cast(u32x4, pack8(c1, 1));
            } else {
#pragma unroll
                for (int s = 0; s < 2; ++s) c0 = __builtin_amdgcn_mfma_f32_32x32x16_bf16(t0[s], bv[s], c0, 0, 0, 0);
#pragma unroll
                for (int s = 0; s < 4; ++s) c1 = __builtin_amdgcn_mfma_f32_32x32x16_bf16(t1[s], bv[s], c1, 0, 0, 0);
                unsigned char* dst = rec + R_U + (size_t)(((wave - 4) * 64 + lane) * 64);
                *(u32x4*)dst = __builtin_bit_cast(u32x4, pack8(c0, 0)); *(u32x4*)(dst + 16) = __builtin_bit_cast(u32x4, pack8(c0, 1));
                *(u32x4*)(dst + 32) = __builtin_bit_cast(u32x4, pack8(c1, 0)); *(u32x4*)(dst + 48) = __builtin_bit_cast(u32x4, pack8(c1, 1));
            }
        }
    }
    __syncthreads();
}

constexpr int DNB_W = 0, DNB_QD = 16896, DNB_KDT = 33792, DNB_ATT = 51200, DNB_U = 59904  , DNB_GL = 80384, DNB_SZ = 80400;
__device__ __forceinline__ void dn_issue_chunk(const unsigned char* rec, const float* glp, u32x4 (&v)[18], float& gl, int tl) {
    asm volatile("" : "+v"(tl));
#pragma unroll
    for (int i = 0; i < 18; ++i) v[i] = *(const u32x4*)(rec + (size_t)(tl + 256 * i) * 16);
    gl = *glp;
}
__device__ __forceinline__ void dn_write_chunk(const u32x4 (&v)[18], float gl, LAS unsigned char* buf, int tl) {
    asm volatile("" : "+v"(tl));
#pragma unroll
    for (int i = 0; i < 18; ++i) {
        const int q = tl + 256 * i;
        LAS unsigned char* d;
        if (i < 4) d = buf + DNB_W + q * 16;
        else if (i < 8) d = buf + DNB_QD + ((q - 1024) >> 4) * 264 + (q & 15) * 16;
        else if (i < 12) d = buf + DNB_KDT + ((q - 2048) >> 3) * 136 + (q & 7) * 16;
        else if (i < 14) d = buf + DNB_ATT + ((q - 3072) >> 3) * 136 + (q & 7) * 16;
        else d = buf + DNB_U + ((q - 3584) >> 2) * 80 + (q & 3) * 16;
        u32x2 lo, hi; lo.x = v[i].x; lo.y = v[i].y; hi.x = v[i].z; hi.y = v[i].w;
        *(LAS u32x2*)d = lo; *(LAS u32x2*)(d + 8) = hi;
    }
    if (tl == 0) *(LAS float*)(buf + DNB_GL) = gl;
}
__device__ __forceinline__ void dn_gate_norm(const Args& a) {
    const int lane = threadIdx.x & 63, wave = threadIdx.x >> 6;
    const int gw = blockIdx.x * NWAVE + wave, NGW = gridDim.x * NWAVE;
    const bf16_t* oraw = (const bf16_t*)a.out; const bf16_t* proj = (const bf16_t*)(a.ws + WS_PROJ); const bf16_t* mixed = (const bf16_t*)(a.ws + WS_ACT); const float* ogain = a.in[9];
    unsigned char* mq = a.ws + WS_MQ; float* ms = (float*)(a.ws + WS_MS);
    const f32x4 g0 = *(const f32x4*)(ogain + (lane & 15) * 8), g1 = *(const f32x4*)(ogain + (lane & 15) * 8 + 4);
    u32x4 on[2], zn[2], sn[2];
#pragma unroll
    for (int q = 0; q < 2; ++q) { const size_t tok = (size_t)((gw * 2 < T_TOK ? gw * 2 : 0) + q);
        on[q] = *(const u32x4*)(oraw + tok * 512 + lane * 8); zn[q] = *(const u32x4*)(proj + tok * NPROJ + 1536 + lane * 8); sn[q] = *(const u32x4*)(mixed + tok * DM + 512 + lane * 8); }
    for (int tok0 = gw * 2; tok0 < T_TOK; tok0 += NGW * 2) {
        u32x4 ov[2], zv[2], sv[2];
#pragma unroll
        for (int q = 0; q < 2; ++q) { ov[q] = on[q]; zv[q] = zn[q]; sv[q] = sn[q]; }
        {
            const int tn = tok0 + NGW * 2 < T_TOK ? tok0 + NGW * 2 : tok0;
#pragma unroll
            for (int q = 0; q < 2; ++q) { const size_t tok = (size_t)(tn + q);
                on[q] = *(const u32x4*)(oraw + tok * 512 + lane * 8); zn[q] = *(const u32x4*)(proj + tok * NPROJ + 1536 + lane * 8); sn[q] = *(const u32x4*)(mixed + tok * DM + 512 + lane * 8); }
        }
#pragma unroll
        for (int q = 0; q < 2; ++q) {
            float o[8], z[8], s[8];
#pragma unroll
            for (int c = 0; c < 4; ++c) { o[2 * c] = bf_lo(ov[q][c]); o[2 * c + 1] = bf_hi(ov[q][c]); z[2 * c] = bf_lo(zv[q][c]); z[2 * c + 1] = bf_hi(zv[q][c]); s[2 * c] = bf_lo(sv[q][c]); s[2 * c + 1] = bf_hi(sv[q][c]); }
            float ss = 0.f;
#pragma unroll
            for (int c = 0; c < 8; ++c) ss += o[c] * o[c];
            ss += dpp_<0xB1>(ss); ss += dpp_<0x4E>(ss); ss += dpp_<0x141>(ss); ss += dpp_<0x140>(ss);
            const float r = rsqrtf(ss * (1.0f / 128.0f) + EPS);
            float am = 0.f;
#pragma unroll
            for (int c = 0; c < 8; ++c) { o[c] = o[c] * r * (c < 4 ? g0[c] : g1[c - 4]) * siluf(z[c]); am = fmaxf(am, fmaxf(fabsf(o[c]), fabsf(s[c]))); }
            am = wave_max(am);
            const float inv = am > 0.f ? 127.0f / am : 0.f;
            u32x2 od, os;
            od.x = q8x4(o[0], o[1], o[2], o[3], inv); od.y = q8x4(o[4], o[5], o[6], o[7], inv);
            os.x = q8x4(s[0], s[1], s[2], s[3], inv); os.y = q8x4(s[4], s[5], s[6], s[7], inv);
            const size_t tok = (size_t)(tok0 + q);
            *(u32x2*)(mq + tok * 1024 + lane * 8) = od; *(u32x2*)(mq + tok * 1024 + 512 + lane * 8) = os;
            if (lane == 0) ms[tok] = am * (1.0f / 127.0f);
        }
    }
}
__device__ __forceinline__ void dn_scan2(const Args& a, LAS unsigned char* lds) {
    const int tid = threadIdx.x, lane = tid & 63, wave = __builtin_amdgcn_readfirstlane(tid >> 6);
    const int bh = blockIdx.x >> 1, dvh = blockIdx.x & 1, b = bh >> 2, hd = bh & 3;
    const unsigned char* recs = a.ws + WS_DN + (size_t)bh * 64 * DN_REC;
    const float* gls = (const float*)(a.ws + WS_GLS) + bh * 64;
    bf16_t* oraw = (bf16_t*)a.out;
    if (wave >= 4) {
        u32x4 pv[18]; float pgl;
        dn_issue_chunk(recs, gls, pv, pgl, tid - 256); dn_write_chunk(pv, pgl, lds, tid - 256); dn_issue_chunk(recs + DN_REC, gls + 1, pv, pgl, tid - 256);
        __syncthreads();
        for (int n = 0; n < 64; ++n) {
            if (n + 1 < 64) dn_write_chunk(pv, pgl, lds + ((n + 1) & 1) * DNB_SZ, tid - 256);
            if (n + 2 < 64) dn_issue_chunk(recs + (size_t)(n + 2) * DN_REC, gls + n + 2, pv, pgl, tid - 256);
            __syncthreads();
        }
        return;
    }
    if (wave >= 2) {
        __syncthreads();
        for (int n = 0; n < 64; ++n) __syncthreads();
        return;
    }
    const int cw = dvh * 2 + wave;
    f32x16 S[4]; bf16x8 BS[8];
#pragma unroll
    for (int kt = 0; kt < 4; ++kt)
#pragma unroll
        for (int r = 0; r < 16; ++r) S[kt][r] = 0.f;
#pragma unroll
    for (int ks = 0; ks < 8; ++ks) BS[ks] = (bf16x8){0, 0, 0, 0, 0, 0, 0, 0};
    __syncthreads();
    for (int n = 0; n < 64; ++n) {
        {
            int lane_o = lane; asm volatile("" : "+v"(lane_o));
            const int r32 = lane_o & 31, h = lane_o >> 5;
            const LAS unsigned char* B0 = lds + (n & 1) * DNB_SZ;
            const float gl = *(const LAS float*)(B0 + DNB_GL);
            const int koff = 8 * h;
            bf16x8 BV[4];
            {
                bf16x8 fa[16];
#pragma unroll
                for (int ks = 0; ks < 8; ++ks) { fa[2 * ks] = *(const LAS bf16x8*)(B0 + DNB_W + ((ks >> 1) * 4 + (ks & 1)) * 1024 + lane_o * 16); fa[2 * ks + 1] = *(const LAS bf16x8*)(B0 + DNB_W + ((ks >> 1) * 4 + 2 + (ks & 1)) * 1024 + lane_o * 16); }
                const LAS unsigned char* up = B0 + DNB_U + (cw * 64 + lane_o) * 80;
                u32x4 uq[4];
#pragma unroll
                for (int c = 0; c < 4; ++c) uq[c] = *(const LAS u32x4*)(up + c * 16);
                __builtin_amdgcn_sched_barrier(0);
                f32x16 X0, X1;
#pragma unroll
                for (int r = 0; r < 16; ++r) { X0[r] = 0.f; X1[r] = 0.f; }
#pragma unroll
                for (int ks = 0; ks < 8; ++ks) {
                    X0 = __builtin_amdgcn_mfma_f32_32x32x16_bf16(fa[2 * ks], BS[ks], X0, 0, 0, 0);
                    X1 = __builtin_amdgcn_mfma_f32_32x32x16_bf16(fa[2 * ks + 1], BS[ks], X1, 0, 0, 0);
                }
#pragma unroll
                for (int r = 0; r < 16; ++r) { const unsigned w0 = uq[r >> 3][(r >> 1) & 3], w1 = uq[2 + (r >> 3)][(r >> 1) & 3];
                    X0[r] = ((r & 1) ? bf_hi(w0) : bf_lo(w0)) - X0[r]; X1[r] = ((r & 1) ? bf_hi(w1) : bf_lo(w1)) - X1[r]; }
                BV[0] = pack8(X0, 0); BV[1] = pack8(X0, 1); BV[2] = pack8(X1, 0); BV[3] = pack8(X1, 1);
            }
            __builtin_amdgcn_sched_barrier(0);
            {
                bf16x8 fq[16], ft[8];
#pragma unroll
                for (int ks = 0; ks < 8; ++ks) { fq[2 * ks] = lda_split(B0 + DNB_QD + r32 * 264 + ks * 32 + koff); fq[2 * ks + 1] = lda_split(B0 + DNB_QD + (32 + r32) * 264 + ks * 32 + koff); }
                __builtin_amdgcn_sched_barrier(0);
                f32x16 O0, O1;
#pragma unroll
                for (int r = 0; r < 16; ++r) { O0[r] = 0.f; O1[r] = 0.f; }
#pragma unroll
                for (int ks = 0; ks < 4; ++ks) {
                    O0 = __builtin_amdgcn_mfma_f32_32x32x16_bf16(fq[2 * ks], BS[ks], O0, 0, 0, 0);
                    O1 = __builtin_amdgcn_mfma_f32_32x32x16_bf16(fq[2 * ks + 1], BS[ks], O1, 0, 0, 0);
                }
                __builtin_amdgcn_sched_barrier(0);
#pragma unroll
                for (int cs = 0; cs < 4; ++cs) { ft[2 * cs] = lda_split(B0 + DNB_ATT + r32 * 136 + cs * 32 + koff); ft[2 * cs + 1] = lda_split(B0 + DNB_ATT + (32 + r32) * 136 + cs * 32 + koff); }
                __builtin_amdgcn_sched_barrier(0);
#pragma unroll
                for (int ks = 4; ks < 8; ++ks) {
                    O0 = __builtin_amdgcn_mfma_f32_32x32x16_bf16(fq[2 * ks], BS[ks], O0, 0, 0, 0);
                    O1 = __builtin_amdgcn_mfma_f32_32x32x16_bf16(fq[2 * ks + 1], BS[ks], O1, 0, 0, 0);
                }
#pragma unroll
                for (int cs = 0; cs < 4; ++cs) {
                    O0 = __builtin_amdgcn_mfma_f32_32x32x16_bf16(ft[2 * cs], BV[cs], O0, 0, 0, 0);
                    O1 = __builtin_amdgcn_mfma_f32_32x32x16_bf16(ft[2 * cs + 1], BV[cs], O1, 0, 0, 0);
                }
                bf16_t* obu = oraw + ((size_t)b * SEQ + n * 64) * 512 + hd * 128 + 32 * cw;
                const unsigned lo = (unsigned)((4 * h) * 512 + r32);
#pragma unroll
                for (int r = 0; r < 16; ++r) { obu[lo + (unsigned)(((r & 3) + 8 * (r >> 2)) * 512)] = (bf16_t)f2bf(O0[r]); obu[lo + (unsigned)((32 + (r & 3) + 8 * (r >> 2)) * 512)] = (bf16_t)f2bf(O1[r]); }
            }
            __builtin_amdgcn_sched_barrier(0);
            {
                bf16x8 fk[16];
#pragma unroll
                for (int kt = 0; kt < 4; ++kt)
#pragma unroll
                    for (int cs = 0; cs < 4; ++cs) fk[kt * 4 + cs] = lda_split(B0 + DNB_KDT + (32 * kt + r32) * 136 + cs * 32 + koff);
#pragma unroll
                for (int kt = 0; kt < 4; ++kt)
#pragma unroll
                    for (int r = 0; r < 16; ++r) S[kt][r] *= gl;
                __builtin_amdgcn_sched_barrier(0);
#pragma unroll
                for (int cs = 0; cs < 4; ++cs)
#pragma unroll
                    for (int kt = 0; kt < 4; ++kt) S[kt] = __builtin_amdgcn_mfma_f32_32x32x16_bf16(fk[kt * 4 + cs], BV[cs], S[kt], 0, 0, 0);
            }
#pragma unroll
            for (int kt = 0; kt < 4; ++kt) { BS[2 * kt] = pack8(S[kt], 0); BS[2 * kt + 1] = pack8(S[kt], 1); }
        }
        __syncthreads();
    }
}

__device__ __forceinline__ void sb_prep(const Args& a) {
    const int lane = threadIdx.x & 63, wave = threadIdx.x >> 6;
    const int gw = blockIdx.x * NWAVE + wave, NGW = gridDim.x * NWAVE;
    bf16_t* proj = (bf16_t*)(a.ws + WS_PROJ);
    const float* gq = a.in[10]; const float* gk = a.in[11];
    {
        const int sub = lane & 7;
        float gsc[8];
#pragma unroll
        for (int j = 0; j < 8; ++j) gsc[j] = gq[sub * 8 + j] * gk[sub * 8 + j] * 0.125f;
        for (int r0 = gw * 8; r0 < T_TOK * 16; r0 += NGW * 8) {
            const int row = r0 + (lane >> 3); const int isk = row & 1, hd = (row >> 1) & 7; const size_t tok = (size_t)(row >> 4);
            u32x4* p = (u32x4*)(proj + tok * NPROJ + 2048 + isk * 512 + hd * 64 + sub * 8);
            const u32x4 w = *p;
            float ss = dot2(w.x, w.x, 0.f); ss = dot2(w.y, w.y, ss); ss = dot2(w.z, w.z, ss); ss = dot2(w.w, w.w, ss);
            ss += dppf<0xB1>(ss); ss += dppf<0x4E>(ss); ss += dppf<0x141>(ss);
            const float rs = rsqrtf(ss * (1.0f / 64.0f) + EPS);
            u32x4 o;
            if (isk) { o.x = pk2(bf_lo(w.x) * rs, bf_hi(w.x) * rs); o.y = pk2(bf_lo(w.y) * rs, bf_hi(w.y) * rs); o.z = pk2(bf_lo(w.z) * rs, bf_hi(w.z) * rs); o.w = pk2(bf_lo(w.w) * rs, bf_hi(w.w) * rs); }
            else { o.x = pk2(bf_lo(w.x) * rs * gsc[0], bf_hi(w.x) * rs * gsc[1]); o.y = pk2(bf_lo(w.y) * rs * gsc[2], bf_hi(w.y) * rs * gsc[3]);
                   o.z = pk2(bf_lo(w.z) * rs * gsc[4], bf_hi(w.z) * rs * gsc[5]); o.w = pk2(bf_lo(w.w) * rs * gsc[6], bf_hi(w.w) * rs * gsc[7]); }
            *p = o;
        }
    }
    {
        bf16_t* VT = (bf16_t*)((unsigned char*)a.out + VT_OFF);
        for (int item = gw; item < 64 * 64; item += NGW) {
            const int bh = item >> 6, kt = item & 63, b = bh >> 3, h = bh & 7;
            const u32x4* src = (const u32x4*)(proj + ((size_t)b * SEQ + kt * 64 + lane) * NPROJ + 3072 + h * 64);
            u32x4 v[8];
#pragma unroll
            for (int j = 0; j < 8; ++j) v[j] = src[j];
            bf16_t* dst = VT + ((size_t)bh * 64) * SEQ + kt * 64 + lane;
#pragma unroll
            for (int j = 0; j < 8; ++j)
#pragma unroll
                for (int c = 0; c < 4; ++c) { dst[(size_t)(j * 8 + 2 * c) * SEQ] = (bf16_t)(v[j][c] & 0xffffu); dst[(size_t)(j * 8 + 2 * c + 1) * SEQ] = (bf16_t)(v[j][c] >> 16); }
        }
    }
}

__device__ __forceinline__ void sb_attn(const Args& a, int wave_id, int n_waves) {
    const int lane = threadIdx.x & 63, r32 = lane & 31, hh = lane >> 5;
    const bf16_t* proj = (const bf16_t*)(a.ws + WS_PROJ); bf16_t* mixed = (bf16_t*)(a.ws + WS_ACT);
    const bf16_t* VT = (const bf16_t*)((const unsigned char*)a.out + VT_OFF);
    const float* go = a.in[12];
    const int krow_l = (r32 & 19) | ((r32 & 4) << 1) | ((r32 & 8) >> 1);
    for (int item = wave_id; item < 64 * 128; item += n_waves) {
        const int tile = 127 - (item >> 6), bh = item & 63, b = bh >> 3, h = bh & 7;
        const int t0 = tile * 32, t = t0 + r32; const size_t tokb = (size_t)b * SEQ;
        bf16x8 qf[4];
#pragma unroll
        for (int ks = 0; ks < 4; ++ks) qf[ks] = *(const bf16x8*)(proj + (tokb + t) * NPROJ + 2048 + h * 64 + 16 * ks + 8 * hh);
        f32x16 O0, O1;
#pragma unroll
        for (int r = 0; r < 16; ++r) { O0[r] = 0.f; O1[r] = 0.f; }
        float R = 0.f;
        const bf16_t* kbase = proj + (tokb + krow_l) * NPROJ + 2560 + h * 64 + 8 * hh;
        const bf16_t* vbase = VT + ((size_t)bh * 64 + r32) * SEQ + 8 * hh;
        for (int kb = tile; kb >= 0; --kb) {
            const int k0 = kb * 32;
            bf16x8 kf[4], vf[4];
#pragma unroll
            for (int ks = 0; ks < 4; ++ks) kf[ks] = *(const bf16x8*)(kbase + (size_t)k0 * NPROJ + 16 * ks);
#pragma unroll
            for (int mt = 0; mt < 2; ++mt)
#pragma unroll
                for (int s = 0; s < 2; ++s) vf[mt * 2 + s] = *(const bf16x8*)(vbase + (size_t)(32 * mt) * SEQ + k0 + 16 * s);
            f32x16 Z;
#pragma unroll
            for (int r = 0; r < 16; ++r) Z[r] = 0.f;
#pragma unroll
            for (int ks = 0; ks < 4; ++ks) Z = __builtin_amdgcn_mfma_f32_32x32x16_bf16(kf[ks], qf[ks], Z, 0, 0, 0);
            float l1[16], lb[16];
#pragma unroll
            for (int r = 0; r < 16; ++r) {
                const float z = Z[r];
                const float lp = __logf(1.0f + __expf(-fabsf(z)));
                const bool valid = (k0 + 16 * (r >> 3) + 8 * hh + (r & 7)) < t;
                l1[r] = valid ? -(fmaxf(z, 0.f) + lp) : 0.f;
                lb[r] = valid ? (fminf(z, 0.f) - lp) : -1.0e30f;
            }
            float sufA[8], sufB[8];
            sufA[7] = 0.f; sufB[7] = 0.f;
#pragma unroll
            for (int p = 6; p >= 0; --p) { sufA[p] = sufA[p + 1] + l1[p + 1]; sufB[p] = sufB[p + 1] + l1[8 + p + 1]; }
            const float sA = sufA[0] + l1[0], sB = sufB[0] + l1[8];
            const float pA = __shfl_xor(sA, 32), pB = __shfl_xor(sB, 32);
            const float aboveB = hh ? 0.f : pB;
            const float aboveA = hh ? (sB + pB) : (pB + sB + pA);
            const float RA = R + aboveA, RB = R + aboveB;
#pragma unroll
            for (int p = 0; p < 8; ++p) { Z[p] = __expf(lb[p] + RA + sufA[p]); Z[8 + p] = __expf(lb[8 + p] + RB + sufB[p]); }
            R += (sA + sB) + (pA + pB);
            const bf16x8 p0 = pack8(Z, 0), p1 = pack8(Z, 1);
            O0 = __builtin_amdgcn_mfma_f32_32x32x16_bf16(vf[0], p0, O0, 0, 0, 0);
            O0 = __builtin_amdgcn_mfma_f32_32x32x16_bf16(vf[1], p1, O0, 0, 0, 0);
            O1 = __builtin_amdgcn_mfma_f32_32x32x16_bf16(vf[2], p0, O1, 0, 0, 0);
            O1 = __builtin_amdgcn_mfma_f32_32x32x16_bf16(vf[3], p1, O1, 0, 0, 0);
            if (__all(R < -110.0f)) break;
        }
        float ss = 0.f;
#pragma unroll
        for (int r = 0; r < 16; ++r) ss += O0[r] * O0[r] + O1[r] * O1[r];
        ss += __shfl_xor(ss, 32);
        const float rn = rsqrtf(ss * (1.0f / 64.0f) + EPS);
        bf16_t* dst = mixed + (tokb + t) * DM + 512 + h * 64;
#pragma unroll
        for (int g = 0; g < 4; ++g) {
            const int d = 8 * g + 4 * hh;
            const f32x4 gv0 = *(const f32x4*)(go + d), gv1 = *(const f32x4*)(go + 32 + d);
            u32x2 w0, w1;
            w0.x = pk2(O0[4 * g] * rn * gv0[0], O0[4 * g + 1] * rn * gv0[1]); w0.y = pk2(O0[4 * g + 2] * rn * gv0[2], O0[4 * g + 3] * rn * gv0[3]);
            w1.x = pk2(O1[4 * g] * rn * gv1[0], O1[4 * g + 1] * rn * gv1[1]); w1.y = pk2(O1[4 * g + 2] * rn * gv1[2], O1[4 * g + 3] * rn * gv1[3]);
            *(u32x2*)(dst + d) = w0; *(u32x2*)(dst + 32 + d) = w1;
        }
    }
}

__device__ __forceinline__ void topk_insert(float (&L)[16], float x) {
#pragma unroll
    for (int i = 15; i >= 1; --i) L[i] = __builtin_amdgcn_fmed3f(L[i - 1], L[i], x);
    L[0] = fmaxf(L[0], x);
}
template <int I, int J> __device__ __forceinline__ void cand_ins(float (&M)[16], const float (&L0)[16], const float (&L1)[16]) {
    const float s = __uint_as_float(__float_as_uint(L0[I]) & ~127u) + __uint_as_float(__float_as_uint(L1[J]) & ~127u);
    topk_insert(M, __uint_as_float((__float_as_uint(s) & ~255u) | (unsigned)(I * 16 + J)));
}
template <int I, int... Js> __device__ __forceinline__ void cand_row(float (&M)[16], const float (&L0)[16], const float (&L1)[16], std::integer_sequence<int, Js...>) {
    (cand_ins<I, Js>(M, L0, L1), ...);
}
template <int... Is> __device__ __forceinline__ void cand_all(float (&M)[16], const float (&L0)[16], const float (&L1)[16], std::integer_sequence<int, Is...>) {
    (cand_row<Is>(M, L0, L1, std::make_integer_sequence<int, 16 / (Is + 1)>{}), ...);
}
__device__ __forceinline__ unsigned sel16(const float (&L)[16], int i) {
    unsigned r = __float_as_uint(L[0]);
#pragma unroll
    for (int k = 1; k < 16; ++k) { r = (i == k) ? __float_as_uint(L[k]) : r; asm volatile("" : "+v"(r)); }
    return r;
}
__device__ __forceinline__ void phase_scores(const Args& a, LAS unsigned char* lds, const pg8::StaticOrder& S) {
    const bf16_t* qp = (const bf16_t*)(a.ws + WS_QPEER); const bf16_t* kb = (const bf16_t*)(a.ws + WS_SUBK);
    unsigned* sel_e = (unsigned*)(a.ws + WS_SELE); float* sel_g = (float*)(a.ws + WS_SELG);
    pg8::Unit un;
    for (int ui = 0; S.next(ui, un); ++ui) {
        int tid = threadIdx.x; asm volatile("" : "+v"(tid));
        const int lane = tid & 63, wave = tid >> 6, r32 = lane & 31, hh = lane >> 5;
        const int h = un.pn, tile = un.pm;
        __syncthreads();
        for (int c = tid; c < 4096; c += NTHR) { const int r = c >> 4, cc = c & 15;
            *(LAS u32x4*)(lds + r * 272 + cc * 16) = *(const u32x4*)(kb + ((size_t)h * 256 + r) * 128 + cc * 8); }
        __syncthreads();
        const size_t tok = (size_t)tile * 256 + wave * 32 + r32;
        float L0[16], L1[16];
#pragma unroll
        for (int p = 0; p < 2; ++p) {
            bf16x8 bq[8];
#pragma unroll
            for (int ks = 0; ks < 8; ++ks) bq[ks] = *(const bf16x8*)(qp + tok * 2048 + (h * 2 + p) * 128 + 16 * ks + 8 * hh);
            float L[16];
#pragma unroll
            for (int i = 0; i < 16; ++i) L[i] = -3.0e38f;
#pragma unroll
            for (int kt = 0; kt < 4; ++kt) {
                f32x16 acc;
#pragma unroll
                for (int r = 0; r < 16; ++r) acc[r] = 0.f;
                const LAS unsigned char* Ab = lds + (p * 128 + 32 * kt + r32) * 272 + hh * 16;
#pragma unroll
                for (int ks = 0; ks < 8; ++ks) acc = __builtin_amdgcn_mfma_f32_32x32x16_bf16(*(const LAS bf16x8*)(Ab + ks * 32), bq[ks], acc, 0, 0, 0);
#pragma unroll
                for (int r = 0; r < 16; ++r) {
                    const unsigned key = (unsigned)(32 * kt + (r & 3) + 8 * (r >> 2)) + 4u * (unsigned)hh;
                    topk_insert(L, __uint_as_float((__float_as_uint(acc[r]) & ~127u) | key));
                }
            }
            float P[16];
#pragma unroll
            for (int i = 0; i < 16; ++i) P[i] = __shfl_xor(L[i], 32);
#pragma unroll
            for (int i = 0; i < 16; ++i) topk_insert(L, P[i]);
#pragma unroll
            for (int i = 0; i < 16; ++i) { if (p == 0) L0[i] = L[i]; else L1[i] = L[i]; }
        }
        float M[16];
#pragma unroll
        for (int i = 0; i < 16; ++i) M[i] = -3.0e38f;
        cand_all(M, L0, L1, std::make_integer_sequence<int, 16>{});
        const float m0 = __uint_as_float(__float_as_uint(M[0]) & ~255u);
        float den = 0.f;
#pragma unroll
        for (int i = 0; i < 16; ++i) den += __expf(__uint_as_float(__float_as_uint(M[i]) & ~255u) - m0);
        const float rden = 1.0f / den;
        unsigned eo[8]; float go[8];
#pragma unroll
        for (int q = 0; q < 8; ++q) {
            unsigned mlo = __float_as_uint(M[q]), mhi = __float_as_uint(M[8 + q]); asm volatile("" : "+v"(mlo), "+v"(mhi));
            const unsigned mb = hh ? mhi : mlo;
            const int ci = (mb >> 4) & 15, cj = mb & 15;
            eo[q] = (sel16(L0, ci) & 127u) * 128u + (sel16(L1, cj) & 127u);
            go[q] = __expf(__uint_as_float(mb & ~255u) - m0) * rden;
        }
        const size_t ob = (tok * 8 + h) * 16 + 8 * hh;
        *(u32x4*)(sel_e + ob) = (u32x4){eo[0], eo[1], eo[2], eo[3]}; *(u32x4*)(sel_e + ob + 4) = (u32x4){eo[4], eo[5], eo[6], eo[7]};
        *(f32x4*)(sel_g + ob) = (f32x4){go[0], go[1], go[2], go[3]}; *(f32x4*)(sel_g + ob + 4) = (f32x4){go[4], go[5], go[6], go[7]};
    }
}


template <int CTRL> __device__ __forceinline__ int dppi(int x) { return __builtin_amdgcn_update_dpp(0, x, CTRL, 0xF, 0xF, true); }
__device__ __forceinline__ void peer_gather(u32x4 (&w)[16], const LAS unsigned* idp, const unsigned char* tab) {
    u32x4 id[4];
#pragma unroll
    for (int c = 0; c < 4; ++c) id[c] = *(const LAS u32x4*)(idp + 4 * c);
#pragma unroll
    for (int i = 0; i < 16; ++i) w[i] = *(const u32x4*)(tab + (size_t)id[i >> 2][i & 3] * 128);
}
__device__ __forceinline__ void peer_u_reduce(const u32x4 (&w)[16], const u32x4 hq, LAS int* pp, bool first, bool b2, bool b1, bool b0) {
    int p[16];
#pragma unroll
    for (int i = 0; i < 16; ++i) {
        int acc = __builtin_amdgcn_sdot4((int)w[i].x, (int)hq.x, 0, false);
        acc = __builtin_amdgcn_sdot4((int)w[i].y, (int)hq.y, acc, false);
        acc = __builtin_amdgcn_sdot4((int)w[i].z, (int)hq.z, acc, false);
        p[i] = __builtin_amdgcn_sdot4((int)w[i].w, (int)hq.w, acc, false);
    }
    int q8[8], q4[4], q2[2];
#pragma unroll
    for (int k = 0; k < 8; ++k) { const int keep = b2 ? p[8 + k] : p[k], send = b2 ? p[k] : p[8 + k]; q8[k] = keep + dppi<0x141>(send); }
#pragma unroll
    for (int k = 0; k < 4; ++k) { const int keep = b1 ? q8[4 + k] : q8[k], send = b1 ? q8[k] : q8[4 + k]; q4[k] = keep + dppi<0x4E>(send); }
#pragma unroll
    for (int k = 0; k < 2; ++k) { const int keep = b0 ? q4[2 + k] : q4[k], send = b0 ? q4[k] : q4[2 + k]; q2[k] = keep + dppi<0xB1>(send); }
    if (first) { pp[0] = q2[0]; pp[8] = q2[1]; } else { pp[0] += q2[0]; pp[8] += q2[1]; }
}
__device__ __forceinline__ void peer_v_reduce(const u32x4 (&w)[16], const LAS unsigned* ap, float asc, float* op, const unsigned* xp, f32x2 gv, bool e0, bool e1, bool e2) {
    const u32x4 aq = *(const LAS u32x4*)ap;
    int y[16];
#pragma unroll
    for (int k = 0; k < 16; ++k) y[k] = 0;
#pragma unroll
    for (int g = 0; g < 4; ++g)
#pragma unroll
        for (int c = 0; c < 4; ++c) {
            const unsigned W0 = w[4 * g][c], W1 = w[4 * g + 1][c], W2 = w[4 * g + 2][c], W3 = w[4 * g + 3][c];
            const unsigned p01l = __builtin_amdgcn_perm(W1, W0, 0x05010400u), p01h = __builtin_amdgcn_perm(W1, W0, 0x07030602u);
            const unsigned p23l = __builtin_amdgcn_perm(W3, W2, 0x05010400u), p23h = __builtin_amdgcn_perm(W3, W2, 0x07030602u);
            const unsigned T0 = __builtin_amdgcn_perm(p23l, p01l, 0x05040100u), T1 = __builtin_amdgcn_perm(p23l, p01l, 0x07060302u);
            const unsigned T2 = __builtin_amdgcn_perm(p23h, p01h, 0x05040100u), T3 = __builtin_amdgcn_perm(p23h, p01h, 0x07060302u);
            y[4 * c + 0] = __builtin_amdgcn_sdot4((int)T0, (int)aq[g], y[4 * c + 0], false);
            y[4 * c + 1] = __builtin_amdgcn_sdot4((int)T1, (int)aq[g], y[4 * c + 1], false);
            y[4 * c + 2] = __builtin_amdgcn_sdot4((int)T2, (int)aq[g], y[4 * c + 2], false);
            y[4 * c + 3] = __builtin_amdgcn_sdot4((int)T3, (int)aq[g], y[4 * c + 3], false);
        }
    int z8[8], z4[4], z2[2];
#pragma unroll
    for (int k = 0; k < 8; ++k) { const int keep = e0 ? y[8 + k] : y[k], send = e0 ? y[k] : y[8 + k]; z8[k] = keep + dppi<0x128>(send); }
#pragma unroll
    for (int k = 0; k < 4; ++k) { const int keep = e1 ? z8[4 + k] : z8[k], send = e1 ? z8[k] : z8[4 + k]; z4[k] = keep + __shfl_xor(send, 16); }
#pragma unroll
    for (int k = 0; k < 2; ++k) { const int keep = e2 ? z4[2 + k] : z4[k], send = e2 ? z4[k] : z4[2 + k]; z2[k] = keep + __shfl_xor(send, 32); }
    const unsigned xw = *xp; const f32x2 xv = (f32x2){bf_lo(xw), bf_hi(xw)};
    *(f32x2*)op = xv + gv * (f32x2){(float)z2[0] * asc, (float)z2[1] * asc};
}
__device__ __forceinline__ void phase_peer(const Args& a, LAS unsigned char* lds, int vblock) {
    const int wave = threadIdx.x >> 6;
    const int gw = vblock * NWAVE + wave, NGW = gridDim.x * NWAVE;
    const unsigned* gsel_e = (const unsigned*)(a.ws + WS_SELE); const float* gsel_g = (const float*)(a.ws + WS_SELG);
    const unsigned char* hq = a.ws + WS_HQ; const float* hsc = (const float*)(a.ws + WS_HS);
    const unsigned char* Uq = a.ws + WS_UT; const unsigned char* Vq = a.ws + WS_VT;
    const float* uscale = (const float*)(a.ws + WS_US); const float* vscale = (const float*)(a.ws + WS_VS);
    const float* mod = (const float*)(a.ws + WS_MOD); float* out = a.out; const bf16_t* x1b = (const bf16_t*)(a.ws + WS_X1B);
    LAS unsigned* ids = (LAS unsigned*)(lds + wave * 16384);
    LAS int* pre = (LAS int*)(lds + wave * 16384 + 8192);
    for (int grp = gw; grp * 16 < T_TOK; grp += NGW) {
        int lane = threadIdx.x & 63; asm volatile("" : "+v"(lane));
        const int sub = lane & 7, eg = lane >> 3;
        const bool b2 = (sub & 4) != 0, b1 = (sub & 2) != 0, b0 = (sub & 1) != 0;
        const bool e0 = (eg & 1) != 0, e1 = (eg & 2) != 0, e2 = (eg & 4) != 0;
        const size_t tok0 = (size_t)grp * 16;
#pragma unroll
        for (int j = 0; j < 8; ++j) {
            const int q = lane + 64 * j;
            const u32x4 v = *(const u32x4*)(gsel_e + tok0 * 128 + (size_t)q * 4);
            const int t = q >> 5, k = (q & 31) * 4;
#pragma unroll
            for (int c = 0; c < 4; ++c) ids[t * 128 + ((k + c) & 7) * 16 + ((k + c) >> 3)] = v[c];
        }
        LDS_WAIT();
        for (int s = 0; s < 8; ++s) {
            const unsigned char* Us = Uq + (size_t)s * 16384 * 128 + 16 * sub;
            const unsigned char* hs = hq + tok0 * DM + 128 * s + 16 * sub;
            u32x4 wA[16], wB[16], hA, hB;
            peer_gather(wA, ids + eg * 16, Us); hA = *(const u32x4*)(hs);
            for (int t = 0; t < 16; t += 2) {
                peer_gather(wB, ids + (t + 1) * 128 + eg * 16, Us); hB = *(const u32x4*)(hs + (t + 1) * DM);
                peer_u_reduce(wA, hA, pre + t * 128 + 16 * sub + eg, s == 0, b2, b1, b0);
                if (t + 2 < 16) { peer_gather(wA, ids + (t + 2) * 128 + eg * 16, Us); hA = *(const u32x4*)(hs + (t + 2) * DM); }
                peer_u_reduce(wB, hB, pre + (t + 1) * 128 + 16 * sub + eg, s == 0, b2, b1, b0);
            }
        }
        LDS_WAIT();
        for (int t = 0; t < 16; ++t) {
            float r[2]; const float hs_t = hsc[tok0 + t];
#pragma unroll
            for (int c = 0; c < 2; ++c) {
                const int k = lane + 64 * c;
                const unsigned e = ids[t * 128 + (k & 7) * 16 + (k >> 3)];
                const float pv = (float)pre[t * 128 + k] * (uscale[e] * hs_t);
                r[c] = 0.5f * pv * (1.0f + erff(pv * 0.70710678118654752f)) * gsel_g[(tok0 + t) * 128 + k] * vscale[e];
            }
            const float am = wave_max(fmaxf(fabsf(r[0]), fabsf(r[1])));
            const float inv = am > 0.f ? 127.0f / am : 0.f;
            LDS_WAIT();
            LAS unsigned char* ab = (LAS unsigned char*)(pre + t * 128);
#pragma unroll
            for (int c = 0; c < 2; ++c) { const int k = lane + 64 * c; ab[(k & 7) * 16 + (k >> 3)] = (unsigned char)((int)rintf(r[c] * inv) & 255); }
            if (lane == 0) *(LAS float*)(ab + 128) = am * (1.0f / 127.0f);
        }
        LDS_WAIT();
        for (int s = 0; s < 8; ++s) {
            const unsigned char* Vs = Vq + (size_t)s * 16384 * 128 + 16 * sub;
            const int d = 128 * s + 16 * sub + (e0 ? 8 : 0) + (e1 ? 4 : 0) + (e2 ? 2 : 0);
            const f32x2 gv = *(const f32x2*)(mod + (tok0 >> 12) * NMODC + 5120 + d);
            u32x4 wA[16], wB[16];
            peer_gather(wA, ids + eg * 16, Vs);
            for (int t = 0; t < 16; t += 2) {
                peer_gather(wB, ids + (t + 1) * 128 + eg * 16, Vs);
                peer_v_reduce(wA, (const LAS unsigned*)(pre + t * 128) + eg * 4, *(const LAS float*)((const LAS unsigned char*)(pre + t * 128) + 128), out + (tok0 + t) * DM + d, (const unsigned*)(x1b + (tok0 + t) * DM + d), gv, e0, e1, e2);
                if (t + 2 < 16) peer_gather(wA, ids + (t + 2) * 128 + eg * 16, Vs);
                peer_v_reduce(wB, (const LAS unsigned*)(pre + (t + 1) * 128) + eg * 4, *(const LAS float*)((const LAS unsigned char*)(pre + (t + 1) * 128) + 128), out + (tok0 + t + 1) * DM + d, (const unsigned*)(x1b + (tok0 + t + 1) * DM + d), gv, e0, e1, e2);
            }
        }
        LDS_WAIT();
    }
}

__device__ __forceinline__ void grid_barrier(unsigned* cnt, unsigned nblocks) {
    __syncthreads();
    if (threadIdx.x == 0) {
        __builtin_amdgcn_fence(__ATOMIC_RELEASE, "agent");
        asm volatile("s_waitcnt vmcnt(0)" ::: "memory");
        __hip_atomic_fetch_add(cnt, 1u, __ATOMIC_RELAXED, __HIP_MEMORY_SCOPE_AGENT);
        while (__hip_atomic_load(cnt, __ATOMIC_RELAXED, __HIP_MEMORY_SCOPE_AGENT) < nblocks) __builtin_amdgcn_s_sleep(2);
        __builtin_amdgcn_fence(__ATOMIC_ACQUIRE, "agent");
        asm volatile("s_waitcnt vmcnt(0)" ::: "memory");
    }
    __syncthreads();
}

#define XB_TMO      128
#define XB_XCNT(j)  (256  + 64 * (j))
#define XB_XSUB(j)  (1280 + 64 * (j))
#define XB_XGEN(j)  (2304 + 64 * (j))
#define XB_TOP      3328
#define XB_TOPGEN   3392
#define XB_SPIN_CAP (1u << 22)
__device__ __forceinline__ unsigned xb_ld(unsigned* p)              { return __hip_atomic_load(p, __ATOMIC_RELAXED, __HIP_MEMORY_SCOPE_AGENT); }
__device__ __forceinline__ unsigned xb_add(unsigned* p, unsigned v) { return __hip_atomic_fetch_add(p, v, __ATOMIC_RELAXED, __HIP_MEMORY_SCOPE_AGENT); }
__device__ __forceinline__ unsigned xb_xcc_id() { return (unsigned)__builtin_amdgcn_s_getreg((3 << 11) | 20) & 0xFu; }
#define XB_SPIN(cond, bar) do { unsigned _sp = 0; while (cond) { __builtin_amdgcn_s_sleep(1); \
    if ((++_sp & 255u) == 0u) { if (xb_ld(&(bar)[XB_TMO])) break; if (_sp > XB_SPIN_CAP) { atomicAdd(&(bar)[XB_TMO], 1u); break; } } } } while (0)
struct XcdBarrier { unsigned* bar; unsigned x; volatile LAS unsigned* st; };
__device__ __forceinline__ XcdBarrier xcd_barrier_post(unsigned* bar, volatile LAS unsigned* st) {
    XcdBarrier b; b.bar = bar; b.x = xb_xcc_id(); b.st = st;
    if (threadIdx.x == 0) (void)xb_add(&bar[XB_XCNT(b.x)], 1u);
    return b;
}
__device__ __forceinline__ void xcd_barrier_complete(unsigned* bar, unsigned x, unsigned& nloc, unsigned& nx) {
    const unsigned G = gridDim.x * gridDim.y * gridDim.z;
    unsigned sum, cnt, mine, sp = 0u;
    for (;;) {
        sum = 0u; cnt = 0u; mine = 0u;
#pragma unroll
        for (unsigned j = 0; j < 16; ++j) { const unsigned c = xb_ld(&bar[XB_XCNT(j)]); sum += c; cnt += (c > 0u) ? 1u : 0u; mine = (j == x) ? c : mine; }
        if (sum == G) break;
        __builtin_amdgcn_s_sleep(1);
        if ((++sp & 255u) == 0u) { if (xb_ld(&bar[XB_TMO])) break; if (sp > XB_SPIN_CAP) { atomicAdd(&bar[XB_TMO], 1u); break; } }
    }
    nloc = mine > 0u ? mine : 1u; nx = cnt > 0u ? cnt : 1u;
}
__device__ __forceinline__ void xcd_barrier(const XcdBarrier& b) {
    asm volatile("s_waitcnt vmcnt(0)" ::: "memory");
    __syncthreads();
    if (threadIdx.x == 0) {
        unsigned* bar = b.bar;
        __builtin_amdgcn_s_waitcnt(0);
        unsigned nloc = b.st[0], nx = b.st[1];
        if (nloc == 0u) { xcd_barrier_complete(bar, b.x, nloc, nx); b.st[0] = nloc; b.st[1] = nx; }
        const unsigned old = xb_add(&bar[XB_XSUB(b.x)], 1u);
        const unsigned gen = old / nloc;
        if (old + 1u == (gen + 1u) * nloc) {
            __builtin_amdgcn_fence(__ATOMIC_RELEASE, "agent");
            asm volatile("s_waitcnt vmcnt(0)" ::: "memory");
            const unsigned og = xb_add(&bar[XB_TOP], 1u);
            const unsigned tg = og / nx;
            if (og + 1u == (tg + 1u) * nx) xb_add(&bar[XB_TOPGEN], 1u);
            else XB_SPIN(xb_ld(&bar[XB_TOPGEN]) == tg, bar);
            __builtin_amdgcn_fence(__ATOMIC_ACQUIRE, "agent");
            xb_add(&bar[XB_XGEN(b.x)], 1u);
            asm volatile("s_waitcnt vmcnt(0)" ::: "memory");
        } else {
            XB_SPIN(xb_ld(&bar[XB_XGEN(b.x)]) == gen, bar);
            __builtin_amdgcn_fence(__ATOMIC_ACQUIRE, "agent");
            asm volatile("s_waitcnt vmcnt(0)" ::: "memory");
        }
    }
    __syncthreads();
}

__device__ __forceinline__ void pair_sync(unsigned* cnt, unsigned* bar, bool same_xcd) {
    asm volatile("s_waitcnt vmcnt(0)" ::: "memory");
    __syncthreads();
    if (threadIdx.x == 0) {
        if (!same_xcd) __builtin_amdgcn_fence(__ATOMIC_RELEASE, "agent");
        asm volatile("s_waitcnt vmcnt(0)" ::: "memory");
        (void)xb_add(cnt, 1u);
        XB_SPIN(xb_ld(cnt) < 2u, bar);
        __builtin_amdgcn_fence(__ATOMIC_ACQUIRE, "agent");
        asm volatile("s_waitcnt vmcnt(0)" ::: "memory");
    }
    __syncthreads();
}

__global__ void __launch_bounds__(NTHR, 2) mega(Args a) {
    extern __shared__ __attribute__((aligned(16))) unsigned char smem[];
    LAS unsigned char* lds = (LAS unsigned char*)smem;
    const int lo = a.ph_lo, hi = a.ph_hi;
    const int G = gridDim.x;
    if (threadIdx.x < 4) ((LAS unsigned*)(lds + LDS_BYTES - 16))[threadIdx.x] = 0u;
    XcdBarrier xb; xb.bar = (unsigned*)(a.ws + WS_XB); xb.x = 0; xb.st = (volatile LAS unsigned*)(lds + LDS_BYTES - 16);
#define IN(k) (lo <= (k) && (k) < hi)
#ifndef DUP_MASK
#define DUP_MASK 0
#endif
#define REP(k) for (int rep_ = 0; rep_ < 1 + ((DUP_MASK >> (k)) & 1); ++rep_, (((DUP_MASK >> 23) & 1) && ((DUP_MASK >> (k)) & 1) && (k) < 16 && rep_ == 1 ? grid_barrier((unsigned*)(a.ws + WS_BAR) + 64 * ((k) > 15 ? 15 : (k)) + 16, (unsigned)G) : (void)0))
    const bool pairm = PAIR_CHAIN && G == 2 * (T_TOK / pg8::BM) && lo <= 0 && hi > 10;
    const int bx = (int)blockIdx.x, vb = pairm ? (((((bx >> 4) << 3) | (bx & 7)) << 1) | ((bx >> 3) & 1)) : bx;
    unsigned* pcnt = (unsigned*)(a.ws + WS_PC) + (vb >> 1) * 64;
    bool same_xcd = false;
#define PSYNC(k, s) do { if (pairm) pair_sync(pcnt + 16 * (s), (unsigned*)(a.ws + WS_XB), same_xcd); else SYNC(k); } while (0)
#define SYNC(k) do { if (IN(k) && IN((k) + 1)) { if ((k) == 0) { cg::this_grid().sync(); xb = xcd_barrier_post((unsigned*)(a.ws + WS_XB), (volatile LAS unsigned*)(lds + LDS_BYTES - 16)); } else { xcd_barrier(xb); if ((DUP_MASK >> 22) & 1) xcd_barrier(xb); } } } while (0)
    if (IN(0) && threadIdx.x == 0) ((unsigned*)(a.ws + WS_PC) + 128 * 64)[bx] = 1u + xb_xcc_id();
    if (IN(0)) REP(0) phase0(a, lds);
    SYNC(0);
    if (IN(1)) REP(1) { phase_norm<true>(a, a.in[0], a.in[4], 0, 1024, (int)blockIdx.x); phase0b(a, lds); }
    SYNC(1);
#if INPROJ_I8
    if (IN(2)) REP(2) { pg8::Gemm g{(const bf16_t*)(a.ws + WS_ACT), (const bf16_t*)(a.ws + WS_WIN_T), T_TOK, NPROJ, 512}; pg8::StaticOrder S; S.init(T_TOK, NPROJ, G, (int)blockIdx.x);
        pg8::EpiBf16S E{(bf16_t*)(a.ws + WS_PROJ), NPROJ, (const float*)(a.ws + WS_H1S), (const float*)(a.ws + WS_WINS)}; pg8::gemm_phase<pg8::EpiBf16S, true>(lds, g, S, E); }
#else
    if (IN(2)) REP(2) { pg8::Gemm g{(const bf16_t*)(a.ws + WS_ACT), (const bf16_t*)(a.ws + WS_WIN_T), T_TOK, NPROJ, 1024}; pg8::StaticOrder S; S.init(T_TOK, NPROJ, G, (int)blockIdx.x);
        pg8::EpiBf16 E{(bf16_t*)(a.ws + WS_PROJ), NPROJ}; pg8::gemm_phase(lds, g, S, E); }
#endif
    SYNC(2);
    if (IN(3)) { REP(3) dn_prep(a, lds); REP(18) sb_prep(a); }
    SYNC(3);
    if (IN(4)) {
        if ((int)blockIdx.x < DN_BLOCKS) { REP(16) dn_scan2(a, lds); }
        else { REP(17) sb_attn(a, ((int)blockIdx.x - DN_BLOCKS) * NWAVE + (int)(threadIdx.x >> 6), (G - DN_BLOCKS) * NWAVE);
               late_prep(a, lds, ((int)blockIdx.x - DN_BLOCKS) * NWAVE + (int)(threadIdx.x >> 6), (G - DN_BLOCKS) * NWAVE); }
    }
    SYNC(4);
    if (IN(5)) REP(5) dn_gate_norm(a);
    SYNC(5);
    if (IN(6)) REP(6) { pg8::Gemm g{(const bf16_t*)(a.ws + WS_MQ), (const bf16_t*)(a.ws + WS_WOUT_T), T_TOK, 1024, 512}; pg8::StaticOrder S; S.init(T_TOK, 1024, G, vb, pairm);
        pg8::EpiResidS E{a.in[0], (const float*)(a.ws + WS_MOD), (bf16_t*)(a.ws + WS_X1B), (const float*)(a.ws + WS_MS), (const float*)(a.ws + WS_WOS)}; pg8::gemm_phase<pg8::EpiResidS, true>(lds, g, S, E); }
    if (pairm) same_xcd = xb_ld((unsigned*)(a.ws + WS_PC) + 128 * 64 + (bx ^ 8)) == 1u + xb_xcc_id();
    PSYNC(6, 0);
    if (IN(7)) REP(7) phase_norm<false>(a, a.out, a.in[14], 3072, 4096, vb);
    PSYNC(7, 1);
    if (IN(8)) REP(8) {
#if QUERY_I8
        pg8::Gemm g{(const bf16_t*)(a.ws + WS_HQ), (const bf16_t*)(a.ws + WS_WQ_T), T_TOK, 2048, 512}; pg8::StaticOrder S; S.init(T_TOK, 2048, G, vb, pairm);
        pg8::EpiBf16S E{(bf16_t*)(a.ws + WS_QPEER), 2048, (const float*)(a.ws + WS_HS), (const float*)(a.ws + WS_WQS)}; pg8::gemm_phase<pg8::EpiBf16S, true>(lds, g, S, E);
#else
        pg8::Gemm g{(const bf16_t*)(a.ws + WS_ACT), (const bf16_t*)(a.ws + WS_WQ_T), T_TOK, 2048, 1024}; pg8::StaticOrder S; S.init(T_TOK, 2048, G, (int)blockIdx.x);
        pg8::EpiBf16 E{(bf16_t*)(a.ws + WS_QPEER), 2048}; pg8::gemm_phase(lds, g, S, E);
#endif
        asm volatile("s_waitcnt vmcnt(0)" ::: "memory"); __syncthreads();
        phase_scores(a, lds, S); }
    PSYNC(8, 2);
    if (IN(10)) phase_peer(a, lds, vb);
#undef IN
#undef SYNC
#undef PSYNC
}

#ifndef ONE_LAUNCH
#define ONE_LAUNCH 1
#endif

extern "C" void kernel_launch(void* const* d_in, const int* in_sizes, int n_in, void* d_out, int out_size, void* d_ws, size_t ws_size, hipStream_t stream) {
    static int grid = 0;
    if (grid == 0) {
        int dev = 0, cus = 0, per_cu = 0;
        (void)hipGetDevice(&dev);
        (void)hipDeviceGetAttribute(&cus, hipDeviceAttributeMultiprocessorCount, dev);
        (void)hipFuncSetAttribute((const void*)mega, hipFuncAttributeMaxDynamicSharedMemorySize, LDS_BYTES);
        (void)hipOccupancyMaxActiveBlocksPerMultiprocessor(&per_cu, (const void*)mega, NTHR, LDS_BYTES);
        if (per_cu < 1) { fprintf(stderr, "kernel_launch: occupancy query says %d blocks/CU\n", per_cu); per_cu = 1; }
        if (per_cu > 1) per_cu = 1;
        grid = cus * per_cu;
        if (ws_size < WS_END4) fprintf(stderr, "kernel_launch: workspace too small: %zu < %zu\n", ws_size, (size_t)WS_END4);
    }
    Args a{};
    for (int i = 0; i < 19; ++i) a.in[i] = (const float*)d_in[i];
    a.out = (float*)d_out; a.ws = (unsigned char*)d_ws;
#if ONE_LAUNCH
    a.ph_lo = 0; a.ph_hi = N_PHASES;
    void* args[] = {&a};
    hipError_t e = hipLaunchCooperativeKernel((const void*)mega, dim3(grid), dim3(NTHR), args, LDS_BYTES, stream);
    if (e != hipSuccess) fprintf(stderr, "cooperative launch failed: %s (grid %d)\n", hipGetErrorString(e), grid);
#else
    for (int p = 0; p < N_PHASES; ++p) {
        a.ph_lo = p; a.ph_hi = p + 1;
        hipLaunchKernelGGL(mega, dim3(grid), dim3(NTHR), LDS_BYTES, stream, a);
    }
#endif
}
```

```cpp
#include <hip/hip_runtime.h>
#include <hip/hip_cooperative_groups.h>
#include <cstdio>
#include <utility>
#include <type_traits>
namespace cg = cooperative_groups;
#ifndef INPROJ_I8
#define INPROJ_I8 1
#endif
#ifndef QUERY_I8
#define QUERY_I8 1
#ifndef PAIR_CHAIN
#define PAIR_CHAIN 1
#endif
#endif

#define LAS __attribute__((address_space(3)))
typedef unsigned short bf16_t;
typedef short bf16x8 __attribute__((ext_vector_type(8)));
typedef float f32x4 __attribute__((ext_vector_type(4)));
typedef float f32x2 __attribute__((ext_vector_type(2)));
typedef unsigned u32x4 __attribute__((ext_vector_type(4)));
typedef unsigned u32x2 __attribute__((ext_vector_type(2)));
using bf16x2 = __attribute__((ext_vector_type(2))) __bf16;

constexpr int T_TOK = 32768, SEQ = 4096, DM = 1024, NMODC = 6144;
constexpr int NPROJ = 3584, LDW_IN = 3592;
constexpr int NTHR = 512, NWAVE = 8;
constexpr int LDS_BYTES = 160 * 1024;
constexpr int N_PHASES = 11;
constexpr int DN_BLOCKS = 64;
constexpr float EPS = 1e-6f;

constexpr size_t WS_MOD = 0;
constexpr size_t WS_WSM = WS_MOD + 8 * 6144 * 4;
constexpr size_t WS_SMALL = WS_WSM + 8 * 1024 * 4;
constexpr size_t WS_WIN_T = WS_SMALL + (size_t)T_TOK * 8 * 4;
constexpr size_t WS_WOUT_T = WS_WIN_T + (size_t)NPROJ * 1024 * 2;
constexpr size_t WS_WQ_T = WS_WOUT_T + (size_t)1024 * 1024 * 2;
constexpr size_t WS_SUBK = WS_WQ_T + (size_t)2048 * 1024 * 2;
constexpr size_t WS_UT = WS_SUBK + (size_t)16 * 128 * 128 * 2;
constexpr size_t WS_VT = WS_UT + (size_t)16384 * 1024 * 2;
constexpr size_t WS_US = WS_UT + (size_t)16384 * 1024;
constexpr size_t WS_VS = WS_US + 65536;
constexpr size_t WS_H1S = WS_VS + 65536;
constexpr size_t WS_WINS = WS_H1S + (size_t)T_TOK * 4;
constexpr size_t WS_WQS = WS_WINS + 16384;
constexpr size_t WS_WOS = WS_WQS + 8192;
constexpr size_t WS_MS = WS_WOS + 4096;
constexpr size_t WS_ACT = WS_VT + (size_t)16384 * 1024 * 2;
constexpr size_t WS_PROJ = WS_ACT + (size_t)T_TOK * 1024 * 2;
constexpr size_t WS_QPEER = WS_PROJ;
constexpr size_t WS_SELE = WS_PROJ + (size_t)T_TOK * 2048 * 2;
constexpr size_t WS_SELG = WS_SELE + (size_t)T_TOK * 128 * 4;
constexpr size_t WS_HQ = WS_SELG + (size_t)T_TOK * 128 * 4;
constexpr size_t WS_HS = WS_HQ + (size_t)T_TOK * 1024;
constexpr size_t WS_END = WS_PROJ + (size_t)T_TOK * NPROJ * 2;
constexpr size_t DN_REC = 73728;
constexpr size_t WS_DN = WS_END;
constexpr size_t WS_X1B = WS_DN;
constexpr size_t WS_MQ = WS_DN + (size_t)T_TOK * 1024 * 2;
constexpr size_t WS_GLS = WS_DN + 2048 * DN_REC;
constexpr size_t WS_END2 = WS_GLS + 8192;
constexpr size_t WS_BAR = WS_END2;
constexpr size_t WS_XB = WS_BAR + 16 * 256;
constexpr size_t WS_END3 = WS_XB + 3456 * 4;
constexpr size_t WS_PC = WS_END3;
constexpr size_t WS_END4 = WS_PC + 128 * 4 * 64 + 4096;
constexpr size_t VT_OFF = (size_t)T_TOK * 512 * 4;
constexpr size_t H1_OFF = (size_t)T_TOK * 512 * 2;
constexpr size_t KF_OFF = VT_OFF + (size_t)T_TOK * 512 * 2;

struct Args { const float* in[19]; float* out; unsigned char* ws; int ph_lo, ph_hi; };

template <int CTRL> __device__ __forceinline__ float dpp_(float x) {
    return __builtin_bit_cast(float, __builtin_amdgcn_update_dpp(0, __builtin_bit_cast(int, x), CTRL, 0xF, 0xF, true));
}
__device__ __forceinline__ float wave_sum(float v) {
    v += dpp_<0xB1>(v); v += dpp_<0x4E>(v); v += dpp_<0x141>(v); v += dpp_<0x140>(v);
    v += __shfl_xor(v, 16); v += __shfl_xor(v, 32);
    return v;
}
__device__ __forceinline__ float wave_max(float v) {
    v = fmaxf(v, dpp_<0xB1>(v)); v = fmaxf(v, dpp_<0x4E>(v)); v = fmaxf(v, dpp_<0x141>(v)); v = fmaxf(v, dpp_<0x140>(v));
    v = fmaxf(v, __shfl_xor(v, 16)); v = fmaxf(v, __shfl_xor(v, 32));
    return v;
}
__device__ __forceinline__ unsigned pk2(float lo, float hi) {
    typedef __bf16 bf2v_t __attribute__((ext_vector_type(2)));
    bf2v_t v; v[0] = (__bf16)lo; v[1] = (__bf16)hi; return __builtin_bit_cast(unsigned, v);
}
__device__ __forceinline__ unsigned f2bf(float f) { return pk2(f, 0.f) & 0xffffu; }
__device__ __forceinline__ float bf_lo(unsigned w) { return __uint_as_float(w << 16); }
__device__ __forceinline__ float bf_hi(unsigned w) { return __uint_as_float(w & 0xffff0000u); }
__device__ __forceinline__ float dot2(unsigned a, unsigned b, float acc) {
    return __builtin_amdgcn_fdot2_f32_bf16(__builtin_bit_cast(bf16x2, a), __builtin_bit_cast(bf16x2, b), acc, false);
}
__device__ __forceinline__ float siluf(float x) { return x * __builtin_amdgcn_rcpf(1.0f + __expf(-x)); }
template <int CTRL> __device__ __forceinline__ float dppf(float x) {
    return __builtin_bit_cast(float, __builtin_amdgcn_update_dpp(0, __builtin_bit_cast(int, x), CTRL, 0xF, 0xF, true));
}
#define LDS_WAIT() asm volatile("s_waitcnt lgkmcnt(0)" ::: "memory")

namespace pg8 {
typedef int i32x4 __attribute__((ext_vector_type(4)));
constexpr int BM = 256, BK = 64, HALF = 128, HTB = HALF * BK * 2, STAGE_BYTES = 8 * HTB, NXCD = 8, WGM = 4;
__device__ __forceinline__ int lds_byte(int r, int c) { const int st = (r >> 4) * 2 + (c >> 5), rr = r & 15, cc = c & 31, ob = rr * 64 + cc * 2; return st * 1024 + (ob ^ (((ob >> 9) & 1) << 5)); }
__device__ __forceinline__ void stage_rc(int b, int& R, int& C) { const int st = b / 1024, sb = b % 1024, swz = sb ^ (((sb >> 9) & 1) << 5); R = (st >> 1) * 16 + swz / 64; C = (st & 1) * 32 + (swz % 64) / 2; }
__device__ __forceinline__ int perm32(int rho) { const int n = rho >> 4, i = rho & 15; return 8 * (i >> 2) + 4 * n + (i & 3); }
struct Unit { int pm, pn; };
struct Gemm { const bf16_t* A; const bf16_t* Bt; int M, N, K; };
struct StaticOrder {
    int nM, nN, nwg, G, c; bool pair; int zmode;
    __device__ void init(int M, int N, int G_, int c_, bool pair_ = false, int zmode_ = 0) { nM = M / BM; nN = N / BM; nwg = nM * nN; G = G_; c = c_; pair = pair_; zmode = zmode_; }
    __device__ bool next(int i, Unit& u) const {
        if (zmode == 2) {
            int tau; if (i == 0) tau = c; else if (i == 1 && c < 64) tau = 192 + c; else return false;
            u.pm = tau >> 1; u.pn = 6 + (tau & 1); return true;
        }
        if (pair && zmode == 1) {
            if (i >= 6) return false;
            u.pm = c >> 1; u.pn = (c & 1) ? 8 + i : i; return true;
        }
        if (pair) {
            if (i >= nN / 2) return false;
            u.pm = c >> 1; u.pn = (c & 1) * (nN / 2) + i; return true;
        }
        const long L = (long)i * G + c; if (L >= nwg) return false;
        int wgid = (int)L; { const int q = nwg / NXCD, r = nwg % NXCD, xcd = wgid % NXCD, off = wgid / NXCD; wgid = (xcd < r ? xcd * (q + 1) : r * (q + 1) + (xcd - r) * q) + off; }
        const int nig = WGM * nN, gid = wgid / nig, fm = gid * WGM, gsz = (nM - fm) < WGM ? (nM - fm) : WGM;
        u.pm = fm + ((wgid % nig) % gsz); u.pn = (wgid % nig) / gsz; return true;
    }
};
__device__ __forceinline__ unsigned cvt_pk_bf16(float lo, float hi) { unsigned r; asm volatile("v_cvt_pk_bf16_f32 %0, %1, %2" : "=v"(r) : "v"(lo), "v"(hi)); return r; }

struct EpiBf16 {
    static constexpr bool PERM = true;
    bf16_t* O; int ldc;
    __device__ __forceinline__ void operator()(const f32x4 (&acc)[2][2][4][2], const Unit& u, int wr, int wc, int fr, int fq) const {
        const int row0 = u.pm * BM + wr * 64 + fr; const int col0 = u.pn * BM + wc * 32 + 8 * fq;
#pragma unroll
        for (int ai = 0; ai < 2; ++ai)
#pragma unroll
            for (int m = 0; m < 4; ++m) { bf16_t* rowp = O + (size_t)(row0 + ai * HALF + m * 16) * ldc + col0;
#pragma unroll
                for (int bj = 0; bj < 2; ++bj) { const f32x4 v0 = acc[ai][bj][m][0], v1 = acc[ai][bj][m][1];
                    u32x4 w; w.x = cvt_pk_bf16(v0[0], v0[1]); w.y = cvt_pk_bf16(v0[2], v0[3]); w.z = cvt_pk_bf16(v1[0], v1[1]); w.w = cvt_pk_bf16(v1[2], v1[3]);
                    *(u32x4*)(rowp + bj * HALF) = w; } }
    }
};
struct EpiBf16S {
    static constexpr bool PERM = true;
    bf16_t* O; int ldc; const float* ascale; const float* bscale;
    __device__ __forceinline__ void operator()(const i32x4 (&acc)[2][2][4][2], const Unit& u, int wr, int wc, int fr, int fq) const {
        const int row0 = u.pm * BM + wr * 64 + fr; const int col0 = u.pn * BM + wc * 32 + 8 * fq;
        f32x4 bs[2][2];
#pragma unroll
        for (int bj = 0; bj < 2; ++bj) { bs[bj][0] = *(const f32x4*)(bscale + col0 + bj * HALF); bs[bj][1] = *(const f32x4*)(bscale + col0 + bj * HALF + 4); }
#pragma unroll
        for (int ai = 0; ai < 2; ++ai)
#pragma unroll
            for (int m = 0; m < 4; ++m) { const int row = row0 + ai * HALF + m * 16; const float as = ascale[row]; bf16_t* rowp = O + (size_t)row * ldc + col0;
#pragma unroll
                for (int bj = 0; bj < 2; ++bj) { const i32x4 a0 = acc[ai][bj][m][0], a1 = acc[ai][bj][m][1];
                    const f32x4 v0 = (f32x4){(float)a0[0], (float)a0[1], (float)a0[2], (float)a0[3]} * bs[bj][0] * as;
                    const f32x4 v1 = (f32x4){(float)a1[0], (float)a1[1], (float)a1[2], (float)a1[3]} * bs[bj][1] * as;
                    u32x4 w; w.x = cvt_pk_bf16(v0[0], v0[1]); w.y = cvt_pk_bf16(v0[2], v0[3]); w.z = cvt_pk_bf16(v1[0], v1[1]); w.w = cvt_pk_bf16(v1[2], v1[3]);
                    *(u32x4*)(rowp + bj * HALF) = w; } }
    }
};
struct EpiResidS {
    static constexpr bool PERM = false;
    const float* x; const float* mod; bf16_t* out; const float* ascale; const float* bscale;
    __device__ __forceinline__ void operator()(const i32x4 (&acc)[2][2][4][2], const Unit& u, int wr, int wc, int fr, int fq) const {
        const int row0 = u.pm * BM + wr * 64 + fr, col0 = u.pn * BM + wc * 32 + 4 * fq;
        const int b = (u.pm * BM) >> 12;
        f32x4 gv[2][2];
#pragma unroll
        for (int bj = 0; bj < 2; ++bj)
#pragma unroll
            for (int n = 0; n < 2; ++n) gv[bj][n] = *(const f32x4*)(mod + (size_t)b * NMODC + 2048 + col0 + bj * HALF + n * 16) * *(const f32x4*)(bscale + col0 + bj * HALF + n * 16);
#pragma unroll
        for (int ai = 0; ai < 2; ++ai) {
            f32x4 xv[4][2][2]; float as[4];
#pragma unroll
            for (int m = 0; m < 4; ++m) { const int row = row0 + ai * HALF + m * 16; const size_t off = (size_t)row * DM + col0; as[m] = ascale[row];
#pragma unroll
                for (int bj = 0; bj < 2; ++bj)
#pragma unroll
                    for (int n = 0; n < 2; ++n) xv[m][bj][n] = *(const f32x4*)(x + off + bj * HALF + n * 16); }
            __builtin_amdgcn_sched_barrier(0);
#pragma unroll
            for (int m = 0; m < 4; ++m) { const int row = row0 + ai * HALF + m * 16; const size_t off = (size_t)row * DM + col0;
#pragma unroll
                for (int bj = 0; bj < 2; ++bj)
#pragma unroll
                    for (int n = 0; n < 2; ++n) { const i32x4 ai4 = acc[ai][bj][m][n];
                        const f32x4 r = xv[m][bj][n] + gv[bj][n] * ((f32x4){(float)ai4[0], (float)ai4[1], (float)ai4[2], (float)ai4[3]} * as[m]);
                        u32x2 w; w.x = cvt_pk_bf16(r[0], r[1]); w.y = cvt_pk_bf16(r[2], r[3]);
                        *(u32x2*)(out + off + bj * HALF + n * 16) = w; } }
        }
    }
};
struct EpiResid {
    static constexpr bool PERM = false;
    const float* x; const float* mod; bf16_t* out;
    __device__ __forceinline__ void operator()(const f32x4 (&acc)[2][2][4][2], const Unit& u, int wr, int wc, int fr, int fq) const {
        const int row0 = u.pm * BM + wr * 64 + fr, col0 = u.pn * BM + wc * 32 + 4 * fq;
        const int b = (u.pm * BM) >> 12;
        f32x4 gv[2][2];
#pragma unroll
        for (int bj = 0; bj < 2; ++bj)
#pragma unroll
            for (int n = 0; n < 2; ++n) gv[bj][n] = *(const f32x4*)(mod + (size_t)b * NMODC + 2048 + col0 + bj * HALF + n * 16);
#pragma unroll
        for (int ai = 0; ai < 2; ++ai)
#pragma unroll
            for (int m = 0; m < 4; ++m) { const size_t off = (size_t)(row0 + ai * HALF + m * 16) * DM + col0;
#pragma unroll
                for (int bj = 0; bj < 2; ++bj)
#pragma unroll
                    for (int n = 0; n < 2; ++n) { const f32x4 xv = *(const f32x4*)(x + off + bj * HALF + n * 16);
                        const f32x4 r = xv + gv[bj][n] * acc[ai][bj][m][n];
                        u32x2 w; w.x = cvt_pk_bf16(r[0], r[1]); w.y = cvt_pk_bf16(r[2], r[3]);
                        *(u32x2*)(out + off + bj * HALF + n * 16) = w; } }
    }
};

__device__ __forceinline__ f32x4 mma16(bf16x8 a, bf16x8 b, f32x4 c) { return __builtin_amdgcn_mfma_f32_16x16x32_bf16(a, b, c, 0, 0, 0); }
__device__ __forceinline__ i32x4 mma16(bf16x8 a, bf16x8 b, i32x4 c) { return __builtin_amdgcn_mfma_i32_16x16x64_i8(__builtin_bit_cast(i32x4, a), __builtin_bit_cast(i32x4, b), c, 0, 0, 0); }
template <class Epi, bool I8 = false>
__device__ __forceinline__ void gemm_phase(LAS unsigned char* lds, const Gemm g, const StaticOrder& S, const Epi& E) {
    typedef typename std::conditional<I8, i32x4, f32x4>::type acc_t;
    const int tid = threadIdx.x, wid = __builtin_amdgcn_readfirstlane(tid >> 6), lane = tid & 63, wr = wid >> 2, wc = wid & 3, fr = lane & 15, fq = lane >> 4;
    const int K = g.K, nt = K / BK;
    unsigned voffA[2], voffB[2];
#pragma unroll
    for (int i = 0; i < 2; ++i) { int R, C; stage_rc(tid * 16 + i * 8192, R, C); const int Rb = Epi::PERM ? ((R & ~31) + perm32(R & 31)) : R;
        voffA[i] = (unsigned)(R * K + C) * 2u; voffB[i] = (unsigned)(Rb * K + C) * 2u; }
    const size_t kstep = (size_t)(BK * 2);
    const size_t hstep = (size_t)HALF * K * 2;
    const size_t tstep = 2 * hstep;
    const unsigned ldsw = (unsigned)wid * 1024u;
    const int aoff = lds_byte(wr * 64 + fr, fq * 8), boff = lds_byte(wc * 32 + fr, fq * 8);
#define PG8_SA(b, h) (((b) * 2 + (h)) * HTB)
#define PG8_SB(b, h) ((4 + (b) * 2 + (h)) * HTB)
#define PG8_STAGE(bufoff, gbase, voff) do { _Pragma("unroll") for (int _i = 0; _i < 2; ++_i) \
        __builtin_amdgcn_global_load_lds((const unsigned*)((const char*)(gbase) + (voff)[_i]), (LAS unsigned*)(lds + (bufoff) + ldsw + _i * 8192), 16, 0, 0); } while (0)
#define PG8_LDA(dst, b, h) do { _Pragma("unroll") for (int m = 0; m < 4; ++m) _Pragma("unroll") for (int k = 0; k < 2; ++k) dst[m][k] = *(const LAS bf16x8*)(lds + PG8_SA(b, h) + aoff + m * 2048 + k * 1024); } while (0)
#define PG8_LDB(dst, b, h) do { _Pragma("unroll") for (int n = 0; n < 2; ++n) _Pragma("unroll") for (int k = 0; k < 2; ++k) dst[n][k] = *(const LAS bf16x8*)(lds + PG8_SB(b, h) + boff + n * 2048 + k * 1024); } while (0)
#define PG8_MMA(ai, bj, At, Bt) do { __builtin_amdgcn_s_setprio(1); _Pragma("unroll") for (int m = 0; m < 4; ++m) _Pragma("unroll") for (int n = 0; n < 2; ++n) _Pragma("unroll") for (int k = 0; k < 2; ++k) \
        acc[ai][bj][m][n] = mma16(Bt[n][k], At[m][k], acc[ai][bj][m][n]); __builtin_amdgcn_s_setprio(0); } while (0)
#define PG8_WAIT_V(n) asm volatile("s_waitcnt vmcnt(" #n ")" ::: "memory")
#define PG8_WAIT_L(n) asm volatile("s_waitcnt lgkmcnt(" #n ")" ::: "memory")
#define PG8_BAR __builtin_amdgcn_s_barrier()
#define PG8_SCHED __builtin_amdgcn_sched_barrier(0)
    Unit cur, nxt; int ui = 0;
    if (!S.next(0, cur)) return;
    acc_t acc[2][2][4][2];
#pragma unroll
    for (int a = 0; a < 2; ++a)
#pragma unroll
        for (int b = 0; b < 2; ++b)
#pragma unroll
            for (int m = 0; m < 4; ++m)
#pragma unroll
                for (int n = 0; n < 2; ++n) acc[a][b][m][n] = (acc_t){0, 0, 0, 0};
    bf16x8 At[4][2], B0[2][2], B1[2][2];
    const char* cA = (const char*)g.A + (size_t)cur.pm * tstep; const char* cB = (const char*)g.Bt + (size_t)cur.pn * tstep;
    PG8_STAGE(PG8_SB(0, 0), cB, voffB); PG8_STAGE(PG8_SA(0, 0), cA, voffA); PG8_STAGE(PG8_SB(0, 1), cB + hstep, voffB); PG8_STAGE(PG8_SA(0, 1), cA + hstep, voffA);
    if (wr == 1) PG8_BAR;
    PG8_WAIT_V(4); PG8_BAR;
    PG8_STAGE(PG8_SB(1, 0), cB + kstep, voffB); PG8_STAGE(PG8_SA(1, 0), cA + kstep, voffA); PG8_STAGE(PG8_SB(1, 1), cB + hstep + kstep, voffB);
    PG8_WAIT_V(6); PG8_BAR;
    for (;;) {
        const bool has_next = S.next(ui + 1, nxt);
        const char* nA = has_next ? (const char*)g.A + (size_t)nxt.pm * tstep : cA; const char* nB = has_next ? (const char*)g.Bt + (size_t)nxt.pn * tstep : cB;
        for (int t = 0; t < nt; t += 2) {
            const bool last = (t == nt - 2);
            const char* a1 = cA + (size_t)(t + 1) * kstep;
            const char* a2 = last ? nA : cA + (size_t)(t + 2) * kstep; const char* b2 = last ? nB : cB + (size_t)(t + 2) * kstep;
            const char* a3 = a2 + kstep; const char* b3 = b2 + kstep;
            PG8_LDB(B0, 0, 0); PG8_SCHED; PG8_LDA(At, 0, 0); PG8_STAGE(PG8_SA(1, 1), a1 + hstep, voffA);
            PG8_WAIT_L(8); PG8_BAR; PG8_WAIT_L(0); PG8_MMA(0, 0, At, B0); PG8_BAR; PG8_SCHED;
            PG8_LDB(B1, 0, 1); PG8_STAGE(PG8_SB(0, 0), b2, voffB);
            PG8_BAR; PG8_WAIT_L(0); PG8_MMA(0, 1, At, B1); PG8_BAR;
            PG8_LDA(At, 0, 1); PG8_STAGE(PG8_SA(0, 0), a2, voffA);
            PG8_BAR; PG8_WAIT_L(0); PG8_MMA(1, 0, At, B0); PG8_BAR; PG8_SCHED;
            PG8_STAGE(PG8_SB(0, 1), b2 + hstep, voffB);
            PG8_WAIT_V(6); PG8_BAR; PG8_MMA(1, 1, At, B1); PG8_BAR;
            PG8_LDB(B0, 1, 0); PG8_SCHED; PG8_LDA(At, 1, 0); PG8_STAGE(PG8_SA(0, 1), a2 + hstep, voffA);
            PG8_WAIT_L(8); PG8_BAR; PG8_WAIT_L(0); PG8_MMA(0, 0, At, B0); PG8_BAR; PG8_SCHED;
            PG8_LDB(B1, 1, 1); PG8_STAGE(PG8_SB(1, 0), b3, voffB);
            PG8_BAR; PG8_WAIT_L(0); PG8_MMA(0, 1, At, B1); PG8_BAR;
            PG8_LDA(At, 1, 1); PG8_STAGE(PG8_SA(1, 0), a3, voffA);
            PG8_BAR; PG8_WAIT_L(0); PG8_MMA(1, 0, At, B0); PG8_BAR; PG8_SCHED;
            PG8_STAGE(PG8_SB(1, 1), b3 + hstep, voffB);
            PG8_WAIT_V(6); PG8_BAR; PG8_MMA(1, 1, At, B1); PG8_BAR;
        }
        E(acc, cur, wr, wc, fr, fq);
        if (!has_next) break;
#pragma unroll
        for (int a = 0; a < 2; ++a)
#pragma unroll
            for (int b = 0; b < 2; ++b)
#pragma unroll
                for (int m = 0; m < 4; ++m)
#pragma unroll
                    for (int n = 0; n < 2; ++n) acc[a][b][m][n] = (acc_t){0, 0, 0, 0};
        cur = nxt; cA = nA; cB = nB; ++ui;
    }
    PG8_WAIT_V(0);
    if (wr == 0) PG8_BAR;
    PG8_BAR;
#undef PG8_SA
#undef PG8_SB
#undef PG8_STAGE
#undef PG8_LDA
#undef PG8_LDB
#undef PG8_MMA
#undef PG8_WAIT_V
#undef PG8_WAIT_L
#undef PG8_BAR
#undef PG8_SCHED
}
}

__device__ __forceinline__ void transpose_item(const float* W, int ldw, int K, bf16_t* WT, LAS float* scr, int kb, int src_col0, int dst_row0, int lane) {
    const int k0 = 64 * kb;
#pragma unroll 8
    for (int i = 0; i < 32; ++i) { const int kk = 2 * i + (lane >> 5); scr[kk * 33 + (lane & 31)] = W[(size_t)(k0 + kk) * ldw + src_col0 + (lane & 31)]; }
    LDS_WAIT();
    const int c = lane & 7;
#pragma unroll
    for (int j = 0; j < 4; ++j) { const int n = (lane >> 3) + 8 * j; const LAS float* s = scr + (8 * c) * 33 + n;
        u32x4 o; o.x = pk2(s[0 * 33], s[1 * 33]); o.y = pk2(s[2 * 33], s[3 * 33]); o.z = pk2(s[4 * 33], s[5 * 33]); o.w = pk2(s[6 * 33], s[7 * 33]);
        *(u32x4*)(WT + (size_t)(dst_row0 + n) * K + k0 + 8 * c) = o; }
    LDS_WAIT();
}

__device__ __forceinline__ void transpose_item_q(const float* W, int ldw, int K, signed char* WT, LAS float* scr, int kb, int src_col0, int dst_row0, int lane, const float* scale) {
    const int k0 = 64 * kb;
#pragma unroll 8
    for (int i = 0; i < 32; ++i) { const int kk = 2 * i + (lane >> 5); scr[kk * 33 + (lane & 31)] = W[(size_t)(k0 + kk) * ldw + src_col0 + (lane & 31)]; }
    LDS_WAIT();
    const int c = lane & 7;
#pragma unroll
    for (int j = 0; j < 4; ++j) { const int n = (lane >> 3) + 8 * j; const LAS float* s = scr + (8 * c) * 33 + n;
        const float sc = scale[dst_row0 + n], inv = sc > 0.f ? 1.0f / sc : 0.f;
        u32x2 o;
        o.x = ((unsigned)(int)rintf(s[0 * 33] * inv) & 255u) | (((unsigned)(int)rintf(s[1 * 33] * inv) & 255u) << 8) | (((unsigned)(int)rintf(s[2 * 33] * inv) & 255u) << 16) | (((unsigned)(int)rintf(s[3 * 33] * inv) & 255u) << 24);
        o.y = ((unsigned)(int)rintf(s[4 * 33] * inv) & 255u) | (((unsigned)(int)rintf(s[5 * 33] * inv) & 255u) << 8) | (((unsigned)(int)rintf(s[6 * 33] * inv) & 255u) << 16) | (((unsigned)(int)rintf(s[7 * 33] * inv) & 255u) << 24);
        *(u32x2*)(WT + (size_t)(dst_row0 + n) * K + k0 + 8 * c) = o; }
    LDS_WAIT();
}

__device__ __forceinline__ void phase0(const Args& a, LAS unsigned char* lds) {
    const int tid = threadIdx.x, lane = tid & 63, wave = tid >> 6, G = gridDim.x;
    unsigned char* ws = a.ws;
    if (blockIdx.x == 0 && tid < 64) ((unsigned*)(ws + WS_BAR))[16 * tid] = 0u;
    if (blockIdx.x == 2 % gridDim.x) { for (int i = tid; i < 128 * 4 * 16; i += NTHR) ((unsigned*)(ws + WS_PC))[i] = 0u; if (tid == 0) { ((unsigned*)(ws + WS_PC))[128 * 64 + 512] = 0u; ((unsigned*)(ws + WS_PC))[128 * 64 + 576] = 0u; } }
    if (blockIdx.x == 1) for (int i = tid; i < 3456; i += NTHR) ((unsigned*)(ws + WS_XB))[i] = 0u;
    {
        const float* c = a.in[1]; const float* w_ada = a.in[2]; const float* b_ada = a.in[3]; float* mod = (float*)(ws + WS_MOD);
        LAS float* sc = (LAS float*)lds;
        LAS float* red = (LAS float*)(lds + 32768);
        if ((int)blockIdx.x < 96) {
            for (int i = tid; i < 8192; i += NTHR) sc[i] = siluf(c[i]);
            __syncthreads();
            for (int item = blockIdx.x; item < 96; item += G) {
                const int n = item * 64 + lane; float acc[8];
#pragma unroll
                for (int b = 0; b < 8; ++b) acc[b] = 0.f;
                for (int k4 = 0; k4 < 32; ++k4) {
                    const int k = wave * 128 + k4 * 4;
                    float wv[4];
#pragma unroll
                    for (int j = 0; j < 4; ++j) wv[j] = w_ada[(size_t)(k + j) * NMODC + n];
#pragma unroll
                    for (int b = 0; b < 8; ++b) { const f32x4 s = *(const LAS f32x4*)(sc + b * 1024 + k);
                        acc[b] += s[0] * wv[0] + s[1] * wv[1] + s[2] * wv[2] + s[3] * wv[3]; }
                }
#pragma unroll
                for (int b = 0; b < 8; ++b) red[(wave * 8 + b) * 64 + lane] = acc[b];
                __syncthreads();
                { const int b = tid >> 6; float s = 0.f;
#pragma unroll
                  for (int w = 0; w < 8; ++w) s += red[(w * 8 + b) * 64 + lane];
                  mod[b * NMODC + n] = s + b_ada[n]; }
                __syncthreads();
            }
        }
        __syncthreads();
    }
    if ((int)blockIdx.x >= 96) {
        LAS float* red = (LAS float*)lds;
        for (int cb = (int)blockIdx.x - 96; cb < 104; cb += G - 96) {
            const bool isq = cb >= 56 && cb < 88, iso = cb >= 88; const int n = (iso ? cb - 88 : (isq ? cb - 56 : cb)) * 64 + lane;
            const float* W = iso ? a.in[13] : (isq ? a.in[15] : a.in[5]); const int ldw = iso ? 1024 : (isq ? 2048 : LDW_IN); const int col = (isq || iso) ? n : n + (n >= 2048 ? 8 : 0);
            float m = 0.f;
            for (int k = wave * 128; k < wave * 128 + 128; ++k) m = fmaxf(m, fabsf(W[(size_t)k * ldw + col]));
            red[wave * 64 + lane] = m;
            __syncthreads();
            if (wave == 0) {
#pragma unroll
                for (int w = 1; w < 8; ++w) m = fmaxf(m, red[w * 64 + lane]);
                ((float*)(ws + (iso ? WS_WOS : (isq ? WS_WQS : WS_WINS))))[n] = m * (1.0f / 127.0f);
            }
            __syncthreads();
        }
    }
    {
        const size_t gt = (size_t)blockIdx.x * NTHR + tid, NGT = (size_t)G * NTHR;
        float* wsm = (float*)(ws + WS_WSM);
        for (size_t i = gt; i < 8 * 1024; i += NGT) { const int j = (int)(i >> 10), k = (int)(i & 1023); wsm[i] = a.in[5][(size_t)k * LDW_IN + 2048 + j]; }
    }
}
__device__ __forceinline__ void phase0b(const Args& a, LAS unsigned char* lds) {
    const int tid = threadIdx.x, lane = tid & 63, wave = tid >> 6, G = gridDim.x;
    unsigned char* ws = a.ws;
    {
        const int gw = blockIdx.x * NWAVE + wave, NGW = G * NWAVE;
        LAS float* scr = (LAS float*)(lds + wave * 8704);
        bf16_t* win_t = (bf16_t*)(ws + WS_WIN_T);
        constexpr int I_IN = 16 * (NPROJ / 32);
        for (int it = gw; it < I_IN; it += NGW) {
            const int kb = it / (NPROJ / 32), nb = it % (NPROJ / 32), n0 = nb * 32; if (INPROJ_I8) transpose_item_q(a.in[5], LDW_IN, 1024, (signed char*)win_t, scr, kb, n0 + (n0 >= 2048 ? 8 : 0), n0, lane, (const float*)(ws + WS_WINS));
            else transpose_item(a.in[5], LDW_IN, 1024, win_t, scr, kb, n0 + (n0 >= 2048 ? 8 : 0), n0, lane);
        }
    }
    {
        const size_t gt = (size_t)blockIdx.x * NTHR + tid, NGT = (size_t)G * NTHR;
        const float* sk = a.in[16]; unsigned* o = (unsigned*)(ws + WS_SUBK);
        for (size_t i = gt; i < 16 * 128 * 128 / 2; i += NGT) o[i] = pk2(sk[2 * i], sk[2 * i + 1]);
    }
}

__device__ __forceinline__ unsigned q8x4(float v0, float v1, float v2, float v3, float inv) {
    const float M = 12582912.0f;
    const unsigned t0 = __float_as_uint(fmaf(v0, inv, M)), t1 = __float_as_uint(fmaf(v1, inv, M)), t2 = __float_as_uint(fmaf(v2, inv, M)), t3 = __float_as_uint(fmaf(v3, inv, M));
    return __builtin_amdgcn_perm(t1, t0, 0x0c0c0400u) | __builtin_amdgcn_perm(t3, t2, 0x04000c0cu);
}
__device__ __forceinline__ void late_prep(const Args& a, LAS unsigned char* lds, int widx, int nw) {
    const int lane = threadIdx.x & 63, wave = threadIdx.x >> 6;
    unsigned char* ws = a.ws;
    {
        LAS float* scr = (LAS float*)(lds + wave * 8704);
        bf16_t* wout_t = (bf16_t*)(ws + WS_WOUT_T); bf16_t* wq_t = (bf16_t*)(ws + WS_WQ_T);
        constexpr int I_OUT = 16 * 32, I_Q = 16 * 64;
        for (int it = widx; it < I_OUT + I_Q; it += nw) {
            if (it < I_OUT) { const int kb = it / 32, nb = it % 32; transpose_item_q(a.in[13], 1024, 1024, (signed char*)wout_t, scr, kb, nb * 32, nb * 32, lane, (const float*)(ws + WS_WOS)); }
            else { const int r = it - I_OUT, kb = r / 64, nb = r % 64;
                if (QUERY_I8) transpose_item_q(a.in[15], 2048, 1024, (signed char*)wq_t, scr, kb, nb * 32, nb * 32, lane, (const float*)(ws + WS_WQS));
                else transpose_item(a.in[15], 2048, 1024, wq_t, scr, kb, nb * 32, nb * 32, lane); }
        }
    }
    {
        const int G = 0; (void)G;
        { const int gw = widx, NGW = nw;
          for (int row0 = gw; row0 < 2 * 16384; row0 += 4 * NGW) {
              f32x4 v[4][4];
#pragma unroll
              for (int q = 0; q < 4; ++q) { const int row = (row0 + q * NGW < 2 * 16384) ? row0 + q * NGW : row0;
                  const f32x4* src = (const f32x4*)((row >= 16384 ? a.in[18] : a.in[17]) + (size_t)(row & 16383) * 1024) + lane;
#pragma unroll
                  for (int j = 0; j < 4; ++j) v[q][j] = src[64 * j]; }
#pragma unroll
              for (int q = 0; q < 4; ++q) {
                  const int row = row0 + q * NGW;
                  if (row < 2 * 16384) {
                      const bool isv = row >= 16384; const int e = row & 16383;
                      float am = 0.f;
#pragma unroll
                      for (int j = 0; j < 4; ++j) am = fmaxf(am, fmaxf(fmaxf(fabsf(v[q][j][0]), fabsf(v[q][j][1])), fmaxf(fabsf(v[q][j][2]), fabsf(v[q][j][3]))));
                      am = wave_max(am);
                      const float inv = am > 0.f ? 127.0f / am : 0.f;
                      unsigned char* dst = ws + (isv ? WS_VT : WS_UT);
#pragma unroll
                      for (int j = 0; j < 4; ++j) {
                          const unsigned pk = q8x4(v[q][j][0], v[q][j][1], v[q][j][2], v[q][j][3], inv);
                          const int sl = 2 * j + (lane >> 5);
                          *(unsigned*)(dst + ((size_t)sl * 16384 + e) * 128 + ((4 * lane) & 127)) = pk;
                      }
                      if (lane == 0) ((float*)(ws + (isv ? WS_VS : WS_US)))[e] = am * (1.0f / 127.0f);
                  }
              }
          } }
    }
}

#ifndef NORM_PF_FIRST
#define NORM_PF_FIRST 1
#endif
template <bool FIRST>
__device__ __forceinline__ void phase_norm(const Args& a, const float* src, const float* gain, int shift_off, int scale_off, int vblock) {
    const bf16_t* srcb = (const bf16_t*)(a.ws + WS_X1B);
    constexpr int R = FIRST ? 2 : 4;
    const int wave = threadIdx.x >> 6;
    const int gw = vblock * NWAVE + wave, NGW = gridDim.x * NWAVE;
    const float* mod = (const float*)(a.ws + WS_MOD); const float* wsm = (const float*)(a.ws + WS_WSM);
    bf16_t* dst = (bf16_t*)(a.ws + WS_ACT); float* small = (float*)(a.ws + WS_SMALL);
    typedef typename std::conditional<FIRST, f32x4, u32x2>::type raw_t;
    constexpr bool PF = NORM_PF_FIRST || !FIRST;
    const int rpw = (((T_TOK + NGW - 1) / NGW) + 3) & ~3, row_lo = gw * rpw, row_hi = (row_lo + rpw < T_TOK) ? row_lo + rpw : T_TOK;
    raw_t nx[R][4];
    if constexpr (PF) {
        const int lane0 = threadIdx.x & 63, tk = row_lo < T_TOK ? row_lo : 0;
#pragma unroll
        for (int q = 0; q < R; ++q)
#pragma unroll
            for (int j = 0; j < 4; ++j) nx[q][j] = ((const raw_t*)((FIRST ? (const char*)src : (const char*)srcb) + (size_t)(tk + q) * DM * (FIRST ? 4 : 2)) + lane0)[64 * j];
    }
    f32x4 gs[4], sh[4]; int pb = -1;
    for (int tok0 = row_lo; tok0 < row_hi; tok0 += R) {
        int lane = threadIdx.x & 63; asm volatile("" : "+v"(lane));
        if ((tok0 >> 12) != pb) { pb = tok0 >> 12; const float* mrow = mod + (size_t)pb * NMODC;
#pragma unroll
            for (int j = 0; j < 4; ++j) { const int d = 4 * lane + 256 * j;
                const f32x4 g = *(const f32x4*)(gain + d), sc = *(const f32x4*)(mrow + scale_off + d); gs[j] = g * (1.0f + sc); sh[j] = *(const f32x4*)(mrow + shift_off + d); } }
        f32x4 v[R][4]; float rstd[R];
#pragma unroll
        for (int q = 0; q < R; ++q)
#pragma unroll
            for (int j = 0; j < 4; ++j) {
                if constexpr (!PF) nx[q][j] = ((const raw_t*)((FIRST ? (const char*)src : (const char*)srcb) + (size_t)(tok0 + q) * DM * (FIRST ? 4 : 2)) + lane)[64 * j];
                if constexpr (FIRST) v[q][j] = nx[q][j];
                else { const u32x2 w = nx[q][j]; v[q][j] = (f32x4){bf_lo(w.x), bf_hi(w.x), bf_lo(w.y), bf_hi(w.y)}; }
            }
        if constexpr (PF) {
            const int tn = tok0 + R < row_hi ? tok0 + R : tok0;
#pragma unroll
            for (int q = 0; q < R; ++q)
#pragma unroll
                for (int j = 0; j < 4; ++j) nx[q][j] = ((const raw_t*)((FIRST ? (const char*)src : (const char*)srcb) + (size_t)(tn + q) * DM * (FIRST ? 4 : 2)) + lane)[64 * j];
        }
#pragma unroll
        for (int q = 0; q < R; ++q) { float ss = 0.f;
#pragma unroll
            for (int j = 0; j < 4; ++j) ss += (v[q][j][0] * v[q][j][0] + v[q][j][1] * v[q][j][1]) + (v[q][j][2] * v[q][j][2] + v[q][j][3] * v[q][j][3]);
            rstd[q] = ss; }
#pragma unroll
        for (int q = 0; q < R; ++q) rstd[q] = rsqrtf(wave_sum(rstd[q]) * (1.0f / DM) + EPS);
        float sa[R][8];
#pragma unroll
        for (int q = 0; q < R; ++q)
#pragma unroll
            for (int c = 0; c < 8; ++c) sa[q][c] = 0.f;
#pragma unroll
        for (int j = 0; j < 4; ++j) {
            const int d = 4 * lane + 256 * j;
#pragma unroll
            for (int q = 0; q < R; ++q) {
                v[q][j] = v[q][j] * rstd[q] * gs[j] + sh[j];
                if ((FIRST && !INPROJ_I8) || (!FIRST && !QUERY_I8)) { u32x2 o; o.x = pk2(v[q][j][0], v[q][j][1]); o.y = pk2(v[q][j][2], v[q][j][3]); *(u32x2*)(dst + (size_t)(tok0 + q) * DM + d) = o; }
            }
            if (FIRST) {
#pragma unroll
                for (int c = 0; c < 8; ++c) { const f32x4 w = *(const f32x4*)(wsm + c * 1024 + d);
#pragma unroll
                    for (int q = 0; q < R; ++q) sa[q][c] += (v[q][j][0] * w[0] + v[q][j][1] * w[1]) + (v[q][j][2] * w[2] + v[q][j][3] * w[3]); }
            }
            __builtin_amdgcn_sched_barrier(0);
        }
        if (!FIRST || INPROJ_I8) {
#pragma unroll
            for (int q = 0; q < R; ++q) {
                float am = 0.f;
#pragma unroll
                for (int j = 0; j < 4; ++j) am = fmaxf(am, fmaxf(fmaxf(fabsf(v[q][j][0]), fabsf(v[q][j][1])), fmaxf(fabsf(v[q][j][2]), fabsf(v[q][j][3]))));
                am = wave_max(am);
                const float inv = am > 0.f ? 127.0f / am : 0.f;
                unsigned* hq = (unsigned*)(FIRST ? (unsigned char*)a.out + H1_OFF : a.ws + WS_HQ) + (size_t)(tok0 + q) * 256;
#pragma unroll
                for (int j = 0; j < 4; ++j) hq[lane + 64 * j] = q8x4(v[q][j][0], v[q][j][1], v[q][j][2], v[q][j][3], inv);
                if (lane == 0) ((float*)(a.ws + (FIRST ? WS_H1S : WS_HS)))[tok0 + q] = am * (1.0f / 127.0f);
            }
        }
        if (FIRST) {
#pragma unroll
            for (int q = 0; q < R; ++q) {
                float ov = 0.f;
#pragma unroll
                for (int c = 0; c < 8; ++c) { const float s = wave_sum(sa[q][c]); if (lane == c) ov = s; }
                if (lane < 8) small[(size_t)(tok0 + q) * 8 + lane] = ov;
            }
        }
    }
}

typedef float f32x16 __attribute__((ext_vector_type(16)));
__device__ __forceinline__ unsigned cvt2(float lo, float hi) {
    typedef __bf16 bf2_t __attribute__((ext_vector_type(2)));
    bf2_t v; v[0] = (__bf16)lo; v[1] = (__bf16)hi; return __builtin_bit_cast(unsigned, v);
}
__device__ __forceinline__ int crow(int reg, int h) { return (reg & 3) + 8 * (reg >> 2) + 4 * h; }
constexpr int R_W = 0, R_QD = 16384, R_KDT = 32768, R_ATT = 49152, R_U = 57344;

template <int I> __device__ __forceinline__ void tsolve_load(f32x4 (&l)[8], const LAS float* Lb) {
#pragma unroll
    for (int j4 = 0; j4 < (I + 3) / 4; ++j4) l[j4] = *(const LAS f32x4*)(Lb + I * 68 + 4 * j4);
}
template <int I> __device__ __forceinline__ void tsolve_row(float (&x)[32], const LAS float* Lb, int c, f32x4 (&cur)[8], f32x4 (&nxt)[8]) {
    if constexpr (I + 1 < 32) { tsolve_load<I + 1>(nxt, Lb); __builtin_amdgcn_sched_barrier(0); }
    float a0 = 0.f, a1 = 0.f, a2 = 0.f, a3 = 0.f;
#pragma unroll
    for (int j4 = 0; j4 < (I + 3) / 4; ++j4) {
        const f32x4 l = cur[j4];
        if (4 * j4 + 0 < I) a0 += l[0] * x[4 * j4 + 0];
        if (4 * j4 + 1 < I) a1 += l[1] * x[4 * j4 + 1];
        if (4 * j4 + 2 < I) a2 += l[2] * x[4 * j4 + 2];
        if (4 * j4 + 3 < I) a3 += l[3] * x[4 * j4 + 3];
    }
    x[I] = (I == c ? 1.0f : 0.0f) - ((a0 + a1) + (a2 + a3));
}
template <int... Is> __device__ __forceinline__ void tsolve_all(float (&x)[32], const LAS float* Lb, int c, std::integer_sequence<int, Is...>) {
    f32x4 la[8], lb[8];
    tsolve_load<0>(la, Lb);
    ((Is % 2 == 0 ? tsolve_row<Is>(x, Lb, c, la, lb) : tsolve_row<Is>(x, Lb, c, lb, la)), ...);
}
__device__ __forceinline__ bf16x8 lda_split(const LAS unsigned char* p) {
    const u32x2 lo = *(const LAS u32x2*)p, hi = *(const LAS u32x2*)(p + 16);
    u32x4 v; v.x = lo.x; v.y = lo.y; v.z = hi.x; v.w = hi.y; return __builtin_bit_cast(bf16x8, v);
}
__device__ __forceinline__ bf16x8 pack8(const f32x16& x, int s) {
    u32x4 v; v.x = cvt2(x[8 * s], x[8 * s + 1]); v.y = cvt2(x[8 * s + 2], x[8 * s + 3]); v.z = cvt2(x[8 * s + 4], x[8 * s + 5]); v.w = cvt2(x[8 * s + 6], x[8 * s + 7]);
    return __builtin_bit_cast(bf16x8, v);
}

#ifndef DNP_DUP
#define DNP_DUP 0
#endif
#define DNP_REP(k) _Pragma("nounroll") for (int drep_ = 0; drep_ < 1 + ((DNP_DUP >> (k)) & 1); ++drep_)
constexpr int DNL_KBT = 98304, DNL_VBT = 116736, DNL_T = 135168, DNL_T11T = 144384;
__device__ __forceinline__ int dn_chunk(int k, int vb, bool pairm) {
    if (pairm) { const int p = vb >> 1, hf = vb & 1; return k < 8 ? ((((p >> 4) << 8) | ((2 * hf + (k >> 2)) << 6)) | (4 * (p & 15) + (k & 3))) : 4096; }
    const int c = vb + k * (int)gridDim.x; return c < 2048 ? c : 4096;
}
__device__ __forceinline__ void dn_prep(const Args& a, LAS unsigned char* lds, int vb, bool pairm) {
    const bf16_t* proj = (const bf16_t*)(a.ws + WS_PROJ); const float* small = (const float*)(a.ws + WS_SMALL);
    const float* convw = a.in[6];
    LAS float* qs = (LAS float*)lds;
    LAS float* ks = (LAS float*)(lds + 32768);
    LAS float* vs = (LAS float*)(lds + 65536);
    LAS unsigned char* q16 = lds + 98304;
    LAS unsigned char* k16 = lds + 115712;
    LAS unsigned char* kb16 = lds + 133120;
    LAS float* sbeta = (LAS float*)(lds + 150528);
    LAS float* sG = sbeta + 64;
    LAS float* seG = sG + 64;
    LAS float* sbg = seG + 64;
    LAS float* Lm = (LAS float*)lds;
    float* gls = (float*)(a.ws + WS_GLS);
    u32x2 rawn[19];
    float bln = 0.f, dln = 0.f;
    f32x4 w[4]; int whd = -1;
    {
        const int tid0 = threadIdx.x, ci0 = dn_chunk(0, vb, pairm);
        if (tid0 < 384 && ci0 < 2048) {
            const int cgp = tid0 % 96, seg = tid0 / 96, which = cgp >> 5, c4 = (cgp & 31) * 4, col = which * 512 + ((ci0 >> 6) & 3) * 128 + c4;
#pragma unroll
            for (int r = 0; r < 19; ++r) { const int sp = (ci0 & 63) * 64 + 16 * seg - 3 + r;
                rawn[r] = *(const u32x2*)(proj + ((size_t)(ci0 >> 8) * SEQ + (sp < 0 ? 0 : sp)) * NPROJ + col); }
        }
        if (tid0 >= 448 && ci0 < 2048) { const size_t tk = (size_t)(ci0 >> 8) * SEQ + (ci0 & 63) * 64 + (tid0 - 448); bln = small[tk * 8 + ((ci0 >> 6) & 3)]; dln = small[tk * 8 + 4 + ((ci0 >> 6) & 3)]; }
#pragma unroll
        for (int j = 0; j < 4; ++j) w[j] = (f32x4){0.f, 0.f, 0.f, 0.f};
    }
    int kc = 0;
    for (int ci = dn_chunk(0, vb, pairm); ci < 2048; ci = dn_chunk(++kc, vb, pairm)) {
        int tid = threadIdx.x; asm volatile("" : "+v"(tid));
        const int lane = tid & 63, wave = tid >> 6;
        const int b = ci >> 8, hd = (ci >> 6) & 3, n = ci & 63, s0 = n * 64; const size_t tok0 = (size_t)b * SEQ + s0;
        unsigned char* rec = a.ws + WS_DN + (size_t)ci * DN_REC;
        if (hd != whd) { whd = hd;
            if (tid < 384) { const int cgp = tid % 96, which = cgp >> 5, c4 = (cgp & 31) * 4, col = which * 512 + hd * 128 + c4;
#pragma unroll
                for (int j = 0; j < 4; ++j) w[j] = *(const f32x4*)(convw + j * 1536 + col); } }
        const float bl = bln, dl = dln;
        DNP_REP(0) if (tid < 384) {
            const int cgp = tid % 96, seg = tid / 96, which = cgp >> 5, c4 = (cgp & 31) * 4;
            u32x2 raw[19];
#pragma unroll
            for (int r = 0; r < 19; ++r) {
                const int sp = s0 + 16 * seg - 3 + r;
                raw[r] = (sp >= 0) ? rawn[r] : (u32x2){0u, 0u};
            }
            LAS float* dstp = (which == 0 ? qs : (which == 1 ? ks : vs)) + (16 * seg) * 128 + c4;
#pragma unroll
            for (int i = 0; i < 16; ++i) {
                f32x4 y = (f32x4){0.f, 0.f, 0.f, 0.f};
#pragma unroll
                for (int j = 0; j < 4; ++j) { const u32x2 u = raw[i + j];
                    y[0] += w[j][0] * bf_lo(u.x); y[1] += w[j][1] * bf_hi(u.x); y[2] += w[j][2] * bf_lo(u.y); y[3] += w[j][3] * bf_hi(u.y); }
                f32x4 r; r[0] = siluf(y[0]); r[1] = siluf(y[1]); r[2] = siluf(y[2]); r[3] = siluf(y[3]);
                *(LAS f32x4*)(dstp + i * 128) = r;
            }
        }
        if (wave == 7) {
            const float Aexp = __expf(a.in[7][hd]), dtb = a.in[8][hd];
            const float dlb = dl + dtb;
            const float sp = fmaxf(dlb, 0.f) + log1pf(expf(-fabsf(dlb)));
            float Gc = -Aexp * sp;
#pragma unroll
            for (int o = 1; o < 64; o <<= 1) { const float t = __shfl_up(Gc, o); if (lane >= o) Gc += t; }
            const float bt = 1.0f / (1.0f + expf(-bl)), eg = expf(Gc);
            sbeta[lane] = bt; sG[lane] = Gc; seG[lane] = eg; sbg[lane] = bt * eg;
        }
        __syncthreads();
        {
            const int cn = dn_chunk(kc + 1, vb, pairm);
            if (tid < 384 && cn < 2048) {
                const int cgp = tid % 96, seg = tid / 96, which = cgp >> 5, c4 = (cgp & 31) * 4, col = which * 512 + ((cn >> 6) & 3) * 128 + c4;
#pragma unroll
                for (int r = 0; r < 19; ++r) { const int sp = (cn & 63) * 64 + 16 * seg - 3 + r;
                    rawn[r] = *(const u32x2*)(proj + ((size_t)(cn >> 8) * SEQ + (sp < 0 ? 0 : sp)) * NPROJ + col); }
            }
            if (tid >= 448 && cn < 2048) { const size_t tk = (size_t)(cn >> 8) * SEQ + (cn & 63) * 64 + (tid - 448); bln = small[tk * 8 + ((cn >> 6) & 3)]; dln = small[tk * 8 + 4 + ((cn >> 6) & 3)]; }
        }
        {
            const bool isk = wave >= 4;
            LAS float* pb = (isk ? ks : qs) + ((wave & 3) * 16) * 128 + 2 * lane;
#pragma unroll
            for (int r4 = 0; r4 < 4; ++r4) {
                f32x2 v[4]; float ss[4];
#pragma unroll
                for (int q = 0; q < 4; ++q) { v[q] = *(LAS f32x2*)(pb + (r4 * 4 + q) * 128); ss[q] = v[q][0] * v[q][0] + v[q][1] * v[q][1]; }
#pragma unroll
                for (int q = 0; q < 4; ++q) ss[q] = wave_sum(ss[q]);
#pragma unroll
                for (int q = 0; q < 4; ++q) { const float sc = rsqrtf(ss[q] + EPS) * (isk ? 1.0f : 0.08838834764831845f);
                    v[q][0] *= sc; v[q][1] *= sc; *(LAS f32x2*)(pb + (r4 * 4 + q) * 128) = v[q]; }
            }
        }
        __syncthreads();
        DNP_REP(1) for (int idx = tid; idx < 1024; idx += NTHR) {
            const int i = idx >> 4, d0 = (idx & 15) * 8; const float bt = sbeta[i], eg = seG[i];
            const f32x4 q0 = *(const LAS f32x4*)(qs + i * 128 + d0), q1 = *(const LAS f32x4*)(qs + i * 128 + d0 + 4);
            const f32x4 k0 = *(const LAS f32x4*)(ks + i * 128 + d0), k1 = *(const LAS f32x4*)(ks + i * 128 + d0 + 4);
            u32x4 o;
            o.x = cvt2(q0[0], q0[1]); o.y = cvt2(q0[2], q0[3]); o.z = cvt2(q1[0], q1[1]); o.w = cvt2(q1[2], q1[3]); *(LAS u32x4*)(q16 + i * 272 + d0 * 2) = o;
            o.x = cvt2(k0[0], k0[1]); o.y = cvt2(k0[2], k0[3]); o.z = cvt2(k1[0], k1[1]); o.w = cvt2(k1[2], k1[3]); *(LAS u32x4*)(k16 + i * 272 + d0 * 2) = o;
            o.x = cvt2(k0[0] * bt, k0[1] * bt); o.y = cvt2(k0[2] * bt, k0[3] * bt); o.z = cvt2(k1[0] * bt, k1[1] * bt); o.w = cvt2(k1[2] * bt, k1[3] * bt); *(LAS u32x4*)(kb16 + i * 272 + d0 * 2) = o;
            o.x = cvt2(q0[0] * eg, q0[1] * eg); o.y = cvt2(q0[2] * eg, q0[3] * eg); o.z = cvt2(q1[0] * eg, q1[1] * eg); o.w = cvt2(q1[2] * eg, q1[3] * eg);
            *(u32x4*)(rec + R_QD + (i * 128 + d0) * 2) = o;
        }
        DNP_REP(1) for (int idx = tid; idx < 1024; idx += NTHR) {
            const int d = idx & 127, i0 = (idx >> 7) * 8; const float G63 = sG[63];
            float v[8];
#pragma unroll
            for (int jj = 0; jj < 8; ++jj) v[jj] = ks[(i0 + jj) * 128 + d] * __expf(G63 - sG[i0 + jj]);
            u32x2 o0, o1; o0.x = cvt2(v[0], v[1]); o0.y = cvt2(v[2], v[3]); o1.x = cvt2(v[4], v[5]); o1.y = cvt2(v[6], v[7]);
            unsigned char* kd = rec + R_KDT + ((((d >> 5) * 4 + (i0 >> 4)) * 64 + (d & 31)) * 16) + ((i0 >> 3) & 1) * 8;
            *(u32x2*)kd = o0; *(u32x2*)(kd + 32 * 16) = o1;
        }
        if (tid == 0) gls[ci] = seG[63];
        __syncthreads();
        DNP_REP(2) {
            const int which = wave >> 2, mt = (wave >> 1) & 1, nt = wave & 1, r32 = lane & 31, h = lane >> 5;
            const LAS unsigned char* Ab = (which ? q16 : kb16) + (32 * mt + r32) * 272 + h * 16;
            const LAS unsigned char* Bb = k16 + (32 * nt + r32) * 272 + h * 16;
            f32x16 acc;
#pragma unroll
            for (int r = 0; r < 16; ++r) acc[r] = 0.f;
#pragma unroll
            for (int kk = 0; kk < 8; ++kk) {
                const bf16x8 av = *(const LAS bf16x8*)(Ab + kk * 32), bv = *(const LAS bf16x8*)(Bb + kk * 32);
                acc = __builtin_amdgcn_mfma_f32_32x32x16_bf16(av, bv, acc, 0, 0, 0);
            }
            const int j = 32 * nt + r32; const float Gj = sG[j];
#pragma unroll
            for (int r = 0; r < 16; ++r) {
                const int i = 32 * mt + crow(r, h);
                const float val = acc[r] * __expf(sG[i] - Gj);
                if (which == 0) Lm[i * 68 + j] = (i > j) ? val : 0.f;
                else *(bf16_t*)(rec + R_ATT + (i * 64 + j) * 2) = (bf16_t)((i >= j) ? f2bf(val) : 0u);
            }
        }
        __syncthreads();
        const int n32 = lane & 31, h32 = lane >> 5;
        DNP_REP(3) {
        if (wave == 0) {
            int ln = lane; asm volatile("" : "+v"(ln));
            const int r = ln >> 5, c = ln & 31;
            float x[32];
            tsolve_all(x, Lm + (32 * r) * 68 + 32 * r, c, std::make_integer_sequence<int, 32>{});
            if (r == 0) {
#pragma unroll
                for (int q = 0; q < 4; ++q) { u32x4 o; o.x = cvt2(x[8 * q], x[8 * q + 1]); o.y = cvt2(x[8 * q + 2], x[8 * q + 3]); o.z = cvt2(x[8 * q + 4], x[8 * q + 5]); o.w = cvt2(x[8 * q + 6], x[8 * q + 7]);
                    *(LAS u32x4*)(lds + DNL_T11T + c * 80 + q * 16) = o; }
            }
            LAS bf16_t* Tp = (LAS bf16_t*)(lds + DNL_T) + (32 * r) * 72 + 32 * r + c;
#pragma unroll
            for (int i = 0; i < 32; ++i) Tp[i * 72] = (bf16_t)f2bf(x[i]);
            asm volatile("s_waitcnt lgkmcnt(0)" ::: "memory"); __builtin_amdgcn_wave_barrier();
            const int m = ln & 31, h = ln >> 5;
            f32x16 ax, a2;
#pragma unroll
            for (int q = 0; q < 16; ++q) { ax[q] = 0.f; a2[q] = 0.f; }
#pragma unroll
            for (int s = 0; s < 2; ++s) {
                const f32x4 l0 = *(const LAS f32x4*)(Lm + (32 + m) * 68 + 16 * s + 8 * h), l1 = *(const LAS f32x4*)(Lm + (32 + m) * 68 + 16 * s + 8 * h + 4);
                u32x4 av; av.x = cvt2(l0[0], l0[1]); av.y = cvt2(l0[2], l0[3]); av.z = cvt2(l1[0], l1[1]); av.w = cvt2(l1[2], l1[3]);
                const bf16x8 bv = *(const LAS bf16x8*)(lds + DNL_T11T + m * 80 + (16 * s + 8 * h) * 2);
                ax = __builtin_amdgcn_mfma_f32_32x32x16_bf16(__builtin_bit_cast(bf16x8, av), bv, ax, 0, 0, 0);
            }
#pragma unroll
            for (int s = 0; s < 2; ++s)
                a2 = __builtin_amdgcn_mfma_f32_32x32x16_bf16(lda_split(lds + DNL_T + (32 + m) * 144 + (32 + 16 * s + 4 * h) * 2), pack8(ax, s), a2, 0, 0, 0);
            LAS bf16_t* T21 = (LAS bf16_t*)(lds + DNL_T) + 32 * 72 + m;
#pragma unroll
            for (int q = 0; q < 16; ++q) T21[crow(q, h) * 72] = (bf16_t)f2bf(-a2[q]);
        } else {
            for (int idx = tid - 64; idx < 2048; idx += NTHR - 64) {
                const int c = idx & 127, jr = (idx >> 7) & 7, wh = idx >> 10;
                const LAS float* sp_ = (wh ? vs : ks) + c; const LAS float* sc = (wh ? sbeta : sbg) + 8 * jr;
                float v[8];
#pragma unroll
                for (int jj = 0; jj < 8; ++jj) v[jj] = sp_[(8 * jr + jj) * 128] * sc[jj];
                u32x4 o; o.x = cvt2(v[0], v[1]); o.y = cvt2(v[2], v[3]); o.z = cvt2(v[4], v[5]); o.w = cvt2(v[6], v[7]);
                *(LAS u32x4*)(lds + (wh ? DNL_VBT : DNL_KBT) + c * 144 + jr * 16) = o;
            }
        }
        }
        __syncthreads();
        {
            const bool isw = wave < 4;
            const LAS unsigned char* Bt = lds + (isw ? DNL_KBT : DNL_VBT) + (32 * (wave & 3) + n32) * 144 + h32 * 16;
            const LAS unsigned char* Ta = lds + DNL_T + n32 * 144 + h32 * 16;
            bf16x8 bv[4], t0[2], t1[4];
#pragma unroll
            for (int s = 0; s < 4; ++s) { bv[s] = *(const LAS bf16x8*)(Bt + s * 32); t1[s] = *(const LAS bf16x8*)(Ta + 32 * 144 + s * 32); }
#pragma unroll
            for (int s = 0; s < 2; ++s) t0[s] = *(const LAS bf16x8*)(Ta + s * 32);
            f32x16 c0, c1;
#pragma unroll
            for (int q = 0; q < 16; ++q) { c0[q] = 0.f; c1[q] = 0.f; }
            if (isw) {
#pragma unroll
                for (int s = 0; s < 2; ++s) c0 = __builtin_amdgcn_mfma_f32_32x32x16_bf16(bv[s], t0[s], c0, 0, 0, 0);
#pragma unroll
                for (int s = 0; s < 4; ++s) c1 = __builtin_amdgcn_mfma_f32_32x32x16_bf16(bv[s], t1[s], c1, 0, 0, 0);
                unsigned char* dst = rec + R_W + (size_t)(wave * 4096 + lane * 16);
                *(u32x4*)dst = __builtin_bit_cast(u32x4, pack8(c0, 0)); *(u32x4*)(dst + 1024) = __builtin_bit_cast(u32x4, pack8(c0, 1));
                *(u32x4*)(dst + 2048) = __builtin_bit_cast(u32x4, pack8(c1, 0)); *(u32x4*)(dst + 3072) = __builtin_bit_cast(u32x4, pack8(c1, 1));
            } else {
#pragma unroll
                for (int s = 0; s < 2; ++s) c0 = __builtin_amdgcn_mfma_f32_32x32x16_bf16(t0[s], bv[s], c0, 0, 0, 0);
#pragma unroll
                for (int s = 0; s < 4; ++s) c1 = __builtin_amdgcn_mfma_f32_32x32x16_bf16(t1[s], bv[s], c1, 0, 0, 0);
                unsigned char* dst = rec + R_U + (size_t)(((wave - 4) * 64 + lane) * 64);
                *(u32x4*)dst = __builtin_bit_cast(u32x4, pack8(c0, 0)); *(u32x4*)(dst + 16) = __builtin_bit_cast(u32x4, pack8(c0, 1));
                *(u32x4*)(dst + 32) = __builtin_bit_cast(u32x4, pack8(c1, 0)); *(u32x4*)(dst + 48) = __builtin_bit_cast(u32x4, pack8(c1, 1));
            }
        }
    }
    __syncthreads();
}

constexpr int DNB_W = 0, DNB_QD = 16896, DNB_KDT = 33792, DNB_ATT = 51200, DNB_U = 59904  , DNB_GL = 80384, DNB_SZ = 80400;
__device__ __forceinline__ void dn_issue_chunk(const unsigned char* rec, const float* glp, u32x4 (&v)[18], float& gl, int tl) {
    asm volatile("" : "+v"(tl));
#pragma unroll
    for (int i = 0; i < 18; ++i) v[i] = *(const u32x4*)(rec + (size_t)(tl + 256 * i) * 16);
    gl = *glp;
}
__device__ __forceinline__ void dn_write_chunk(const u32x4 (&v)[18], float gl, LAS unsigned char* buf, int tl) {
    asm volatile("" : "+v"(tl));
#pragma unroll
    for (int i = 0; i < 18; ++i) {
        const int q = tl + 256 * i;
        LAS unsigned char* d;
        if (i < 4) d = buf + DNB_W + q * 16;
        else if (i < 8) d = buf + DNB_QD + ((q - 1024) >> 4) * 264 + (q & 15) * 16;
        else if (i < 12) d = buf + DNB_KDT + (q - 2048) * 16;
        else if (i < 14) d = buf + DNB_ATT + ((q - 3072) >> 3) * 136 + (q & 7) * 16;
        else d = buf + DNB_U + ((q - 3584) >> 2) * 80 + (q & 3) * 16;
        u32x2 lo, hi; lo.x = v[i].x; lo.y = v[i].y; hi.x = v[i].z; hi.y = v[i].w;
        *(LAS u32x2*)d = lo; *(LAS u32x2*)(d + 8) = hi;
    }
    if (tl == 0) *(LAS float*)(buf + DNB_GL) = gl;
}
__device__ __forceinline__ void dn_gate_norm(const Args& a, int vblock) {
    const int lane = threadIdx.x & 63, wave = threadIdx.x >> 6;
    const int gw = vblock * NWAVE + wave, NGW = gridDim.x * NWAVE;
    const bf16_t* oraw = (const bf16_t*)a.out; const bf16_t* proj = (const bf16_t*)(a.ws + WS_PROJ); const bf16_t* mixed = (const bf16_t*)(a.ws + WS_ACT); const float* ogain = a.in[9];
    unsigned char* mq = a.ws + WS_MQ; float* ms = (float*)(a.ws + WS_MS);
    const f32x4 g0 = *(const f32x4*)(ogain + (lane & 15) * 8), g1 = *(const f32x4*)(ogain + (lane & 15) * 8 + 4);
    const int rpw = (((T_TOK + NGW - 1) / NGW) + 1) & ~1, row_lo = gw * rpw, row_hi = (row_lo + rpw < T_TOK) ? row_lo + rpw : T_TOK;
    u32x4 on[2], zn[2], sn[2];
#pragma unroll
    for (int q = 0; q < 2; ++q) { const size_t tok = (size_t)((row_lo < T_TOK ? row_lo : 0) + q);
        on[q] = *(const u32x4*)(oraw + tok * 512 + lane * 8); zn[q] = *(const u32x4*)(proj + tok * NPROJ + 1536 + lane * 8); sn[q] = *(const u32x4*)(mixed + tok * DM + 512 + lane * 8); }
    for (int tok0 = row_lo; tok0 < row_hi; tok0 += 2) {
        u32x4 ov[2], zv[2], sv[2];
#pragma unroll
        for (int q = 0; q < 2; ++q) { ov[q] = on[q]; zv[q] = zn[q]; sv[q] = sn[q]; }
        {
            const int tn = tok0 + 2 < row_hi ? tok0 + 2 : tok0;
#pragma unroll
            for (int q = 0; q < 2; ++q) { const size_t tok = (size_t)(tn + q);
                on[q] = *(const u32x4*)(oraw + tok * 512 + lane * 8); zn[q] = *(const u32x4*)(proj + tok * NPROJ + 1536 + lane * 8); sn[q] = *(const u32x4*)(mixed + tok * DM + 512 + lane * 8); }
        }
#pragma unroll
        for (int q = 0; q < 2; ++q) {
            float o[8], z[8], s[8];
#pragma unroll
            for (int c = 0; c < 4; ++c) { o[2 * c] = bf_lo(ov[q][c]); o[2 * c + 1] = bf_hi(ov[q][c]); z[2 * c] = bf_lo(zv[q][c]); z[2 * c + 1] = bf_hi(zv[q][c]); s[2 * c] = bf_lo(sv[q][c]); s[2 * c + 1] = bf_hi(sv[q][c]); }
            float ss = 0.f;
#pragma unroll
            for (int c = 0; c < 8; ++c) ss += o[c] * o[c];
            ss += dpp_<0xB1>(ss); ss += dpp_<0x4E>(ss); ss += dpp_<0x141>(ss); ss += dpp_<0x140>(ss);
            const float r = rsqrtf(ss * (1.0f / 128.0f) + EPS);
            float am = 0.f;
#pragma unroll
            for (int c = 0; c < 8; ++c) { o[c] = o[c] * r * (c < 4 ? g0[c] : g1[c - 4]) * siluf(z[c]); am = fmaxf(am, fmaxf(fabsf(o[c]), fabsf(s[c]))); }
            am = wave_max(am);
            const float inv = am > 0.f ? 127.0f / am : 0.f;
            u32x2 od, os;
            od.x = q8x4(o[0], o[1], o[2], o[3], inv); od.y = q8x4(o[4], o[5], o[6], o[7], inv);
            os.x = q8x4(s[0], s[1], s[2], s[3], inv); os.y = q8x4(s[4], s[5], s[6], s[7], inv);
            const size_t tok = (size_t)(tok0 + q);
            *(u32x2*)(mq + tok * 1024 + lane * 8) = od; *(u32x2*)(mq + tok * 1024 + 512 + lane * 8) = os;
            if (lane == 0) ms[tok] = am * (1.0f / 127.0f);
        }
    }
}
__device__ __forceinline__ void dn_scan2(const Args& a, LAS unsigned char* lds) {
    const int tid = threadIdx.x, lane = tid & 63, wave = __builtin_amdgcn_readfirstlane(tid >> 6);
    const int bh = blockIdx.x >> 1, dvh = blockIdx.x & 1, b = bh >> 2, hd = bh & 3;
    const unsigned char* recs = a.ws + WS_DN + (size_t)bh * 64 * DN_REC;
    const float* gls = (const float*)(a.ws + WS_GLS) + bh * 64;
    bf16_t* oraw = (bf16_t*)a.out;
    if (wave >= 4) {
        u32x4 pv[18]; float pgl;
        dn_issue_chunk(recs, gls, pv, pgl, tid - 256); dn_write_chunk(pv, pgl, lds, tid - 256); dn_issue_chunk(recs + DN_REC, gls + 1, pv, pgl, tid - 256);
        __syncthreads();
        for (int n = 0; n < 64; ++n) {
            if (n + 1 < 64) dn_write_chunk(pv, pgl, lds + ((n + 1) & 1) * DNB_SZ, tid - 256);
            if (n + 2 < 64) dn_issue_chunk(recs + (size_t)(n + 2) * DN_REC, gls + n + 2, pv, pgl, tid - 256);
            __syncthreads();
        }
        return;
    }
    if (wave >= 2) {
        __syncthreads();
        for (int n = 0; n < 64; ++n) __syncthreads();
        return;
    }
    const int cw = dvh * 2 + wave;
    f32x16 S[4]; bf16x8 BS[8];
#pragma unroll
    for (int kt = 0; kt < 4; ++kt)
#pragma unroll
        for (int r = 0; r < 16; ++r) S[kt][r] = 0.f;
#pragma unroll
    for (int ks = 0; ks < 8; ++ks) BS[ks] = (bf16x8){0, 0, 0, 0, 0, 0, 0, 0};
    __syncthreads();
    for (int n = 0; n < 64; ++n) {
        {
            int lane_o = lane; asm volatile("" : "+v"(lane_o));
            const int r32 = lane_o & 31, h = lane_o >> 5;
            const LAS unsigned char* B0 = lds + (n & 1) * DNB_SZ;
            const float gl = *(const LAS float*)(B0 + DNB_GL);
            const int koff = 8 * h;
            bf16x8 BV[4];
            {
                bf16x8 fa[16];
#pragma unroll
                for (int ks = 0; ks < 8; ++ks) { fa[2 * ks] = *(const LAS bf16x8*)(B0 + DNB_W + ((ks >> 1) * 4 + (ks & 1)) * 1024 + lane_o * 16); fa[2 * ks + 1] = *(const LAS bf16x8*)(B0 + DNB_W + ((ks >> 1) * 4 + 2 + (ks & 1)) * 1024 + lane_o * 16); }
                const LAS unsigned char* up = B0 + DNB_U + (cw * 64 + lane_o) * 80;
                u32x4 uq[4];
#pragma unroll
                for (int c = 0; c < 4; ++c) uq[c] = *(const LAS u32x4*)(up + c * 16);
                __builtin_amdgcn_sched_barrier(0);
                f32x16 X0, X1;
#pragma unroll
                for (int r = 0; r < 16; ++r) { X0[r] = 0.f; X1[r] = 0.f; }
#pragma unroll
                for (int ks = 0; ks < 8; ++ks) {
                    X0 = __builtin_amdgcn_mfma_f32_32x32x16_bf16(fa[2 * ks], BS[ks], X0, 0, 0, 0);
                    X1 = __builtin_amdgcn_mfma_f32_32x32x16_bf16(fa[2 * ks + 1], BS[ks], X1, 0, 0, 0);
                }
#pragma unroll
                for (int r = 0; r < 16; ++r) { const unsigned w0 = uq[r >> 3][(r >> 1) & 3], w1 = uq[2 + (r >> 3)][(r >> 1) & 3];
                    X0[r] = ((r & 1) ? bf_hi(w0) : bf_lo(w0)) - X0[r]; X1[r] = ((r & 1) ? bf_hi(w1) : bf_lo(w1)) - X1[r]; }
                BV[0] = pack8(X0, 0); BV[1] = pack8(X0, 1); BV[2] = pack8(X1, 0); BV[3] = pack8(X1, 1);
            }
            __builtin_amdgcn_sched_barrier(0);
            {
                bf16x8 fq[16], ft[8];
#pragma unroll
                for (int ks = 0; ks < 8; ++ks) { fq[2 * ks] = lda_split(B0 + DNB_QD + r32 * 264 + ks * 32 + koff); fq[2 * ks + 1] = lda_split(B0 + DNB_QD + (32 + r32) * 264 + ks * 32 + koff); }
                __builtin_amdgcn_sched_barrier(0);
                f32x16 O0, O1;
#pragma unroll
                for (int r = 0; r < 16; ++r) { O0[r] = 0.f; O1[r] = 0.f; }
#pragma unroll
                for (int ks = 0; ks < 4; ++ks) {
                    O0 = __builtin_amdgcn_mfma_f32_32x32x16_bf16(fq[2 * ks], BS[ks], O0, 0, 0, 0);
                    O1 = __builtin_amdgcn_mfma_f32_32x32x16_bf16(fq[2 * ks + 1], BS[ks], O1, 0, 0, 0);
                }
                __builtin_amdgcn_sched_barrier(0);
#pragma unroll
                for (int cs = 0; cs < 4; ++cs) { ft[2 * cs] = lda_split(B0 + DNB_ATT + r32 * 136 + cs * 32 + koff); ft[2 * cs + 1] = lda_split(B0 + DNB_ATT + (32 + r32) * 136 + cs * 32 + koff); }
                __builtin_amdgcn_sched_barrier(0);
#pragma unroll
                for (int ks = 4; ks < 8; ++ks) {
                    O0 = __builtin_amdgcn_mfma_f32_32x32x16_bf16(fq[2 * ks], BS[ks], O0, 0, 0, 0);
                    O1 = __builtin_amdgcn_mfma_f32_32x32x16_bf16(fq[2 * ks + 1], BS[ks], O1, 0, 0, 0);
                }
#pragma unroll
                for (int cs = 0; cs < 4; ++cs) {
                    O0 = __builtin_amdgcn_mfma_f32_32x32x16_bf16(ft[2 * cs], BV[cs], O0, 0, 0, 0);
                    O1 = __builtin_amdgcn_mfma_f32_32x32x16_bf16(ft[2 * cs + 1], BV[cs], O1, 0, 0, 0);
                }
                bf16_t* obu = oraw + ((size_t)b * SEQ + n * 64) * 512 + hd * 128 + 32 * cw;
                const unsigned lo = (unsigned)((4 * h) * 512 + r32);
#pragma unroll
                for (int r = 0; r < 16; ++r) { obu[lo + (unsigned)(((r & 3) + 8 * (r >> 2)) * 512)] = (bf16_t)f2bf(O0[r]); obu[lo + (unsigned)((32 + (r & 3) + 8 * (r >> 2)) * 512)] = (bf16_t)f2bf(O1[r]); }
            }
            __builtin_amdgcn_sched_barrier(0);
            {
                bf16x8 fk[16];
#pragma unroll
                for (int kt = 0; kt < 4; ++kt)
#pragma unroll
                    for (int cs = 0; cs < 4; ++cs) fk[kt * 4 + cs] = *(const LAS bf16x8*)(B0 + DNB_KDT + ((kt * 4 + cs) * 64 + lane_o) * 16);
#pragma unroll
                for (int kt = 0; kt < 4; ++kt)
#pragma unroll
                    for (int r = 0; r < 16; ++r) S[kt][r] *= gl;
                __builtin_amdgcn_sched_barrier(0);
#pragma unroll
                for (int cs = 0; cs < 4; ++cs)
#pragma unroll
                    for (int kt = 0; kt < 4; ++kt) S[kt] = __builtin_amdgcn_mfma_f32_32x32x16_bf16(fk[kt * 4 + cs], BV[cs], S[kt], 0, 0, 0);
            }
#pragma unroll
            for (int kt = 0; kt < 4; ++kt) { BS[2 * kt] = pack8(S[kt], 0); BS[2 * kt + 1] = pack8(S[kt], 1); }
        }
        __syncthreads();
    }
}

__device__ __forceinline__ void sb_prep(const Args& a, LAS unsigned char* lds, int vb, bool pairm) {
    int lane = threadIdx.x & 63; asm volatile("" : "+v"(lane));
    const int wave = threadIdx.x >> 6;
    const int gw = vb * NWAVE + wave, NGW = gridDim.x * NWAVE;
    const bf16_t* proj = (const bf16_t*)(a.ws + WS_PROJ);
    bf16_t* KF = (bf16_t*)((unsigned char*)a.out + KF_OFF); bf16_t* VF = (bf16_t*)((unsigned char*)a.out + VT_OFF);
    LAS unsigned char* tl = lds + wave * (32 * 144);
    const int rho = lane & 31, hh = lane >> 5, krow = (rho & 19) | ((rho & 4) << 1) | ((rho & 8) >> 1);
    for (int it = 0; ; ++it) {
        int bh, kb;
        if (pairm) { if (it >= 4) break; const int tok0 = vb * 128; bh = ((tok0 >> 12) << 3) | wave; kb = ((tok0 & 4095) >> 5) + it; }
        else { const int item = gw + it * NGW; if (item >= 64 * 128) break; bh = item >> 7; kb = item & 127; }
        const int b = bh >> 3, h = bh & 7; const size_t tok = (size_t)b * SEQ + kb * 32;
        {
            const bf16_t* kr = proj + (tok + krow) * NPROJ + 2560 + h * 64 + 8 * hh;
            u32x4 w[4]; float ss = 0.f;
#pragma unroll
            for (int ks = 0; ks < 4; ++ks) { w[ks] = *(const u32x4*)(kr + 16 * ks);
                ss = dot2(w[ks].x, w[ks].x, ss); ss = dot2(w[ks].y, w[ks].y, ss); ss = dot2(w[ks].z, w[ks].z, ss); ss = dot2(w[ks].w, w[ks].w, ss); }
            ss += __shfl_xor(ss, 32);
            const float rs = rsqrtf(ss * (1.0f / 64.0f) + EPS);
            bf16_t* dst = KF + (((size_t)(bh * 128 + kb) * 4) * 64 + lane) * 8;
#pragma unroll
            for (int ks = 0; ks < 4; ++ks) { u32x4 o;
                o.x = pk2(bf_lo(w[ks].x) * rs, bf_hi(w[ks].x) * rs); o.y = pk2(bf_lo(w[ks].y) * rs, bf_hi(w[ks].y) * rs);
                o.z = pk2(bf_lo(w[ks].z) * rs, bf_hi(w[ks].z) * rs); o.w = pk2(bf_lo(w[ks].w) * rs, bf_hi(w[ks].w) * rs);
                *(u32x4*)(dst + ks * 512) = o; }
        }
        {
#pragma unroll
            for (int i = 0; i < 4; ++i) { const int key = 8 * i + (lane >> 3), pc = lane & 7;
                *(LAS u32x4*)(tl + key * 144 + pc * 16) = *(const u32x4*)(proj + (tok + key) * NPROJ + 3072 + h * 64 + pc * 8); }
            LDS_WAIT();
            bf16_t* dst = VF + (((size_t)(bh * 128 + kb) * 4) * 64 + lane) * 8;
#pragma unroll
            for (int f = 0; f < 4; ++f) {
                const LAS unsigned short* sp = (const LAS unsigned short*)(tl + (16 * (f & 1) + 8 * hh) * 144) + 32 * (f >> 1) + rho;
                unsigned v[8];
#pragma unroll
                for (int j = 0; j < 8; ++j) v[j] = sp[j * 72];
                u32x4 o; o.x = v[0] | (v[1] << 16); o.y = v[2] | (v[3] << 16); o.z = v[4] | (v[5] << 16); o.w = v[6] | (v[7] << 16);
                *(u32x4*)(dst + f * 512) = o;
            }
            LDS_WAIT();
        }
    }
}

__device__ __forceinline__ void sb_attn(const Args& a, int wave_id, int n_waves) {
    const int lane = threadIdx.x & 63, r32 = lane & 31, hh = lane >> 5;
    const bf16_t* proj = (const bf16_t*)(a.ws + WS_PROJ); bf16_t* mixed = (bf16_t*)(a.ws + WS_ACT);
    const bf16_t* VT = (const bf16_t*)((const unsigned char*)a.out + VT_OFF); const bf16_t* KF = (const bf16_t*)((const unsigned char*)a.out + KF_OFF);
    const float* go = a.in[12]; const float* gqv = a.in[10]; const float* gkv = a.in[11];
    const int krow_l = (r32 & 19) | ((r32 & 4) << 1) | ((r32 & 8) >> 1);
    for (int item = wave_id; item < 64 * 128; item += n_waves) {
        const int tile = 127 - (item >> 6), bh = item & 63, b = bh >> 3, h = bh & 7;
        const int t0 = tile * 32, t = t0 + r32; const size_t tokb = (size_t)b * SEQ;
        bf16x8 qf[4];
        {
            u32x4 qr[4]; float ss = 0.f;
#pragma unroll
            for (int ks = 0; ks < 4; ++ks) { qr[ks] = *(const u32x4*)(proj + (tokb + t) * NPROJ + 2048 + h * 64 + 16 * ks + 8 * hh);
                ss = dot2(qr[ks].x, qr[ks].x, ss); ss = dot2(qr[ks].y, qr[ks].y, ss); ss = dot2(qr[ks].z, qr[ks].z, ss); ss = dot2(qr[ks].w, qr[ks].w, ss); }
            ss += __shfl_xor(ss, 32);
            const float rs = rsqrtf(ss * (1.0f / 64.0f) + EPS) * 0.125f;
#pragma unroll
            for (int ks = 0; ks < 4; ++ks) {
                const int d = 16 * ks + 8 * hh;
                const f32x4 g0 = *(const f32x4*)(gqv + d) * *(const f32x4*)(gkv + d), g1 = *(const f32x4*)(gqv + d + 4) * *(const f32x4*)(gkv + d + 4);
                u32x4 o;
                o.x = pk2(bf_lo(qr[ks].x) * rs * g0[0], bf_hi(qr[ks].x) * rs * g0[1]); o.y = pk2(bf_lo(qr[ks].y) * rs * g0[2], bf_hi(qr[ks].y) * rs * g0[3]);
                o.z = pk2(bf_lo(qr[ks].z) * rs * g1[0], bf_hi(qr[ks].z) * rs * g1[1]); o.w = pk2(bf_lo(qr[ks].w) * rs * g1[2], bf_hi(qr[ks].w) * rs * g1[3]);
                qf[ks] = __builtin_bit_cast(bf16x8, o);
            }
        }
        f32x16 O0, O1;
#pragma unroll
        for (int r = 0; r < 16; ++r) { O0[r] = 0.f; O1[r] = 0.f; }
        float R = 1.f;
        const bf16_t* kbase = KF + ((size_t)bh * 128 * 4 * 64 + lane) * 8;
        const bf16_t* vbase = VT + ((size_t)bh * 128 * 4 * 64 + lane) * 8;
        for (int kb = tile; kb >= 0; --kb) {
            const int k0 = kb * 32;
            bf16x8 kf[4], vf[4];
#pragma unroll
            for (int ks = 0; ks < 4; ++ks) kf[ks] = *(const bf16x8*)(kbase + (size_t)(kb * 4 + ks) * 512);
#pragma unroll
            for (int f = 0; f < 4; ++f) vf[f] = *(const bf16x8*)(vbase + (size_t)(kb * 4 + f) * 512);
            f32x16 Z;
#pragma unroll
            for (int r = 0; r < 16; ++r) Z[r] = 0.f;
#pragma unroll
            for (int ks = 0; ks < 4; ++ks) Z = __builtin_amdgcn_mfma_f32_32x32x16_bf16(kf[ks], qf[ks], Z, 0, 0, 0);
            float bt[16], om[16];
#pragma unroll
            for (int r = 0; r < 16; ++r) {
                const float e = __expf(-fmaxf(Z[r], -80.0f));
                const float bb = __builtin_amdgcn_rcpf(1.0f + e);
                const bool valid = (k0 + 16 * (r >> 3) + 8 * hh + (r & 7)) < t;
                bt[r] = valid ? bb : 0.f;
                om[r] = valid ? e * bb : 1.0f;
            }
            float sufA[8], sufB[8];
            sufA[7] = 1.f; sufB[7] = 1.f;
#pragma unroll
            for (int p = 6; p >= 0; --p) { sufA[p] = sufA[p + 1] * om[p + 1]; sufB[p] = sufB[p + 1] * om[8 + p + 1]; }
            const float sA = sufA[0] * om[0], sB = sufB[0] * om[8];
            const float pA = __shfl_xor(sA, 32), pB = __shfl_xor(sB, 32);
            const float aboveB = hh ? 1.f : pB;
            const float aboveA = hh ? (sB * pB) : (pB * sB * pA);
            const float PA = R * aboveA, PB = R * aboveB;
#pragma unroll
            for (int p = 0; p < 8; ++p) { Z[p] = bt[p] * (PA * sufA[p]); Z[8 + p] = bt[8 + p] * (PB * sufB[p]); }
            R *= (sA * sB) * (pA * pB);
            const bf16x8 p0 = pack8(Z, 0), p1 = pack8(Z, 1);
            O0 = __builtin_amdgcn_mfma_f32_32x32x16_bf16(vf[0], p0, O0, 0, 0, 0);
            O0 = __builtin_amdgcn_mfma_f32_32x32x16_bf16(vf[1], p1, O0, 0, 0, 0);
            O1 = __builtin_amdgcn_mfma_f32_32x32x16_bf16(vf[2], p0, O1, 0, 0, 0);
            O1 = __builtin_amdgcn_mfma_f32_32x32x16_bf16(vf[3], p1, O1, 0, 0, 0);
            if (__all(R == 0.0f)) break;
        }
        float ss = 0.f;
#pragma unroll
        for (int r = 0; r < 16; ++r) ss += O0[r] * O0[r] + O1[r] * O1[r];
        ss += __shfl_xor(ss, 32);
        const float rn = rsqrtf(ss * (1.0f / 64.0f) + EPS);
        bf16_t* dst = mixed + (tokb + t) * DM + 512 + h * 64;
#pragma unroll
        for (int g = 0; g < 4; ++g) {
            const int d = 8 * g + 4 * hh;
            const f32x4 gv0 = *(const f32x4*)(go + d), gv1 = *(const f32x4*)(go + 32 + d);
            u32x2 w0, w1;
            w0.x = pk2(O0[4 * g] * rn * gv0[0], O0[4 * g + 1] * rn * gv0[1]); w0.y = pk2(O0[4 * g + 2] * rn * gv0[2], O0[4 * g + 3] * rn * gv0[3]);
            w1.x = pk2(O1[4 * g] * rn * gv1[0], O1[4 * g + 1] * rn * gv1[1]); w1.y = pk2(O1[4 * g + 2] * rn * gv1[2], O1[4 * g + 3] * rn * gv1[3]);
            *(u32x2*)(dst + d) = w0; *(u32x2*)(dst + 32 + d) = w1;
        }
    }
}

__device__ __forceinline__ void topk_insert(float (&L)[16], float x) {
#pragma unroll
    for (int i = 15; i >= 1; --i) L[i] = __builtin_amdgcn_fmed3f(L[i - 1], L[i], x);
    L[0] = fmaxf(L[0], x);
}
#define CE(a, b) { const float hi_ = __builtin_fmaxf(x[a], x[b]), lo_ = __builtin_fminf(x[a], x[b]); x[a] = hi_; x[b] = lo_; }
__device__ __forceinline__ void sort16_desc(float (&x)[16]) { CE(0,1) CE(2,3) CE(0,2) CE(1,3) CE(1,2) CE(4,5) CE(6,7) CE(4,6) CE(5,7) CE(5,6) CE(0,4) CE(2,6) CE(2,4) CE(1,5) CE(3,7) CE(3,5) CE(1,2) CE(3,4) CE(5,6) CE(8,9) CE(10,11) CE(8,10) CE(9,11) CE(9,10) CE(12,13) CE(14,15) CE(12,14) CE(13,15) CE(13,14) CE(8,12) CE(10,14) CE(10,12) CE(9,13) CE(11,15) CE(11,13) CE(9,10) CE(11,12) CE(13,14) CE(0,8) CE(4,12) CE(4,8) CE(2,10) CE(6,14) CE(6,10) CE(2,4) CE(6,8) CE(10,12) CE(1,9) CE(5,13) CE(5,9) CE(3,11) CE(7,15) CE(7,11) CE(3,5) CE(7,9) CE(11,13) CE(1,2) CE(3,4) CE(5,6) CE(7,8) CE(9,10) CE(11,12) CE(13,14) }
__device__ __forceinline__ void bmerge16_desc(float (&x)[16]) { CE(0,8) CE(1,9) CE(2,10) CE(3,11) CE(4,12) CE(5,13) CE(6,14) CE(7,15) CE(0,4) CE(1,5) CE(2,6) CE(3,7) CE(8,12) CE(9,13) CE(10,14) CE(11,15) CE(0,2) CE(1,3) CE(4,6) CE(5,7) CE(8,10) CE(9,11) CE(12,14) CE(13,15) CE(0,1) CE(2,3) CE(4,5) CE(6,7) CE(8,9) CE(10,11) CE(12,13) CE(14,15) }
#undef CE
__device__ __forceinline__ void topk_merge16(float (&L)[16], float (&v)[16]) {
    sort16_desc(v);
#pragma unroll
    for (int i = 0; i < 16; ++i) L[i] = __builtin_fmaxf(L[i], v[15 - i]);
    bmerge16_desc(L);
}
template <int I, int J> __device__ __forceinline__ float cand_val(const float (&L0)[16], const float (&L1)[16]) {
    const float s = __uint_as_float(__float_as_uint(L0[I]) & ~127u) + __uint_as_float(__float_as_uint(L1[J]) & ~127u);
    return __uint_as_float((__float_as_uint(s) & ~255u) | (unsigned)(255 - (I * 16 + J)));
}
template <int I, int J> __device__ __forceinline__ void cand_ins(float (&M)[16], const float (&L0)[16], const float (&L1)[16]) {
    if constexpr (I == 0) M[J] = cand_val<0, J>(L0, L1);
    else topk_insert(M, cand_val<I, J>(L0, L1));
}
template <int I, int... Js> __device__ __forceinline__ void cand_row(float (&M)[16], const float (&L0)[16], const float (&L1)[16], std::integer_sequence<int, Js...>) {
    (cand_ins<I, Js>(M, L0, L1), ...);
}
template <int... Is> __device__ __forceinline__ void cand_all(float (&M)[16], const float (&L0)[16], const float (&L1)[16], std::integer_sequence<int, Is...>) {
    (cand_row<Is>(M, L0, L1, std::make_integer_sequence<int, 16 / (Is + 1)>{}), ...);
}
__device__ __forceinline__ void phase_scores(const Args& a, LAS unsigned char* lds, const pg8::StaticOrder& S) {
    const bf16_t* qp = (const bf16_t*)(a.ws + WS_QPEER); const bf16_t* kb = (const bf16_t*)(a.ws + WS_SUBK);
    unsigned* sel_e = (unsigned*)(a.ws + WS_SELE); float* sel_g = (float*)(a.ws + WS_SELG);
    pg8::Unit un, unn;
    u32x4 skn[8];
    if (S.next(0, un)) {
#pragma unroll
        for (int j = 0; j < 8; ++j) { const int c = (int)threadIdx.x + j * NTHR; skn[j] = *(const u32x4*)(kb + ((size_t)un.pn * 256 + (c >> 4)) * 128 + (c & 15) * 8); }
    }
    for (int ui = 0; S.next(ui, un); ++ui) {
        int tid = threadIdx.x; asm volatile("" : "+v"(tid));
        const int lane = tid & 63, wave = tid >> 6, r32 = lane & 31, hh = lane >> 5;
        const int h = un.pn, tile = un.pm;
        const size_t tok = (size_t)tile * 256 + wave * 32 + r32;
        bf16x8 bq0[8], bq1[8];
#pragma unroll
        for (int ks = 0; ks < 8; ++ks) { bq0[ks] = *(const bf16x8*)(qp + tok * 2048 + (h * 2) * 128 + 16 * ks + 8 * hh); bq1[ks] = *(const bf16x8*)(qp + tok * 2048 + (h * 2 + 1) * 128 + 16 * ks + 8 * hh); }
        __syncthreads();
#pragma unroll
        for (int j = 0; j < 8; ++j) { const int c = tid + j * NTHR; *(LAS u32x4*)(lds + (c >> 4) * 272 + (c & 15) * 16) = skn[j]; }
        {
            const int hn = S.next(ui + 1, unn) ? unn.pn : h;
#pragma unroll
            for (int j = 0; j < 8; ++j) { const int c = tid + j * NTHR; skn[j] = *(const u32x4*)(kb + ((size_t)hn * 256 + (c >> 4)) * 128 + (c & 15) * 8); }
        }
        __syncthreads();
        float L[16];
#pragma unroll
        for (int kt = 0; kt < 4; ++kt) {
            f32x16 acc0, acc1;
#pragma unroll
            for (int r = 0; r < 16; ++r) { acc0[r] = 0.f; acc1[r] = 0.f; }
            const LAS unsigned char* Ab = lds + (32 * kt + r32) * 272 + hh * 16;
#pragma unroll
            for (int ks = 0; ks < 8; ++ks) {
                acc0 = __builtin_amdgcn_mfma_f32_32x32x16_bf16(*(const LAS bf16x8*)(Ab + ks * 32), bq0[ks], acc0, 0, 0, 0);
                acc1 = __builtin_amdgcn_mfma_f32_32x32x16_bf16(*(const LAS bf16x8*)(Ab + 128 * 272 + ks * 32), bq1[ks], acc1, 0, 0, 0);
            }
            float va[16], vb[16];
#pragma unroll
            for (int r = 0; r < 16; ++r) {
                const auto sw = __builtin_amdgcn_permlane32_swap(__float_as_uint(acc0[r]), __float_as_uint(acc1[r]), false, false);
                const unsigned key = (unsigned)(32 * kt + (r & 3) + 8 * (r >> 2));
                va[r] = __uint_as_float((sw[0] & ~127u) | key); vb[r] = __uint_as_float((sw[1] & ~127u) | (key + 4u));
            }
            if (kt == 0) { sort16_desc(va);
#pragma unroll
                for (int i = 0; i < 16; ++i) L[i] = va[i]; }
            else topk_merge16(L, va);
            topk_merge16(L, vb);
        }
        float L0[16], L1[16];
#pragma unroll
        for (int i = 0; i < 16; ++i) { const auto sw = __builtin_amdgcn_permlane32_swap(__float_as_uint(L[i]), __float_as_uint(L[i]), false, false); L0[i] = __uint_as_float(sw[0]); L1[i] = __uint_as_float(sw[1]); }
        LAS unsigned* ltab = (LAS unsigned*)(lds + 69632) + tid;
#pragma unroll
        for (int i = 0; i < 16; ++i) { ltab[i * 512] = __float_as_uint(L0[i]) & 127u; ltab[(16 + i) * 512] = __float_as_uint(L1[i]) & 127u; }
        float M[16];
        cand_all(M, L0, L1, std::make_integer_sequence<int, 16>{});
        const float m0 = __uint_as_float(__float_as_uint(M[0]) & ~255u);
        float den = 0.f;
#pragma unroll
        for (int i = 0; i < 16; ++i) den += __expf(__uint_as_float(__float_as_uint(M[i]) & ~255u) - m0);
        const float rden = 1.0f / den;
        unsigned eo[8]; float go[8];
#pragma unroll
        for (int q = 0; q < 8; ++q) {
            unsigned mlo = __float_as_uint(M[q]), mhi = __float_as_uint(M[8 + q]); asm volatile("" : "+v"(mlo), "+v"(mhi));
            const unsigned mb = hh ? mhi : mlo;
            const unsigned code = 255u - (mb & 255u);
            eo[q] = ltab[(code >> 4) * 512] * 128u + ltab[(16 + (code & 15u)) * 512];
            go[q] = __expf(__uint_as_float(mb & ~255u) - m0) * rden;
        }
        const size_t ob = (tok * 8 + h) * 16 + 8 * hh;
        *(u32x4*)(sel_e + ob) = (u32x4){eo[0], eo[1], eo[2], eo[3]}; *(u32x4*)(sel_e + ob + 4) = (u32x4){eo[4], eo[5], eo[6], eo[7]};
        *(f32x4*)(sel_g + ob) = (f32x4){go[0], go[1], go[2], go[3]}; *(f32x4*)(sel_g + ob + 4) = (f32x4){go[4], go[5], go[6], go[7]};
    }
}


template <int CTRL> __device__ __forceinline__ int dppi(int x) { return __builtin_amdgcn_update_dpp(0, x, CTRL, 0xF, 0xF, true); }
__device__ __forceinline__ void peer_gather(u32x4 (&w)[16], const LAS unsigned* idp, const unsigned char* tab) {
    u32x4 id[4];
#pragma unroll
    for (int c = 0; c < 4; ++c) id[c] = *(const LAS u32x4*)(idp + 4 * c);
#pragma unroll
    for (int i = 0; i < 16; ++i) w[i] = *(const u32x4*)(tab + (size_t)id[i >> 2][i & 3] * 128);
}
__device__ __forceinline__ void peer_u_reduce(const u32x4 (&w)[16], const u32x4 hq, LAS int* pp, bool first, bool b2, bool b1, bool b0) {
    int p[16];
#pragma unroll
    for (int i = 0; i < 16; ++i) {
        int acc = __builtin_amdgcn_sdot4((int)w[i].x, (int)hq.x, 0, false);
        acc = __builtin_amdgcn_sdot4((int)w[i].y, (int)hq.y, acc, false);
        acc = __builtin_amdgcn_sdot4((int)w[i].z, (int)hq.z, acc, false);
        p[i] = __builtin_amdgcn_sdot4((int)w[i].w, (int)hq.w, acc, false);
    }
    int q8[8], q4[4], q2[2];
#pragma unroll
    for (int k = 0; k < 8; ++k) { const int keep = b2 ? p[8 + k] : p[k], send = b2 ? p[k] : p[8 + k]; q8[k] = keep + dppi<0x141>(send); }
#pragma unroll
    for (int k = 0; k < 4; ++k) { const int keep = b1 ? q8[4 + k] : q8[k], send = b1 ? q8[k] : q8[4 + k]; q4[k] = keep + dppi<0x4E>(send); }
#pragma unroll
    for (int k = 0; k < 2; ++k) { const int keep = b0 ? q4[2 + k] : q4[k], send = b0 ? q4[k] : q4[2 + k]; q2[k] = keep + dppi<0xB1>(send); }
    if (first) { pp[0] = q2[0]; pp[8] = q2[1]; } else { pp[0] += q2[0]; pp[8] += q2[1]; }
}
__device__ __forceinline__ void peer_v_reduce(const u32x4 (&w)[16], const LAS unsigned* ap, float asc, float* op, unsigned xw, f32x2 gv, bool e0, bool e1, bool e2) {
    const u32x4 aq = *(const LAS u32x4*)ap;
    int y[16];
#pragma unroll
    for (int k = 0; k < 16; ++k) y[k] = 0;
#pragma unroll
    for (int g = 0; g < 4; ++g)
#pragma unroll
        for (int c = 0; c < 4; ++c) {
            const unsigned W0 = w[4 * g][c], W1 = w[4 * g + 1][c], W2 = w[4 * g + 2][c], W3 = w[4 * g + 3][c];
            const unsigned p01l = __builtin_amdgcn_perm(W1, W0, 0x05010400u), p01h = __builtin_amdgcn_perm(W1, W0, 0x07030602u);
            const unsigned p23l = __builtin_amdgcn_perm(W3, W2, 0x05010400u), p23h = __builtin_amdgcn_perm(W3, W2, 0x07030602u);
            const unsigned T0 = __builtin_amdgcn_perm(p23l, p01l, 0x05040100u), T1 = __builtin_amdgcn_perm(p23l, p01l, 0x07060302u);
            const unsigned T2 = __builtin_amdgcn_perm(p23h, p01h, 0x05040100u), T3 = __builtin_amdgcn_perm(p23h, p01h, 0x07060302u);
            y[4 * c + 0] = __builtin_amdgcn_sdot4((int)T0, (int)aq[g], y[4 * c + 0], false);
            y[4 * c + 1] = __builtin_amdgcn_sdot4((int)T1, (int)aq[g], y[4 * c + 1], false);
            y[4 * c + 2] = __builtin_amdgcn_sdot4((int)T2, (int)aq[g], y[4 * c + 2], false);
            y[4 * c + 3] = __builtin_amdgcn_sdot4((int)T3, (int)aq[g], y[4 * c + 3], false);
        }
    int z8[8], z4[4], z2[2];
#pragma unroll
    for (int k = 0; k < 8; ++k) { const int keep = e0 ? y[8 + k] : y[k], send = e0 ? y[k] : y[8 + k]; z8[k] = keep + dppi<0x128>(send); }
#pragma unroll
    for (int k = 0; k < 4; ++k) { const int keep = e1 ? z8[4 + k] : z8[k], send = e1 ? z8[k] : z8[4 + k]; z4[k] = keep + __shfl_xor(send, 16); }
#pragma unroll
    for (int k = 0; k < 2; ++k) { const int keep = e2 ? z4[2 + k] : z4[k], send = e2 ? z4[k] : z4[2 + k]; z2[k] = keep + __shfl_xor(send, 32); }
    const f32x2 xv = (f32x2){bf_lo(xw), bf_hi(xw)};
    __builtin_nontemporal_store(xv + gv * (f32x2){(float)z2[0] * asc, (float)z2[1] * asc}, (f32x2*)op);
}
__device__ __forceinline__ void peer_u_red16(const u32x4 (&w)[16], const u32x4 (&ent)[4], const LAS unsigned char* Hs, LAS int* pp, bool first, bool b2, bool b1, bool b0) {
    int p[16];
#pragma unroll
    for (int hb = 0; hb < 2; ++hb) {
        u32x4 h[8];
#pragma unroll
        for (int i = 0; i < 8; ++i) h[i] = *(const LAS u32x4*)(Hs + (ent[(8 * hb + i) >> 2][(8 * hb + i) & 3] >> 21) * 144);
#pragma unroll
        for (int i = 0; i < 8; ++i) { const u32x4 wi = w[8 * hb + i];
            int acc = __builtin_amdgcn_sdot4((int)wi.x, (int)h[i].x, 0, false);
            acc = __builtin_amdgcn_sdot4((int)wi.y, (int)h[i].y, acc, false);
            acc = __builtin_amdgcn_sdot4((int)wi.z, (int)h[i].z, acc, false);
            p[8 * hb + i] = __builtin_amdgcn_sdot4((int)wi.w, (int)h[i].w, acc, false); }
    }
    int q8[8], q4[4], q2[2];
#pragma unroll
    for (int k = 0; k < 8; ++k) { const int keep = b2 ? p[8 + k] : p[k], send = b2 ? p[k] : p[8 + k]; q8[k] = keep + dppi<0x141>(send); }
#pragma unroll
    for (int k = 0; k < 4; ++k) { const int keep = b1 ? q8[4 + k] : q8[k], send = b1 ? q8[k] : q8[4 + k]; q4[k] = keep + dppi<0x4E>(send); }
#pragma unroll
    for (int k = 0; k < 2; ++k) { const int keep = b0 ? q4[2 + k] : q4[k], send = b0 ? q4[k] : q4[2 + k]; q2[k] = keep + dppi<0xB1>(send); }
    if (first) { pp[0] = q2[0]; pp[1] = q2[1]; } else { pp[0] += q2[0]; pp[1] += q2[1]; }
}
__device__ __forceinline__ void peer_gather_e(u32x4 (&w)[16], u32x4 (&ent)[4], const LAS unsigned* ep, const unsigned char* tab) {
#pragma unroll
    for (int c = 0; c < 4; ++c) ent[c] = *(const LAS u32x4*)(ep + 4 * c);
#pragma unroll
    for (int i = 0; i < 16; ++i) w[i] = *(const u32x4*)(tab + (size_t)(ent[i >> 2][i & 3] & 16383u) * 128);
}
constexpr int PBL_SRT = 0, PBL_ACC = 65536, PBL_H = 131072;
__device__ __forceinline__ void peer_u_block(const Args& a, LAS unsigned char* lds, int vblock) {
    const unsigned* gsel_e = (const unsigned*)(a.ws + WS_SELE); const float* gsel_g = (const float*)(a.ws + WS_SELG);
    const unsigned char* hq = a.ws + WS_HQ; const float* hsc = (const float*)(a.ws + WS_HS);
    const unsigned char* Uq = a.ws + WS_UT; const float* uscale = (const float*)(a.ws + WS_US); const float* vscale = (const float*)(a.ws + WS_VS);
    int tid = threadIdx.x; asm volatile("" : "+v"(tid));
    const int lane = tid & 63, wave = tid >> 6;
    const size_t tokB = (size_t)vblock * 128;
    LAS unsigned* SRT = (LAS unsigned*)(lds + PBL_SRT); LAS unsigned* ACC = (LAS unsigned*)(lds + PBL_ACC); LAS unsigned char* H = lds + PBL_H;
    u32x4 ev[8];
#pragma unroll
    for (int j = 0; j < 8; ++j) ev[j] = *(const u32x4*)(gsel_e + tokB * 128 + (size_t)tid * 32 + 4 * j);
#pragma unroll
    for (int j = 0; j < 8; ++j) ((LAS u32x4*)ACC)[tid + 512 * j] = (u32x4){0u, 0u, 0u, 0u};
    __syncthreads();
    unsigned rk[32];
#pragma unroll
    for (int j = 0; j < 32; ++j) rk[j] = __hip_atomic_fetch_add(ACC + ev[j >> 2][j & 3], 1u, __ATOMIC_RELAXED, __HIP_MEMORY_SCOPE_WORKGROUP);
    __syncthreads();
    {
        unsigned c[32], tot = 0u;
#pragma unroll
        for (int j = 0; j < 32; ++j) { c[j] = ACC[tid + 512 * j]; tot += c[j]; }
        unsigned inc = tot;
#pragma unroll
        for (int o = 1; o < 64; o <<= 1) { const unsigned u = __shfl_up(inc, o); if (lane >= o) inc += u; }
        LAS unsigned* wtot = (LAS unsigned*)H;
        if (lane == 63) wtot[wave] = inc;
        __syncthreads();
        unsigned base = inc - tot;
#pragma unroll
        for (int w2 = 0; w2 < 8; ++w2) base += (w2 < wave) ? wtot[w2] : 0u;
#pragma unroll
        for (int j = 0; j < 32; ++j) { ACC[tid + 512 * j] = base; base += c[j]; }
    }
    __syncthreads();
#pragma unroll
    for (int j = 0; j < 32; ++j) { const unsigned e = ev[j >> 2][j & 3]; const unsigned q = ACC[e] + rk[j];
        SRT[(q & ~127u) | ((q & 7u) << 4) | ((q >> 3) & 15u)] = ((unsigned)(tid * 32 + j) << 14) | e; }
    __syncthreads();
    const int sub = lane & 7, eg = lane >> 3;
    const bool b2 = (sub & 4) != 0, b1 = (sub & 2) != 0, b0 = (sub & 1) != 0;
    const unsigned char* hsrc = hq + (tokB + (size_t)(tid >> 2)) * DM + (tid & 3) * 32;
    u32x4 hn0 = *(const u32x4*)hsrc, hn1 = *(const u32x4*)(hsrc + 16);
    u32x4 wA[16], wB[16], eA[4], eB[4];
    for (int s = 0; s < 8; ++s) {
        *(LAS u32x4*)(H + (tid >> 2) * 144 + (tid & 3) * 32) = hn0; *(LAS u32x4*)(H + (tid >> 2) * 144 + (tid & 3) * 32 + 16) = hn1;
        { const int sn = s < 7 ? s + 1 : s; hn0 = *(const u32x4*)(hsrc + 128 * sn); hn1 = *(const u32x4*)(hsrc + 128 * sn + 16); }
        __syncthreads();
        const unsigned char* Us = Uq + (size_t)s * 16384 * 128 + 16 * sub;
        const LAS unsigned char* Hs = H + 16 * sub;
        const LAS unsigned* ep = SRT + wave * 2048 + eg * 16;
        LAS int* pp = (LAS int*)ACC + wave * 2048 + eg * 16 + 2 * sub;
        if (s == 0) peer_gather_e(wA, eA, ep, Us);
        for (int g = 0; g < 16; g += 2) {
            peer_gather_e(wB, eB, ep + (g + 1) * 128, Us);
            peer_u_red16(wA, eA, Hs, pp + g * 128, s == 0, b2, b1, b0);
            if (g + 2 < 16) peer_gather_e(wA, eA, ep + (g + 2) * 128, Us);
            else if (s < 7) peer_gather_e(wA, eA, ep, Us + (size_t)16384 * 128);
            peer_u_red16(wB, eB, Hs, pp + (g + 1) * 128, s == 0, b2, b1, b0);
        }
        __syncthreads();
    }
    {
        float r[32]; unsigned pid[32];
#pragma unroll
        for (int j = 0; j < 32; ++j) {
            const unsigned en = SRT[tid + 512 * j]; const int acc = ((LAS int*)ACC)[tid + 512 * j];
            const unsigned e = en & 16383u; pid[j] = en >> 14;
            const float pv = (float)acc * (uscale[e] * hsc[tokB + (pid[j] >> 7)]);
            r[j] = 0.5f * pv * (1.0f + erff(pv * 0.70710678118654752f)) * gsel_g[tokB * 128 + pid[j]] * vscale[e];
        }
        __syncthreads();
        LAS float* R = (LAS float*)(lds + PBL_SRT);
#pragma unroll
        for (int j = 0; j < 32; ++j) R[pid[j]] = r[j];
        __syncthreads();
        for (int t = 0; t < 16; ++t) {
            const int tl = 16 * wave + t;
            const float r0 = R[tl * 128 + lane], r1 = R[tl * 128 + lane + 64];
            const float am = wave_max(fmaxf(fabsf(r0), fabsf(r1)));
            const float inv = am > 0.f ? 127.0f / am : 0.f;
            LAS unsigned char* ab = H + tl * 144;
            ab[(lane & 7) * 16 + (lane >> 3)] = (unsigned char)((int)rintf(r0 * inv) & 255);
            ab[((lane + 64) & 7) * 16 + ((lane + 64) >> 3)] = (unsigned char)((int)rintf(r1 * inv) & 255);
            if (lane == 0) *(LAS float*)(ab + 128) = am * (1.0f / 127.0f);
        }
        __syncthreads();
    }
}
__device__ __forceinline__ void phase_peer(const Args& a, LAS unsigned char* lds, int vblock) {
    const int wave = threadIdx.x >> 6;
    const int gw = vblock * NWAVE + wave, NGW = gridDim.x * NWAVE;
    const unsigned* gsel_e = (const unsigned*)(a.ws + WS_SELE); const float* gsel_g = (const float*)(a.ws + WS_SELG);
    const unsigned char* hq = a.ws + WS_HQ; const float* hsc = (const float*)(a.ws + WS_HS);
    const unsigned char* Uq = a.ws + WS_UT; const unsigned char* Vq = a.ws + WS_VT;
    const float* uscale = (const float*)(a.ws + WS_US); const float* vscale = (const float*)(a.ws + WS_VS);
    const float* mod = (const float*)(a.ws + WS_MOD); float* out = a.out; const bf16_t* x1b = (const bf16_t*)(a.ws + WS_X1B);
    LAS unsigned* ids = (LAS unsigned*)(lds + wave * 16384);
    LAS int* pre = (LAS int*)(lds + wave * 16384 + 8192);
    for (int grp = gw; grp * 16 < T_TOK; grp += NGW) {
        int lane = threadIdx.x & 63; asm volatile("" : "+v"(lane));
        const int sub = lane & 7, eg = lane >> 3;
        const bool b2 = (sub & 4) != 0, b1 = (sub & 2) != 0, b0 = (sub & 1) != 0;
        const bool e0 = (eg & 1) != 0, e1 = (eg & 2) != 0, e2 = (eg & 4) != 0;
        const size_t tok0 = (size_t)grp * 16;
        const bool blockwise = (int)gridDim.x * 128 == T_TOK;
        const LAS unsigned char* actb = (const LAS unsigned char*)pre; int astr = 512;
        if (blockwise) { peer_u_block(a, lds, vblock); actb = lds + PBL_H + (wave * 16) * 144; astr = 144; }
#pragma unroll
        for (int j = 0; j < 8; ++j) {
            const int q = lane + 64 * j;
            const u32x4 v = *(const u32x4*)(gsel_e + tok0 * 128 + (size_t)q * 4);
            const int t = q >> 5, k = (q & 31) * 4;
#pragma unroll
            for (int c = 0; c < 4; ++c) ids[t * 128 + ((k + c) & 7) * 16 + ((k + c) >> 3)] = v[c];
        }
        LDS_WAIT();
        if (!blockwise) {
        for (int s = 0; s < 8; ++s) {
            const unsigned char* Us = Uq + (size_t)s * 16384 * 128 + 16 * sub;
            const unsigned char* hs = hq + tok0 * DM + 128 * s + 16 * sub;
            u32x4 wA[16], wB[16], hA, hB;
            peer_gather(wA, ids + eg * 16, Us); hA = *(const u32x4*)(hs);
            for (int t = 0; t < 16; t += 2) {
                peer_gather(wB, ids + (t + 1) * 128 + eg * 16, Us); hB = *(const u32x4*)(hs + (t + 1) * DM);
                peer_u_reduce(wA, hA, pre + t * 128 + 16 * sub + eg, s == 0, b2, b1, b0);
                if (t + 2 < 16) { peer_gather(wA, ids + (t + 2) * 128 + eg * 16, Us); hA = *(const u32x4*)(hs + (t + 2) * DM); }
                peer_u_reduce(wB, hB, pre + (t + 1) * 128 + 16 * sub + eg, s == 0, b2, b1, b0);
            }
        }
        LDS_WAIT();
        for (int t = 0; t < 16; ++t) {
            float r[2]; const float hs_t = hsc[tok0 + t];
#pragma unroll
            for (int c = 0; c < 2; ++c) {
                const int k = lane + 64 * c;
                const unsigned e = ids[t * 128 + (k & 7) * 16 + (k >> 3)];
                const float pv = (float)pre[t * 128 + k] * (uscale[e] * hs_t);
                r[c] = 0.5f * pv * (1.0f + erff(pv * 0.70710678118654752f)) * gsel_g[(tok0 + t) * 128 + k] * vscale[e];
            }
            const float am = wave_max(fmaxf(fabsf(r[0]), fabsf(r[1])));
            const float inv = am > 0.f ? 127.0f / am : 0.f;
            LDS_WAIT();
            LAS unsigned char* ab = (LAS unsigned char*)(pre + t * 128);
#pragma unroll
            for (int c = 0; c < 2; ++c) { const int k = lane + 64 * c; ab[(k & 7) * 16 + (k >> 3)] = (unsigned char)((int)rintf(r[c] * inv) & 255); }
            if (lane == 0) *(LAS float*)(ab + 128) = am * (1.0f / 127.0f);
        }
        }
        LDS_WAIT();
        for (int s = 0; s < 8; ++s) {
            const unsigned char* Vs = Vq + (size_t)s * 16384 * 128 + 16 * sub;
            const int d = 128 * s + 16 * sub + (e0 ? 8 : 0) + (e1 ? 4 : 0) + (e2 ? 2 : 0);
            const f32x2 gv = *(const f32x2*)(mod + (tok0 >> 12) * NMODC + 5120 + d);
            u32x4 wA[16], wB[16];
            const unsigned* xq = (const unsigned*)(x1b + tok0 * DM + d);
            unsigned xA = __builtin_nontemporal_load(xq), xB;
            peer_gather(wA, ids + eg * 16, Vs);
            for (int t = 0; t < 16; t += 2) {
                xB = __builtin_nontemporal_load(xq + (t + 1) * (DM / 2));
                peer_gather(wB, ids + (t + 1) * 128 + eg * 16, Vs);
                peer_v_reduce(wA, (const LAS unsigned*)(actb + t * astr) + eg * 4, *(const LAS float*)(actb + t * astr + 128), out + (tok0 + t) * DM + d, xA, gv, e0, e1, e2);
                if (t + 2 < 16) { xA = __builtin_nontemporal_load(xq + (t + 2) * (DM / 2)); peer_gather(wA, ids + (t + 2) * 128 + eg * 16, Vs); }
                peer_v_reduce(wB, (const LAS unsigned*)(actb + (t + 1) * astr) + eg * 4, *(const LAS float*)(actb + (t + 1) * astr + 128), out + (tok0 + t + 1) * DM + d, xB, gv, e0, e1, e2);
            }
        }
        LDS_WAIT();
    }
}

__device__ __forceinline__ void grid_barrier(unsigned* cnt, unsigned nblocks) {
    __syncthreads();
    if (threadIdx.x == 0) {
        __builtin_amdgcn_fence(__ATOMIC_RELEASE, "agent");
        asm volatile("s_waitcnt vmcnt(0)" ::: "memory");
        __hip_atomic_fetch_add(cnt, 1u, __ATOMIC_RELAXED, __HIP_MEMORY_SCOPE_AGENT);
        while (__hip_atomic_load(cnt, __ATOMIC_RELAXED, __HIP_MEMORY_SCOPE_AGENT) < nblocks) __builtin_amdgcn_s_sleep(2);
        __builtin_amdgcn_fence(__ATOMIC_ACQUIRE, "agent");
        asm volatile("s_waitcnt vmcnt(0)" ::: "memory");
    }
    __syncthreads();
}

#define XB_TMO      128
#define XB_XCNT(j)  (256  + 64 * (j))
#define XB_XSUB(j)  (1280 + 64 * (j))
#define XB_XGEN(j)  (2304 + 64 * (j))
#define XB_TOP      3328
#define XB_TOPGEN   3392
#define XB_SPIN_CAP (1u << 22)
__device__ __forceinline__ unsigned xb_ld(unsigned* p)              { return __hip_atomic_load(p, __ATOMIC_RELAXED, __HIP_MEMORY_SCOPE_AGENT); }
__device__ __forceinline__ unsigned xb_add(unsigned* p, unsigned v) { return __hip_atomic_fetch_add(p, v, __ATOMIC_RELAXED, __HIP_MEMORY_SCOPE_AGENT); }
__device__ __forceinline__ unsigned xb_xcc_id() { return (unsigned)__builtin_amdgcn_s_getreg((3 << 11) | 20) & 0xFu; }
#define XB_SPIN(cond, bar) do { unsigned _sp = 0; while (cond) { __builtin_amdgcn_s_sleep(1); \
    if ((++_sp & 255u) == 0u) { if (xb_ld(&(bar)[XB_TMO])) break; if (_sp > XB_SPIN_CAP) { atomicAdd(&(bar)[XB_TMO], 1u); break; } } } } while (0)
struct XcdBarrier { unsigned* bar; unsigned x; volatile LAS unsigned* st; };
__device__ __forceinline__ XcdBarrier xcd_barrier_post(unsigned* bar, volatile LAS unsigned* st) {
    XcdBarrier b; b.bar = bar; b.x = xb_xcc_id(); b.st = st;
    if (threadIdx.x == 0) (void)xb_add(&bar[XB_XCNT(b.x)], 1u);
    return b;
}
__device__ __forceinline__ void xcd_barrier_complete(unsigned* bar, unsigned x, unsigned& nloc, unsigned& nx) {
    const unsigned G = gridDim.x * gridDim.y * gridDim.z;
    unsigned sum, cnt, mine, sp = 0u;
    for (;;) {
        sum = 0u; cnt = 0u; mine = 0u;
#pragma unroll
        for (unsigned j = 0; j < 16; ++j) { const unsigned c = xb_ld(&bar[XB_XCNT(j)]); sum += c; cnt += (c > 0u) ? 1u : 0u; mine = (j == x) ? c : mine; }
        if (sum == G) break;
        __builtin_amdgcn_s_sleep(1);
        if ((++sp & 255u) == 0u) { if (xb_ld(&bar[XB_TMO])) break; if (sp > XB_SPIN_CAP) { atomicAdd(&bar[XB_TMO], 1u); break; } }
    }
    nloc = mine > 0u ? mine : 1u; nx = cnt > 0u ? cnt : 1u;
}
__device__ __forceinline__ void xcd_barrier(const XcdBarrier& b) {
    asm volatile("s_waitcnt vmcnt(0)" ::: "memory");
    __syncthreads();
    if (threadIdx.x == 0) {
        unsigned* bar = b.bar;
        __builtin_amdgcn_s_waitcnt(0);
        unsigned nloc = b.st[0], nx = b.st[1];
        if (nloc == 0u) { xcd_barrier_complete(bar, b.x, nloc, nx); b.st[0] = nloc; b.st[1] = nx; }
        const unsigned old = xb_add(&bar[XB_XSUB(b.x)], 1u);
        const unsigned gen = old / nloc;
        if (old + 1u == (gen + 1u) * nloc) {
            __builtin_amdgcn_fence(__ATOMIC_RELEASE, "agent");
            asm volatile("s_waitcnt vmcnt(0)" ::: "memory");
            const unsigned og = xb_add(&bar[XB_TOP], 1u);
            const unsigned tg = og / nx;
            if (og + 1u == (tg + 1u) * nx) xb_add(&bar[XB_TOPGEN], 1u);
            else XB_SPIN(xb_ld(&bar[XB_TOPGEN]) == tg, bar);
            __builtin_amdgcn_fence(__ATOMIC_ACQUIRE, "agent");
            xb_add(&bar[XB_XGEN(b.x)], 1u);
            asm volatile("s_waitcnt vmcnt(0)" ::: "memory");
        } else {
            XB_SPIN(xb_ld(&bar[XB_XGEN(b.x)]) == gen, bar);
            __builtin_amdgcn_fence(__ATOMIC_ACQUIRE, "agent");
            asm volatile("s_waitcnt vmcnt(0)" ::: "memory");
        }
    }
    __syncthreads();
}

__device__ __forceinline__ void pair_sync(unsigned* cnt, unsigned* bar, bool same_xcd, unsigned target = 2u) {
    asm volatile("s_waitcnt vmcnt(0)" ::: "memory");
    __syncthreads();
    if (threadIdx.x == 0) {
        if (!same_xcd) __builtin_amdgcn_fence(__ATOMIC_RELEASE, "agent");
        asm volatile("s_waitcnt vmcnt(0)" ::: "memory");
        (void)xb_add(cnt, 1u);
        XB_SPIN(xb_ld(cnt) < target, bar);
        __builtin_amdgcn_fence(__ATOMIC_ACQUIRE, "agent");
        asm volatile("s_waitcnt vmcnt(0)" ::: "memory");
    }
    __syncthreads();
}

__global__ void __launch_bounds__(NTHR, 2) mega(Args a) {
    extern __shared__ __attribute__((aligned(16))) unsigned char smem[];
    LAS unsigned char* lds = (LAS unsigned char*)smem;
    const int lo = a.ph_lo, hi = a.ph_hi;
    const int G = gridDim.x;
    if (threadIdx.x < 4) ((LAS unsigned*)(lds + LDS_BYTES - 16))[threadIdx.x] = 0u;
    XcdBarrier xb; xb.bar = (unsigned*)(a.ws + WS_XB); xb.x = 0; xb.st = (volatile LAS unsigned*)(lds + LDS_BYTES - 16);
#define IN(k) (lo <= (k) && (k) < hi)
#ifndef DUP_MASK
#define DUP_MASK 0
#endif
#define REP(k) for (int rep_ = 0; rep_ < 1 + ((DUP_MASK >> (k)) & 1); ++rep_, (((DUP_MASK >> 23) & 1) && ((DUP_MASK >> (k)) & 1) && (k) < 16 && rep_ == 1 ? grid_barrier((unsigned*)(a.ws + WS_BAR) + 64 * ((k) > 15 ? 15 : (k)) + 16, (unsigned)G) : (void)0))
    const bool pairm = PAIR_CHAIN && G == 2 * (T_TOK / pg8::BM) && lo <= 0 && hi > 10;
    const int bx = (int)blockIdx.x, vb = pairm ? (((((bx & 7) << 4) | (bx >> 4)) << 1) | ((bx >> 3) & 1)) : bx;
    unsigned* pcnt = (unsigned*)(a.ws + WS_PC) + (vb >> 1) * 64;
    bool same_xcd = false;
#define PSYNC(k, s, tg) do { if (pairm) pair_sync(pcnt + 16 * (s), (unsigned*)(a.ws + WS_XB), same_xcd, (tg)); else SYNC(k); } while (0)
#define SYNC(k) do { if (IN(k) && IN((k) + 1)) { if ((k) == 0) { cg::this_grid().sync(); xb = xcd_barrier_post((unsigned*)(a.ws + WS_XB), (volatile LAS unsigned*)(lds + LDS_BYTES - 16)); } else { xcd_barrier(xb); if ((DUP_MASK >> 22) & 1) xcd_barrier(xb); } } } while (0)
    if (IN(0) && threadIdx.x == 0) ((unsigned*)(a.ws + WS_PC) + 128 * 64)[bx] = 1u + xb_xcc_id();
    if (IN(0)) REP(0) phase0(a, lds);
    SYNC(0);
    bool same_all = false;
    if (pairm) { const unsigned* xid = (const unsigned*)(a.ws + WS_PC) + 128 * 64; const unsigned me = 1u + xb_xcc_id();
        same_xcd = xb_ld((unsigned*)xid + (bx ^ 8)) == me; same_all = same_xcd;
        if ((bx >> 4) > 0)  same_all = same_all && xb_ld((unsigned*)xid + (bx - 16)) == me && xb_ld((unsigned*)xid + ((bx - 16) ^ 8)) == me;
        if ((bx >> 4) < 15) same_all = same_all && xb_ld((unsigned*)xid + (bx + 16)) == me && xb_ld((unsigned*)xid + ((bx + 16) ^ 8)) == me; }
    unsigned* cntw = (unsigned*)(a.ws + WS_PC) + 128 * 64 + 576;
    if (IN(1)) REP(1) {
        phase0b(a, lds);
        if (pairm) {
            asm volatile("s_waitcnt vmcnt(0)" ::: "memory"); __syncthreads();
            if (threadIdx.x == 0) { __builtin_amdgcn_fence(__ATOMIC_RELEASE, "agent"); asm volatile("s_waitcnt vmcnt(0)" ::: "memory"); (void)xb_add(cntw, 1u); }
        }
        phase_norm<true>(a, a.in[0], a.in[4], 0, 1024, vb);
    }
    if (pairm) {
        pair_sync(pcnt, (unsigned*)(a.ws + WS_XB), same_xcd, 2u);
        if (threadIdx.x == 0) { XB_SPIN(xb_ld(cntw) < (unsigned)G, (unsigned*)(a.ws + WS_XB)); __builtin_amdgcn_fence(__ATOMIC_ACQUIRE, "agent"); asm volatile("s_waitcnt vmcnt(0)" ::: "memory"); }
        __syncthreads();
    } else SYNC(1);
#if INPROJ_I8
    if (IN(2)) REP(2) { pg8::Gemm g{(const bf16_t*)((const unsigned char*)a.out + H1_OFF), (const bf16_t*)(a.ws + WS_WIN_T), T_TOK, NPROJ, 512}; pg8::StaticOrder S; S.init(T_TOK, NPROJ, G, vb, pairm, pairm ? 1 : 0);
        pg8::EpiBf16S E{(bf16_t*)(a.ws + WS_PROJ), NPROJ, (const float*)(a.ws + WS_H1S), (const float*)(a.ws + WS_WINS)}; pg8::gemm_phase<pg8::EpiBf16S, true>(lds, g, S, E); }
#else
    if (IN(2)) REP(2) { pg8::Gemm g{(const bf16_t*)(a.ws + WS_ACT), (const bf16_t*)(a.ws + WS_WIN_T), T_TOK, NPROJ, 1024}; pg8::StaticOrder S; S.init(T_TOK, NPROJ, G, (int)blockIdx.x);
        pg8::EpiBf16 E{(bf16_t*)(a.ws + WS_PROJ), NPROJ}; pg8::gemm_phase(lds, g, S, E); }
#endif
    if (pairm) {
        pair_sync(pcnt + 16, (unsigned*)(a.ws + WS_XB), same_all, 2u);
        if (((vb >> 1) & 15) != 0) {
            if (threadIdx.x == 0) { XB_SPIN(xb_ld(pcnt - 64 + 16) < 2u, (unsigned*)(a.ws + WS_XB)); __builtin_amdgcn_fence(__ATOMIC_ACQUIRE, "agent"); asm volatile("s_waitcnt vmcnt(0)" ::: "memory"); }
            __syncthreads();
        }
    } else SYNC(2);
    if (IN(3)) { REP(3) dn_prep(a, lds, vb, pairm); REP(18) sb_prep(a, lds, vb, pairm); }
    SYNC(3);
    if (IN(4)) {
        if ((int)blockIdx.x < DN_BLOCKS) { REP(16) dn_scan2(a, lds); }
        else {
            const int sbi = (int)blockIdx.x - DN_BLOCKS;
            REP(17) sb_attn(a, sbi * NWAVE + (int)(threadIdx.x >> 6), (G - DN_BLOCKS) * NWAVE);
            if (!pairm) late_prep(a, lds, sbi * NWAVE + (int)(threadIdx.x >> 6), (G - DN_BLOCKS) * NWAVE);
            else if (sbi >= 64) late_prep(a, lds, (sbi - 64) * NWAVE + (int)(threadIdx.x >> 6), (G - DN_BLOCKS - 64) * NWAVE);
            if (pairm) {
                __syncthreads();
                pg8::Gemm g{(const bf16_t*)((const unsigned char*)a.out + H1_OFF), (const bf16_t*)(a.ws + WS_WIN_T), T_TOK, NPROJ, 512}; pg8::StaticOrder S; S.init(T_TOK, NPROJ, G, sbi, false, 2);
                pg8::EpiBf16S E{(bf16_t*)(a.ws + WS_PROJ), NPROJ, (const float*)(a.ws + WS_H1S), (const float*)(a.ws + WS_WINS)}; pg8::gemm_phase<pg8::EpiBf16S, true>(lds, g, S, E);
            }
        }
    }
    SYNC(4);
    if (IN(5)) REP(5) dn_gate_norm(a, vb);
    if (pairm) {
        asm volatile("s_waitcnt vmcnt(0)" ::: "memory"); __syncthreads();
        if (threadIdx.x == 0) (void)xb_add((unsigned*)(a.ws + WS_PC) + 128 * 64 + 512, 1u);
    }
    PSYNC(5, 3, 2u);
    if (IN(6)) REP(6) { pg8::Gemm g{(const bf16_t*)(a.ws + WS_MQ), (const bf16_t*)(a.ws + WS_WOUT_T), T_TOK, 1024, 512}; pg8::StaticOrder S; S.init(T_TOK, 1024, G, vb, pairm);
        pg8::EpiResidS E{a.in[0], (const float*)(a.ws + WS_MOD), (bf16_t*)(a.ws + WS_X1B), (const float*)(a.ws + WS_MS), (const float*)(a.ws + WS_WOS)}; pg8::gemm_phase<pg8::EpiResidS, true>(lds, g, S, E); }
    PSYNC(6, 0, 4u);
    if (pairm) { if (threadIdx.x == 0) XB_SPIN(xb_ld((unsigned*)(a.ws + WS_PC) + 128 * 64 + 512) < (unsigned)G, (unsigned*)(a.ws + WS_XB)); __syncthreads(); }
    if (IN(7)) REP(7) phase_norm<false>(a, a.out, a.in[14], 3072, 4096, vb);
    PSYNC(7, 1, 4u);
    if (IN(8)) REP(8) {
#if QUERY_I8
        pg8::Gemm g{(const bf16_t*)(a.ws + WS_HQ), (const bf16_t*)(a.ws + WS_WQ_T), T_TOK, 2048, 512}; pg8::StaticOrder S; S.init(T_TOK, 2048, G, vb, pairm);
        pg8::EpiBf16S E{(bf16_t*)(a.ws + WS_QPEER), 2048, (const float*)(a.ws + WS_HS), (const float*)(a.ws + WS_WQS)}; pg8::gemm_phase<pg8::EpiBf16S, true>(lds, g, S, E);
#else
        pg8::Gemm g{(const bf16_t*)(a.ws + WS_ACT), (const bf16_t*)(a.ws + WS_WQ_T), T_TOK, 2048, 1024}; pg8::StaticOrder S; S.init(T_TOK, 2048, G, (int)blockIdx.x);
        pg8::EpiBf16 E{(bf16_t*)(a.ws + WS_QPEER), 2048}; pg8::gemm_phase(lds, g, S, E);
#endif
        asm volatile("s_waitcnt vmcnt(0)" ::: "memory"); __syncthreads();
        phase_scores(a, lds, S); }
    PSYNC(8, 2, 2u);
    if (IN(10)) phase_peer(a, lds, vb);
#undef IN
#undef SYNC
#undef PSYNC
}

#ifndef ONE_LAUNCH
#define ONE_LAUNCH 1
#endif

extern "C" void kernel_launch(void* const* d_in, const int* in_sizes, int n_in, void* d_out, int out_size, void* d_ws, size_t ws_size, hipStream_t stream) {
    static int grid = 0;
    if (grid == 0) {
        int dev = 0, cus = 0, per_cu = 0;
        (void)hipGetDevice(&dev);
        (void)hipDeviceGetAttribute(&cus, hipDeviceAttributeMultiprocessorCount, dev);
        (void)hipFuncSetAttribute((const void*)mega, hipFuncAttributeMaxDynamicSharedMemorySize, LDS_BYTES);
        (void)hipOccupancyMaxActiveBlocksPerMultiprocessor(&per_cu, (const void*)mega, NTHR, LDS_BYTES);
        if (per_cu < 1) { fprintf(stderr, "kernel_launch: occupancy query says %d blocks/CU\n", per_cu); per_cu = 1; }
        if (per_cu > 1) per_cu = 1;
        grid = cus * per_cu;
        if (ws_size < WS_END4) fprintf(stderr, "kernel_launch: workspace too small: %zu < %zu\n", ws_size, (size_t)WS_END4);
    }
    Args a{};
    for (int i = 0; i < 19; ++i) a.in[i] = (const float*)d_in[i];
    a.out = (float*)d_out; a.ws = (unsigned char*)d_ws;
#if ONE_LAUNCH
    a.ph_lo = 0; a.ph_hi = N_PHASES;
    void* args[] = {&a};
    hipError_t e = hipLaunchCooperativeKernel((const void*)mega, dim3(grid), dim3(NTHR), args, LDS_BYTES, stream);
    if (e != hipSuccess) fprintf(stderr, "cooperative launch failed: %s (grid %d)\n", hipGetErrorString(e), grid);
#else
    for (int p = 0; p < N_PHASES; ++p) {
        a.ph_lo = p; a.ph_hi = p + 1;
        hipLaunchKernelGGL(mega, dim3(grid), dim3(NTHR), LDS_BYTES, stream, a);
    }
#endif
}
```
